# Optimizing an MI355X kernel written in HIP

```python
import jax, jax.numpy as jnp
from jax import lax
import numpy as np

D_MODEL = 2048
BATCH = 4
SEQ = 4096
DEPTH = 2

HEAD_DIM = 128
N_HEADS_DIL = D_MODEL // (2 * HEAD_DIM)
N_HEADS_SB = D_MODEL // (2 * HEAD_DIM)
D_DIL = N_HEADS_DIL * HEAD_DIM
D_SB = N_HEADS_SB * HEAD_DIM
D_MIX = D_DIL + D_SB
DILATED_BRANCHES = ((128, 1), (512, 4), (2048, 16))
Q_BLOCK = 128
N_BUCKETS = 32
MAX_DISTANCE = 2048
D_FF_DENSE = 5504
N_EXPERTS = 8
TOP_K = 2
D_FF_EXPERT = 7168
N_DENSE_LAYERS = (DEPTH + 1) // 2
N_MOE_LAYERS = DEPTH // 2
EPS = 1e-6

kernel_name = "hybrid_dilated_stickbreaking_moe_block"


def rms_norm(x, g):
    xf = x.astype(jnp.float32)
    y = xf * lax.rsqrt(jnp.mean(xf * xf, axis=-1, keepdims=True) + EPS)
    return (y * g.astype(jnp.float32)).astype(x.dtype)


def t5_bucket(dist):
    n = np.asarray(dist, dtype=np.int64)
    max_exact = N_BUCKETS // 2
    large = max_exact + (np.log(np.maximum(n, 1) / max_exact)
                         / np.log(MAX_DISTANCE / max_exact)
                         * (N_BUCKETS - max_exact)).astype(np.int64)
    large = np.minimum(large, N_BUCKETS - 1)
    return np.where(n < max_exact, n, large).astype(np.int32)


def to_blocks(t):
    b, h, s, dh = t.shape
    return t.reshape(b, h, s // Q_BLOCK, Q_BLOCK, dh).transpose(2, 0, 1, 3, 4)


def from_blocks(t):
    nb, b, h, q, dh = t.shape
    return t.transpose(1, 2, 0, 3, 4).reshape(b, h, nb * q, dh)


def dilated_attention(q, k, v, rel_bias):
    b, h, s, dh = q.shape
    nb = s // Q_BLOCK
    qb = to_blocks(q * (dh ** -0.5))
    branches = []
    for (w, d) in DILATED_BRANCHES:
        m = np.arange(w // d + 1, dtype=np.int32)
        bias = rel_bias[t5_bucket(d * m)].T.astype(jnp.float32)
        branches.append((d, m, bias))

    def block(args):
        q_blk, i = args
        t = i * Q_BLOCK + jnp.arange(Q_BLOCK, dtype=jnp.int32)
        lses, outs = [], []
        for d, m, bias in branches:
            idx = t[:, None] - d * m[None, :]
            valid = idx >= 0
            idx = jnp.maximum(idx, 0)
            k_g = k[:, :, idx]
            v_g = v[:, :, idx]
            sc = jnp.einsum('bhqd,bhqmd->bhqm', q_blk, k_g).astype(jnp.float32)
            sc = jnp.where(valid, sc + bias[None, :, None, :], -jnp.inf)
            lse = jax.nn.logsumexp(sc, axis=-1, keepdims=True)
            p = jnp.exp(sc - lse).astype(v.dtype)
            outs.append(jnp.einsum('bhqm,bhqmd->bhqd', p, v_g).astype(jnp.float32))
            lses.append(lse)
        wts = jax.nn.softmax(jnp.stack(lses, axis=0), axis=0)
        return jnp.sum(wts * jnp.stack(outs, axis=0), axis=0).astype(q.dtype)

    out = lax.map(block, (qb, jnp.arange(nb, dtype=jnp.int32)))
    return from_blocks(out)


def stick_breaking_attention(q, k, v):
    b, h, s, dh = q.shape
    nb = s // Q_BLOCK
    qb = to_blocks(q * (dh ** -0.5))
    pos = jnp.arange(s, dtype=jnp.int32)

    def block(args):
        q_blk, i = args
        t = i * Q_BLOCK + jnp.arange(Q_BLOCK, dtype=jnp.int32)
        causal = pos[None, :] < t[:, None]
        z = jnp.einsum('bhqd,bhsd->bhqs', q_blk, k).astype(jnp.float32)
        log_keep = jnp.where(causal, jax.nn.log_sigmoid(-z), 0.0)
        later = lax.cumsum(log_keep, axis=3, reverse=True) - log_keep
        a = jnp.where(causal, jnp.exp(jax.nn.log_sigmoid(z) + later), 0.0)
        return jnp.einsum('bhqs,bhsd->bhqd', a.astype(v.dtype), v)

    out = lax.map(block, (qb, jnp.arange(nb, dtype=jnp.int32)))
    return from_blocks(out)


def token_mixer(h, w_in, w_o, g_dil, g_sb, rel_bias):
    b, s, _ = h.shape
    proj = h @ w_in
    qd, kd, vd, qs, ks, vs = jnp.split(
        proj, [D_DIL, 2 * D_DIL, 3 * D_DIL, 3 * D_DIL + D_SB, 3 * D_DIL + 2 * D_SB], axis=-1)
    heads = lambda t, n: t.reshape(b, s, n, HEAD_DIM).transpose(0, 2, 1, 3)
    merge = lambda t: t.transpose(0, 2, 1, 3).reshape(b, s, -1)
    o_dil = merge(dilated_attention(heads(qd, N_HEADS_DIL), heads(kd, N_HEADS_DIL),
                                    heads(vd, N_HEADS_DIL), rel_bias))
    o_sb = merge(stick_breaking_attention(heads(qs, N_HEADS_SB), heads(ks, N_HEADS_SB),
                                          heads(vs, N_HEADS_SB)))
    o = jnp.concatenate([rms_norm(o_dil, g_dil), rms_norm(o_sb, g_sb)], axis=-1)
    return o @ w_o


def swiglu(h, w_gate, w_up, w_down):
    return (jax.nn.silu(h @ w_gate) * (h @ w_up)) @ w_down


def moe_swiglu(h, w_router, w_gate, w_up, w_down):
    logits = (h @ w_router).astype(jnp.float32)
    top_v, top_i = lax.top_k(logits, TOP_K)
    top_w = jax.nn.softmax(top_v, axis=-1)
    gates = jnp.sum(jax.nn.one_hot(top_i, N_EXPERTS, dtype=jnp.float32) * top_w[..., None], axis=-2)
    y = jnp.zeros_like(h)
    for e in range(N_EXPERTS):
        y = y + gates[..., e:e + 1].astype(h.dtype) * swiglu(h, w_gate[e], w_up[e], w_down[e])
    return y


def setup_inputs(seed: int = 0) -> dict:
    key = jax.random.key(seed)
    ks = jax.random.split(key, 18)
    nrm = lambda k, shape, scale: jax.random.normal(k, shape, jnp.float32) * scale
    gain = lambda k, shape: 1.0 + 0.02 * jax.random.normal(k, shape, jnp.float32)
    return {
        "x": nrm(ks[0], (BATCH, SEQ, D_MODEL), 1.0),
        "rel_bias": nrm(ks[1], (N_BUCKETS, N_HEADS_DIL), 0.5),
        "attn_norm_g": gain(ks[2], (DEPTH, D_MODEL)),
        "w_in": nrm(ks[3], (DEPTH, D_MODEL, 3 * D_MIX), D_MODEL ** -0.5),
        "mix_norm_dil_g": gain(ks[4], (DEPTH, D_DIL)),
        "mix_norm_sb_g": gain(ks[5], (DEPTH, D_SB)),
        "w_o": nrm(ks[6], (DEPTH, D_MIX, D_MODEL), D_MIX ** -0.5),
        "ffn_norm_g": gain(ks[7], (DEPTH, D_MODEL)),
        "dense_w_gate": nrm(ks[8], (N_DENSE_LAYERS, D_MODEL, D_FF_DENSE), D_MODEL ** -0.5),
        "dense_w_up": nrm(ks[9], (N_DENSE_LAYERS, D_MODEL, D_FF_DENSE), D_MODEL ** -0.5),
        "dense_w_down": nrm(ks[10], (N_DENSE_LAYERS, D_FF_DENSE, D_MODEL), D_FF_DENSE ** -0.5),
        "router_w": nrm(ks[11], (N_MOE_LAYERS, D_MODEL, N_EXPERTS), D_MODEL ** -0.5),
        "moe_w_gate": nrm(ks[12], (N_MOE_LAYERS, N_EXPERTS, D_MODEL, D_FF_EXPERT), D_MODEL ** -0.5),
        "moe_w_up": nrm(ks[13], (N_MOE_LAYERS, N_EXPERTS, D_MODEL, D_FF_EXPERT), D_MODEL ** -0.5),
        "moe_w_down": nrm(ks[14], (N_MOE_LAYERS, N_EXPERTS, D_FF_EXPERT, D_MODEL), D_FF_EXPERT ** -0.5),
        "final_norm_g": gain(ks[15], (D_MODEL,)),
    }


def reference(x, rel_bias, attn_norm_g, w_in, mix_norm_dil_g, mix_norm_sb_g, w_o, ffn_norm_g,
              dense_w_gate, dense_w_up, dense_w_down, router_w, moe_w_gate, moe_w_up,
              moe_w_down, final_norm_g):
    for layer in range(DEPTH):
        h = rms_norm(x, attn_norm_g[layer])
        x = x + token_mixer(h, w_in[layer], w_o[layer], mix_norm_dil_g[layer],
                            mix_norm_sb_g[layer], rel_bias)
        h = rms_norm(x, ffn_norm_g[layer])
        j = layer // 2
        if layer % 2 == 0:
            x = x + swiglu(h, dense_w_gate[j], dense_w_up[j], dense_w_down[j])
        else:
            x = x + moe_swiglu(h, router_w[j], moe_w_gate[j], moe_w_up[j], moe_w_down[j])
    return rms_norm(x, final_norm_g)
```

```cpp
#include <hip/hip_runtime.h>
#include <cstdio>
#include <cstdint>
namespace pg8 {
#define PG8_LAS __attribute__((address_space(3)))
typedef unsigned short bf16_t;
typedef short bf16x8 __attribute__((ext_vector_type(8)));
typedef float f32x4 __attribute__((ext_vector_type(4)));
typedef unsigned u32x4 __attribute__((ext_vector_type(4)));
typedef int i32x4 __attribute__((ext_vector_type(4)));
typedef int v8i32 __attribute__((ext_vector_type(8)));
typedef unsigned u32x2 __attribute__((ext_vector_type(2)));
constexpr int BM = 256, BK = 64, HALF = 128, HTB = HALF * BK * 2  , STAGE_BYTES = 8 * HTB, NXCD = 8, WGM = 8;

__host__ __device__ __forceinline__ int lds_byte(int r, int c) { const int st = (r >> 4) * 2 + (c >> 5), rr = r & 15, cc = c & 31, ob = rr * 64 + cc * 2; return st * 1024 + (ob ^ (((ob >> 9) & 1) << 5)); }
__host__ __device__ __forceinline__ void stage_rc(int b, int& R, int& C) { const int st = b / 1024, sb = b % 1024, swz = sb ^ (((sb >> 9) & 1) << 5); R = (st >> 1) * 16 + swz / 64; C = (st & 1) * 32 + (swz % 64) / 2; }
__host__ __device__ __forceinline__ int perm32(int rho) { const int n = rho >> 4, i = rho & 15; return 8 * (i >> 2) + 4 * n + (i & 3); }

struct Unit { int pm, pn; };
struct Gemm { const bf16_t* A; const bf16_t* Bt; int M, N, K; };

struct StaticOrder {
    int nM, nN, nwg, G, c;
    __host__ __device__ void init(int M, int N, int G_, int c_) { nM = M / BM; nN = N / BM; nwg = nM * nN; G = G_; c = c_; }
    __host__ __device__ bool next(int i, Unit& u) const {
        const long L = (long)i * G + c; if (L >= nwg) return false;
        int wgid = (int)L; { const int q = nwg / NXCD, r = nwg % NXCD, xcd = wgid % NXCD, off = wgid / NXCD; wgid = (xcd < r ? xcd * (q + 1) : r * (q + 1) + (xcd - r) * q) + off; }
        const int nig = WGM * nN, gid = wgid / nig, fm = gid * WGM, gsz = (nM - fm) < WGM ? (nM - fm) : WGM;
        u.pm = fm + ((wgid % nig) % gsz); u.pn = (wgid % nig) / gsz; return true;
    }
    __device__ __forceinline__ void a_ready(const Unit&) const {}
    __device__ __forceinline__ void done(const Unit&) const {}
};

__device__ __forceinline__ unsigned cvt_pk_bf16(float lo, float hi) { unsigned r; asm volatile("v_cvt_pk_bf16_f32 %0, %1, %2" : "=v"(r) : "v"(lo), "v"(hi)); return r; }

struct EpiBf16 {
    static constexpr bool PERM = true, AFTER_DRAIN = false;
    bf16_t* O; int ldc; int split_cols; size_t split_stride; int tpe;
    __device__ __forceinline__ void operator()(const f32x4 (&acc)[2][2][4][2], const Unit& u, int wr, int wc, int fr, int fq) const {
        const int row0 = u.pm * BM + wr * 64 + fr; int colt = (tpe ? (u.pn % tpe) : u.pn) * BM; bf16_t* base = O;
        if (split_cols) { const int t = colt / split_cols; base += (size_t)t * split_stride; colt -= t * split_cols; }
        const int col0 = colt + wc * 32 + 8 * fq;
#pragma unroll
        for (int ai = 0; ai < 2; ++ai)
#pragma unroll
            for (int m = 0; m < 4; ++m) { bf16_t* rowp = base + (size_t)(row0 + ai * HALF + m * 16) * ldc + col0;
#pragma unroll
                for (int bj = 0; bj < 2; ++bj) { const f32x4 v0 = acc[ai][bj][m][0], v1 = acc[ai][bj][m][1];
                    u32x4 w; w.x = cvt_pk_bf16(v0[0], v0[1]); w.y = cvt_pk_bf16(v0[2], v0[3]); w.z = cvt_pk_bf16(v1[0], v1[1]); w.w = cvt_pk_bf16(v1[2], v1[3]);
                    *(u32x4*)(rowp + bj * HALF) = w; } }
    }
};


struct EpiBf16G {
    static constexpr bool PERM = true, AFTER_DRAIN = false;
    bf16_t* O; int ldc; int tpe;
    __device__ __forceinline__ void operator()(const f32x4 (&acc)[2][2][4][2], const Unit& u, int wr, int wc, int fr, int fq) const {
        const unsigned off0 = (unsigned)(u.pm * BM + wr * 64 + fr) * (unsigned)ldc + (unsigned)((u.pn % tpe) * BM + wc * 32 + 8 * fq);
#pragma unroll
        for (int ai = 0; ai < 2; ++ai)
#pragma unroll
            for (int m = 0; m < 4; ++m)
#pragma unroll
                for (int bj = 0; bj < 2; ++bj) { const f32x4 v0 = acc[ai][bj][m][0], v1 = acc[ai][bj][m][1];
                    u32x4 w; w.x = cvt_pk_bf16(v0[0], v0[1]); w.y = cvt_pk_bf16(v0[2], v0[3]); w.z = cvt_pk_bf16(v1[0], v1[1]); w.w = cvt_pk_bf16(v1[2], v1[3]);
                    *(u32x4*)(O + (off0 + (unsigned)((ai * HALF + m * 16) * ldc + bj * HALF))) = w; }
    }
};
struct EpiQKV {
    static constexpr bool PERM = true, AFTER_DRAIN = false;
    bf16_t* O;
    __device__ __forceinline__ void operator()(const f32x4 (&acc)[2][2][4][2], const Unit& u, int wr, int wc, int fr, int fq) const {
        const int t = u.pn >> 2, hp = u.pn & 3; const int m0 = u.pm * BM, b = m0 >> 12, s0 = (m0 & 4095) + wr * 64 + fr;
        const size_t TS = (size_t)16384 * 1024; const int slot = t == 0 ? 0 : (t == 1 ? 1 : (t == 2 ? 4 : t + 4)); const bool three = (t == 1 || t == 2);
        bf16_t* base = O + (size_t)slot * TS + wc * 32 + 8 * fq;
#pragma unroll
        for (int ai = 0; ai < 2; ++ai)
#pragma unroll
            for (int m = 0; m < 4; ++m) { const int s = s0 + ai * HALF + m * 16;
#pragma unroll
                for (int bj = 0; bj < 2; ++bj) { const f32x4 v0 = acc[ai][bj][m][0], v1 = acc[ai][bj][m][1];
                    u32x4 w; w.x = cvt_pk_bf16(v0[0], v0[1]); w.y = cvt_pk_bf16(v0[2], v0[3]); w.z = cvt_pk_bf16(v1[0], v1[1]); w.w = cvt_pk_bf16(v1[2], v1[3]);
                    const size_t hb = (size_t)((b * 8 + 2 * hp + bj) * 4096);
                    *(u32x4*)(base + (hb + s) * 128) = w;
                    if (three) { *(u32x4*)(base + TS + (hb + (s & 3) * 1024 + (s >> 2)) * 128) = w; *(u32x4*)(base + 2 * TS + (hb + (s & 15) * 256 + (s >> 4)) * 128) = w; } } }
    }
};
struct EpiResF32 {
    static constexpr bool PERM = false, AFTER_DRAIN = false;
    const float* base; float* out; int ldc;
    __device__ __forceinline__ void operator()(const f32x4 (&acc)[2][2][4][2], const Unit& u, int wr, int wc, int fr, int fq) const {
        const int row0 = u.pm * BM + wr * 64 + fr, col0 = u.pn * BM + wc * 32 + 4 * fq;
#pragma unroll
        for (int ai = 0; ai < 2; ++ai) {
            f32x4 bs[4][2][2];
#pragma unroll
            for (int m = 0; m < 4; ++m) { const size_t off = (size_t)(row0 + ai * HALF + m * 16) * ldc + col0;
#pragma unroll
                for (int bj = 0; bj < 2; ++bj)
#pragma unroll
                    for (int n = 0; n < 2; ++n) bs[m][bj][n] = *(const f32x4*)(base + off + bj * HALF + n * 16); }
#pragma unroll
            for (int m = 0; m < 4; ++m) { const size_t off = (size_t)(row0 + ai * HALF + m * 16) * ldc + col0;
#pragma unroll
                for (int bj = 0; bj < 2; ++bj)
#pragma unroll
                    for (int n = 0; n < 2; ++n) *(f32x4*)(out + off + bj * HALF + n * 16) = bs[m][bj][n] + acc[ai][bj][m][n]; }
            asm volatile("" ::: "memory"); }
    }
};
__device__ __forceinline__ float silu_mul(float g, float u) { return g * u * __builtin_amdgcn_rcpf(1.0f + __builtin_amdgcn_exp2f(g * -1.4426950408889634f)); }
struct EpiSwiGLU {
    static constexpr bool PERM = true, AFTER_DRAIN = false;
    bf16_t* O; int ldc; int tpe;
    __device__ __forceinline__ void operator()(const f32x4 (&acc)[2][2][4][2], const Unit& u, int wr, int wc, int fr, int fq) const {
        const int row0 = u.pm * BM + wr * 64 + fr, col0 = (u.pn % tpe) * HALF + wc * 32 + 8 * fq;
#pragma unroll
        for (int ai = 0; ai < 2; ++ai)
#pragma unroll
            for (int m = 0; m < 4; ++m) { bf16_t* rowp = O + (size_t)(row0 + ai * HALF + m * 16) * ldc + col0;
                const f32x4 g0 = acc[ai][0][m][0], g1 = acc[ai][0][m][1], u0 = acc[ai][1][m][0], u1 = acc[ai][1][m][1];
                u32x4 w; w.x = cvt_pk_bf16(silu_mul(g0[0], u0[0]), silu_mul(g0[1], u0[1])); w.y = cvt_pk_bf16(silu_mul(g0[2], u0[2]), silu_mul(g0[3], u0[3]));
                w.z = cvt_pk_bf16(silu_mul(g1[0], u1[0]), silu_mul(g1[1], u1[1])); w.w = cvt_pk_bf16(silu_mul(g1[2], u1[2]), silu_mul(g1[3], u1[3]));
                *(u32x4*)rowp = w; }
    }
};

__device__ __forceinline__ unsigned pk4_fp8(float a, float b, float c, float d) {
    a = __builtin_amdgcn_fmed3f(a, -448.f, 448.f); b = __builtin_amdgcn_fmed3f(b, -448.f, 448.f); c = __builtin_amdgcn_fmed3f(c, -448.f, 448.f); d = __builtin_amdgcn_fmed3f(d, -448.f, 448.f);
    int p = __builtin_amdgcn_cvt_pk_fp8_f32(a, b, 0, false); p = __builtin_amdgcn_cvt_pk_fp8_f32(c, d, p, true); return (unsigned)p;
}
struct EpiSwiGLU8 {
    static constexpr bool PERM = true, AFTER_DRAIN = false;
    unsigned char* O; int ldc; int tpe; float in_scale, out_scale;
    __device__ __forceinline__ void operator()(const f32x4 (&acc)[2][2][4][2], const Unit& u, int wr, int wc, int fr, int fq) const {
        const int row0 = u.pm * BM + wr * 64 + fr, col0 = (u.pn % tpe) * HALF + wc * 32 + 8 * fq;
#pragma unroll
        for (int ai = 0; ai < 2; ++ai)
#pragma unroll
            for (int m = 0; m < 4; ++m) { unsigned char* rowp = O + (size_t)(row0 + ai * HALF + m * 16) * ldc + col0;
                const f32x4 g0 = acc[ai][0][m][0] * in_scale, g1 = acc[ai][0][m][1] * in_scale, u0 = acc[ai][1][m][0] * (in_scale * out_scale), u1 = acc[ai][1][m][1] * (in_scale * out_scale);
                u32x2 w; w.x = pk4_fp8(silu_mul(g0[0], u0[0]), silu_mul(g0[1], u0[1]), silu_mul(g0[2], u0[2]), silu_mul(g0[3], u0[3]));
                w.y = pk4_fp8(silu_mul(g1[0], u1[0]), silu_mul(g1[1], u1[1]), silu_mul(g1[2], u1[2]), silu_mul(g1[3], u1[3]));
                *(u32x2*)rowp = w; }
    }
};
struct GroupedOrder {
    int nM, nN, nwg, G, c; int tb[9];
    __device__ __forceinline__ void init(int RT, int nN_, int G_, int c_) { nM = RT; nN = nN_; nwg = nM * nN; G = G_; c = c_; }
    __device__ __forceinline__ bool next(int i, Unit& u) const {
        const long L = (long)i * G + c; if (L >= nwg) return false;
        int wgid = (int)L; { const int q = nwg / NXCD, r = nwg % NXCD, xcd = wgid % NXCD, off = wgid / NXCD; wgid = (xcd < r ? xcd * (q + 1) : r * (q + 1) + (xcd - r) * q) + off; }
        const int nig = WGM * nN, gid = wgid / nig, fm = gid * WGM, gsz = (nM - fm) < WGM ? (nM - fm) : WGM;
        const int pm = fm + ((wgid % nig) % gsz), pn = (wgid % nig) / gsz; int e = 0;
#pragma unroll
        for (int k = 1; k < 8; ++k) e += (pm >= tb[k]) ? 1 : 0;
        u.pm = pm; u.pn = e * nN + pn; return true;
    }
    __device__ __forceinline__ void a_ready(const Unit&) const {}
    __device__ __forceinline__ void done(const Unit&) const {}
};
template <class Epi, class Sched, bool ALIGN_EPI = false, bool SP2 = false, bool F8 = false>
__device__ __forceinline__ void gemm_phase(PG8_LAS unsigned char* lds, const Gemm g, const Sched& S, const Epi& E, const int tid) {
    const int wid = __builtin_amdgcn_readfirstlane(tid >> 6), lane = tid & 63, wr = wid >> 2, wc = wid & 3, fr = lane & 15, fq = lane >> 4;
    const int K = g.K, nt = K / BK;
    unsigned voffA[2], voffB[2];
#pragma unroll
    for (int i = 0; i < 2; ++i) { int R, C; stage_rc(tid * 16 + i * 8192, R, C); const int Rb = Epi::PERM ? ((R & ~31) + perm32(R & 31)) : R;
        voffA[i] = (unsigned)(R * K + C) * 2u; voffB[i] = (unsigned)(Rb * K + C) * 2u; }
    const size_t kstep = (size_t)(BK * 2);
    const size_t hstep = (size_t)HALF * K * 2;
    const size_t tstep = 2 * hstep;
    const unsigned ldsw = (unsigned)wid * 1024u;
    const unsigned ldsb = (unsigned)__builtin_amdgcn_readfirstlane((int)((unsigned)(size_t)lds + ldsw));
    const int aoff = lds_byte(wr * 64 + fr, fq * 8), boff = lds_byte(wc * 32 + fr, fq * 8);
#define PG8_SA(b, h) (((b) * 2 + (h)) * HTB)
#define PG8_SB(b, h) ((4 + (b) * 2 + (h)) * HTB)
#define PG8_STAGE(bufoff, gbase, voff) do { _Pragma("unroll") for (int _i = 0; _i < 2; ++_i) { unsigned _keep; \
        asm volatile("s_mov_b32 %0, m0\n\ts_mov_b32 m0, %3\n\ts_nop 0\n\tglobal_load_lds_dwordx4 %1, %2\n\ts_mov_b32 m0, %0" : "=&s"(_keep) : "v"((voff)[_i]), "s"((const char*)(gbase)), "s"(ldsb + (unsigned)((bufoff) + _i * 8192)) : "memory"); } } while (0)
#define PG8_LDA(dst, b, h) do { _Pragma("unroll") for (int m = 0; m < 4; ++m) _Pragma("unroll") for (int k = 0; k < 2; ++k) dst[m][k] = *(const PG8_LAS bf16x8*)(lds + PG8_SA(b, h) + aoff + m * 2048 + k * 1024); } while (0)
#define PG8_LDB(dst, b, h) do { _Pragma("unroll") for (int n = 0; n < 2; ++n) _Pragma("unroll") for (int k = 0; k < 2; ++k) dst[n][k] = *(const PG8_LAS bf16x8*)(lds + PG8_SB(b, h) + boff + n * 2048 + k * 1024); } while (0)
#define PG8_CAT(x) __builtin_bit_cast(v8i32, __builtin_shufflevector(__builtin_bit_cast(i32x4, (x)[0]), __builtin_bit_cast(i32x4, (x)[1]), 0, 1, 2, 3, 4, 5, 6, 7))
#define PG8_MMA(ai, bj, At, Bt) do { __builtin_amdgcn_s_setprio(1); if constexpr (F8) asm volatile("s_nop 4" ::: "memory"); _Pragma("unroll") for (int m = 0; m < 4; ++m) _Pragma("unroll") for (int n = 0; n < 2; ++n) { \
        if constexpr (F8) { asm volatile("v_mfma_scale_f32_16x16x128_f8f6f4 %0, %1, %2, %0, %3, %3 op_sel_hi:[0,0,0]" : "+v"(acc[ai][bj][m][n]) : "v"(PG8_CAT(Bt[n])), "v"(PG8_CAT(At[m])), "v"(f8sc)); } \
        else { _Pragma("unroll") for (int k = 0; k < 2; ++k) acc[ai][bj][m][n] = __builtin_amdgcn_mfma_f32_16x16x32_bf16(Bt[n][k], At[m][k], acc[ai][bj][m][n], 0, 0, 0); } } __builtin_amdgcn_s_setprio(0); } while (0)
#define PG8_WAIT_V(n) asm volatile("s_waitcnt vmcnt(" #n ")" ::: "memory")
#define PG8_WAIT_L(n) asm volatile("s_waitcnt lgkmcnt(" #n ")" ::: "memory")
#define PG8_BAR __builtin_amdgcn_s_barrier()
#define PG8_SCHED __builtin_amdgcn_sched_barrier(0)
    const int f8sc = 0x7f7f7f7f;
    Unit cur, nxt; int ui = 0;
    if (!S.next(0, cur)) return;
    f32x4 acc[2][2][4][2];
#pragma unroll
    for (int a = 0; a < 2; ++a)
#pragma unroll
        for (int b = 0; b < 2; ++b)
#pragma unroll
            for (int m = 0; m < 4; ++m)
#pragma unroll
                for (int n = 0; n < 2; ++n) acc[a][b][m][n] = (f32x4){0.f, 0.f, 0.f, 0.f};
    bf16x8 At[4][2], B0[2][2], B1[2][2];
    const char* cA = (const char*)g.A + (size_t)cur.pm * tstep; const char* cB = (const char*)g.Bt + (size_t)cur.pn * tstep;
    S.a_ready(cur);
    if constexpr (SP2) {
        PG8_STAGE(PG8_SB(0, 0), cB, voffB); PG8_STAGE(PG8_SB(0, 1), cB + hstep, voffB); PG8_STAGE(PG8_SA(0, 0), cA, voffA); PG8_STAGE(PG8_SA(0, 1), cA + hstep, voffA);
        if (wr == 1) PG8_BAR;
        PG8_WAIT_V(2); PG8_BAR;
        PG8_STAGE(PG8_SB(1, 0), cB + kstep, voffB); PG8_STAGE(PG8_SA(1, 0), cA + kstep, voffA); PG8_STAGE(PG8_SB(1, 1), cB + hstep + kstep, voffB);
        PG8_WAIT_V(6); PG8_BAR;
    } else {
        PG8_STAGE(PG8_SB(0, 0), cB, voffB); PG8_STAGE(PG8_SA(0, 0), cA, voffA); PG8_STAGE(PG8_SB(0, 1), cB + hstep, voffB); PG8_STAGE(PG8_SA(0, 1), cA + hstep, voffA);
        if (wr == 1) PG8_BAR;
        PG8_WAIT_V(4); PG8_BAR;
        PG8_STAGE(PG8_SB(1, 0), cB + kstep, voffB); PG8_STAGE(PG8_SA(1, 0), cA + kstep, voffA); PG8_STAGE(PG8_SB(1, 1), cB + hstep + kstep, voffB);
        PG8_WAIT_V(6); PG8_BAR;
    }
    for (;;) {
        const bool has_next = S.next(ui + 1, nxt);
        const char* nA = has_next ? (const char*)g.A + (size_t)nxt.pm * tstep : cA; const char* nB = has_next ? (const char*)g.Bt + (size_t)nxt.pn * tstep : cB;
        for (int t = 0; t < nt; t += 2) {
            const bool last = (t == nt - 2);
            const char* a1 = cA + (size_t)(t + 1) * kstep;
            const char* a2 = last ? nA : cA + (size_t)(t + 2) * kstep; const char* b2 = last ? nB : cB + (size_t)(t + 2) * kstep;
            const char* a3 = a2 + kstep; const char* b3 = b2 + kstep;
            if (last && has_next) S.a_ready(nxt);
            if constexpr (SP2) {
            PG8_LDB(B0, 0, 0); PG8_LDB(B1, 0, 1); PG8_SCHED; PG8_LDA(At, 0, 0); PG8_STAGE(PG8_SA(1, 1), a1 + hstep, voffA);
            PG8_WAIT_V(8); PG8_WAIT_L(0); PG8_BAR; PG8_MMA(0, 0, At, B0); PG8_MMA(0, 1, At, B1); PG8_BAR; PG8_SCHED;
            PG8_LDA(At, 0, 1); PG8_STAGE(PG8_SB(0, 0), b2, voffB); PG8_STAGE(PG8_SB(0, 1), b2 + hstep, voffB); PG8_STAGE(PG8_SA(0, 0), a2, voffA);
            PG8_WAIT_V(8); PG8_WAIT_L(0); PG8_BAR; PG8_MMA(1, 0, At, B0); PG8_MMA(1, 1, At, B1); PG8_BAR; PG8_SCHED;
            PG8_LDB(B0, 1, 0); PG8_LDB(B1, 1, 1); PG8_SCHED; PG8_LDA(At, 1, 0); PG8_STAGE(PG8_SA(0, 1), a2 + hstep, voffA);
            PG8_WAIT_V(8); PG8_WAIT_L(0); PG8_BAR; PG8_MMA(0, 0, At, B0); PG8_MMA(0, 1, At, B1); PG8_BAR; PG8_SCHED;
            PG8_LDA(At, 1, 1); PG8_STAGE(PG8_SB(1, 0), b3, voffB); PG8_STAGE(PG8_SB(1, 1), b3 + hstep, voffB); PG8_STAGE(PG8_SA(1, 0), a3, voffA);
            PG8_WAIT_V(8); PG8_WAIT_L(0); PG8_BAR; PG8_MMA(1, 0, At, B0); PG8_MMA(1, 1, At, B1); PG8_BAR; PG8_SCHED;
            } else {
            PG8_LDB(B0, 0, 0); PG8_SCHED; PG8_LDA(At, 0, 0); PG8_STAGE(PG8_SA(1, 1), a1 + hstep, voffA);
            PG8_WAIT_L(8); PG8_BAR; PG8_WAIT_L(0); PG8_MMA(0, 0, At, B0); PG8_BAR; PG8_SCHED;
            PG8_LDB(B1, 0, 1); PG8_STAGE(PG8_SB(0, 0), b2, voffB);
            PG8_BAR; PG8_WAIT_L(0); PG8_MMA(0, 1, At, B1); PG8_BAR;
            PG8_LDA(At, 0, 1); PG8_STAGE(PG8_SA(0, 0), a2, voffA);
            PG8_BAR; PG8_WAIT_L(0); PG8_MMA(1, 0, At, B0); PG8_BAR; PG8_SCHED;
            PG8_STAGE(PG8_SB(0, 1), b2 + hstep, voffB);
            PG8_WAIT_V(6); PG8_BAR; PG8_MMA(1, 1, At, B1); PG8_BAR;
            PG8_LDB(B0, 1, 0); PG8_SCHED; PG8_LDA(At, 1, 0); PG8_STAGE(PG8_SA(0, 1), a2 + hstep, voffA);
            PG8_WAIT_L(8); PG8_BAR; PG8_WAIT_L(0); PG8_MMA(0, 0, At, B0); PG8_BAR; PG8_SCHED;
            PG8_LDB(B1, 1, 1); PG8_STAGE(PG8_SB(1, 0), b3, voffB);
            PG8_BAR; PG8_WAIT_L(0); PG8_MMA(0, 1, At, B1); PG8_BAR;
            PG8_LDA(At, 1, 1); PG8_STAGE(PG8_SA(1, 0), a3, voffA);
            PG8_BAR; PG8_WAIT_L(0); PG8_MMA(1, 0, At, B0); PG8_BAR; PG8_SCHED;
            PG8_STAGE(PG8_SB(1, 1), b3 + hstep, voffB);
            PG8_WAIT_V(6); PG8_BAR; PG8_MMA(1, 1, At, B1); PG8_BAR;
            }
        }
        if constexpr (ALIGN_EPI) { if (wr == 0) PG8_BAR; }
        if constexpr (F8) asm volatile("s_nop 15\n\ts_nop 15" ::: "memory");
        if constexpr (!Epi::AFTER_DRAIN) { E(acc, cur, wr, wc, fr, fq); S.done(cur); }
        if (!has_next) break;
#pragma unroll
        for (int a = 0; a < 2; ++a)
#pragma unroll
            for (int b = 0; b < 2; ++b)
#pragma unroll
                for (int m = 0; m < 4; ++m)
#pragma unroll
                    for (int n = 0; n < 2; ++n) acc[a][b][m][n] = (f32x4){0.f, 0.f, 0.f, 0.f};
        cur = nxt; cA = nA; cB = nB; ++ui;
        if constexpr (ALIGN_EPI) { if (wr == 1) PG8_BAR; }
    }
    PG8_WAIT_V(0);
    if constexpr (!ALIGN_EPI) { if (wr == 0) PG8_BAR; }
    PG8_BAR;
    if constexpr (Epi::AFTER_DRAIN) { E.fused(acc, cur, wr, wc, fr, fq, lds, wid, lane); S.done(cur); }
#undef PG8_SA
#undef PG8_SB
#undef PG8_STAGE
#undef PG8_LDA
#undef PG8_LDB
#undef PG8_MMA
#undef PG8_CAT
#undef PG8_WAIT_V
#undef PG8_WAIT_L
#undef PG8_BAR
#undef PG8_SCHED
}
}

#define GAS __attribute__((address_space(1)))
#define LAS __attribute__((address_space(3)))
typedef unsigned short bf16_t;
typedef short bf16x8 __attribute__((ext_vector_type(8)));
typedef short s16x4 __attribute__((ext_vector_type(4)));
typedef float f32x4 __attribute__((ext_vector_type(4)));
typedef float f32x16 __attribute__((ext_vector_type(16)));
typedef unsigned u32x4 __attribute__((ext_vector_type(4)));
typedef unsigned u32x2 __attribute__((ext_vector_type(2)));
#define LDS_WAIT() asm volatile("s_waitcnt lgkmcnt(0)" ::: "memory")
#define VM_WAIT() asm volatile("s_waitcnt vmcnt(0)" ::: "memory")
#define SBAR() __builtin_amdgcn_sched_barrier(0)

constexpr int BATCH = 4, SEQ = 4096, T = BATCH * SEQ, D = 2048, NH = 8, HD = 128, DH = NH * HD  , DQKV = 6144;
constexpr int DFF = 5504, DFE = 7168, NE = 8, MOE_ROWS = 2 * T + NE * 256;
constexpr float EPS = 1e-6f;
constexpr int NWAVES = 8, NTHREADS = 512;
constexpr float LOG2E = 1.4426950408889634f, LN2 = 0.6931471805599453f;
constexpr float QSCALE = 0.08838834764831845f;
constexpr float F8_SH = 16.f, F8_SW = 512.f, F8_SACT = 8.f;

constexpr size_t MiB = 1u << 20;
constexpr size_t WS_CTL = 0, CTL_ZERO_BYTES = 1 * MiB;
constexpr size_t WS_BKT = 1 * MiB;
constexpr size_t WS_SEL = 2 * MiB;
constexpr size_t WS_GW = WS_SEL + 256 * 1024;
constexpr size_t WS_POS = WS_GW + 256 * 1024;
constexpr size_t WS_HIST = WS_POS + 256 * 1024;
constexpr size_t WS_MOEINFO = WS_HIST + 64 * 1024;
constexpr size_t WS_LSE = 3 * MiB;
constexpr size_t WS_WI = 8 * MiB;
constexpr size_t WS_WO = WS_WI + 2 * (size_t)DQKV * D * 2;
constexpr size_t WS_WGU_D = WS_WO + 2 * (size_t)D * D * 2;
constexpr size_t WS_WD_D = WS_WGU_D + (size_t)2 * DFF * D * 2;
constexpr size_t WS_WGU_M = WS_WD_D + (size_t)D * DFF * 2 + 512 * 1024;
constexpr size_t WS_WD_M = WS_WGU_M + (size_t)NE * 2 * DFE * D;
constexpr size_t WS_X = WS_WD_M + (size_t)NE * D * DFE;
constexpr size_t WS_H = WS_X + (size_t)T * D * 4;
constexpr size_t WS_R = WS_H + (size_t)T * D * 2;
constexpr size_t WS_QKV = WS_R;
constexpr size_t WS_OD = WS_QKV + (size_t)10 * T * DH * 2;
constexpr size_t WS_OS = WS_OD + (size_t)3 * T * DH * 2;
constexpr size_t WS_O = WS_OS + (size_t)T * DH * 2;
constexpr size_t WS_DELTA = WS_R + 256 * MiB;
constexpr size_t WS_ACT = WS_R;
constexpr size_t WS_AS = WS_R + (size_t)MOE_ROWS * D * 2;
constexpr size_t WS_ACTM = WS_AS + (size_t)MOE_ROWS * D;
constexpr size_t WS_Y = WS_R;
constexpr size_t WS_END_MOE = WS_ACTM + (size_t)MOE_ROWS * DFE, WS_END_ATT = WS_O + (size_t)T * D * 2, WS_END = WS_END_MOE > WS_END_ATT ? WS_END_MOE : WS_END_ATT;
static_assert(WS_ACT + (size_t)T * DFF * 2 <= WS_END, "region R");
static_assert(WS_END <= 1879048192ull, "workspace");
static_assert(WS_WI % 256 == 0 && WS_WO % 256 == 0 && WS_WGU_D % 256 == 0 && WS_WD_D % 256 == 0 && WS_WGU_M % 256 == 0 && WS_WD_M % 256 == 0 && WS_X % 256 == 0 && WS_H % 256 == 0 && WS_R % 256 == 0 && WS_ACTM % 256 == 0, "alignment");
constexpr int CW_BAR = 4096;
constexpr int CW_VCU = 8192;

constexpr int SCR_BYTES = 133120;
constexpr int TBL_OFF = SCR_BYTES, TBL_N = 200, TBL_BYTES = 3 * NH * TBL_N * 4;
constexpr int MISC_OFF = 152576;
constexpr int LDS_BYTES = 155648;
static_assert(TBL_OFF + TBL_BYTES <= MISC_OFF && MISC_OFF + 3072 <= LDS_BYTES, "LDS map");

#define XB_TMO      128
#define XB_XCNT(j)  (256  + 64 * (j))
#define XB_XSUB(j)  (1280 + 64 * (j))
#define XB_XGEN(j)  (2304 + 64 * (j))
#define XB_TOP      3328
#define XB_TOPGEN   3392
#define XCD_BAR_WORDS 3456
#define XB_SPIN_CAP (1u << 20)
__device__ __forceinline__ unsigned xb_ld(unsigned* p)              { return __hip_atomic_load(p, __ATOMIC_RELAXED, __HIP_MEMORY_SCOPE_AGENT); }
__device__ __forceinline__ unsigned xb_add(unsigned* p, unsigned v) { return __hip_atomic_fetch_add(p, v, __ATOMIC_RELAXED, __HIP_MEMORY_SCOPE_AGENT); }
__device__ __forceinline__ unsigned xb_xcc_id() { return (unsigned)__builtin_amdgcn_s_getreg((3 << 11) | 20) & 0xFu; }
#define XB_SPIN(cond, bar) do { unsigned _sp = 0; while (cond) { __builtin_amdgcn_s_sleep(1); \
    if ((++_sp & 255u) == 0u) { if (xb_ld(&(bar)[XB_TMO])) break; if (_sp > XB_SPIN_CAP) { atomicAdd(&(bar)[XB_TMO], 1u); break; } } } } while (0)
struct XcdBarrier { unsigned* bar; unsigned x; volatile LAS unsigned* st; };
__device__ __forceinline__ XcdBarrier xcd_barrier_post(unsigned* bar, volatile LAS unsigned* st) {
    XcdBarrier b; b.bar = bar; b.x = xb_xcc_id(); b.st = st;
    if (threadIdx.x == 0) (void)xb_add(&bar[XB_XCNT(b.x)], 1u);
    return b;
}
__device__ __forceinline__ void xcd_barrier_complete(unsigned* bar, unsigned x, unsigned& nloc, unsigned& nx) {
    const unsigned G = gridDim.x * gridDim.y * gridDim.z;
    unsigned sum, cnt, mine, sp = 0u;
    for (;;) {
        sum = 0u; cnt = 0u; mine = 0u;
#pragma unroll
        for (unsigned j = 0; j < 16; ++j) { const unsigned c = xb_ld(&bar[XB_XCNT(j)]); sum += c; cnt += (c > 0u) ? 1u : 0u; mine = (j == x) ? c : mine; }
        if (sum == G) break;
        __builtin_amdgcn_s_sleep(1);
        if ((++sp & 255u) == 0u) { if (xb_ld(&bar[XB_TMO])) break; if (sp > XB_SPIN_CAP) { atomicAdd(&bar[XB_TMO], 1u); break; } }
    }
    nloc = mine > 0u ? mine : 1u; nx = cnt > 0u ? cnt : 1u;
}
__device__ __forceinline__ void xcd_barrier(const XcdBarrier& b) {
    asm volatile("s_waitcnt vmcnt(0)" ::: "memory");
    __syncthreads();
    if (threadIdx.x == 0) {
        unsigned* bar = b.bar;
        __builtin_amdgcn_s_waitcnt(0);
        unsigned nloc = b.st[0], nx = b.st[1];
        if (nloc == 0u) { xcd_barrier_complete(bar, b.x, nloc, nx); b.st[0] = nloc; b.st[1] = nx; }
        const unsigned old = xb_add(&bar[XB_XSUB(b.x)], 1u);
        const unsigned gen = old / nloc;
        if (old + 1u == (gen + 1u) * nloc) {
            __builtin_amdgcn_fence(__ATOMIC_RELEASE, "agent");
            asm volatile("s_waitcnt vmcnt(0)" ::: "memory");
            const unsigned og = xb_add(&bar[XB_TOP], 1u);
            const unsigned tg = og / nx;
            if (og + 1u == (tg + 1u) * nx) xb_add(&bar[XB_TOPGEN], 1u);
            else XB_SPIN(xb_ld(&bar[XB_TOPGEN]) == tg, bar);
            __builtin_amdgcn_fence(__ATOMIC_ACQUIRE, "agent");
            xb_add(&bar[XB_XGEN(b.x)], 1u);
            asm volatile("s_waitcnt vmcnt(0)" ::: "memory");
        } else {
            XB_SPIN(xb_ld(&bar[XB_XGEN(b.x)]) == gen, bar);
            __builtin_amdgcn_fence(__ATOMIC_ACQUIRE, "agent");
            asm volatile("s_waitcnt vmcnt(0)" ::: "memory");
        }
    }
    __syncthreads();
}

__device__ __forceinline__ unsigned pk2(float lo, float hi) { unsigned r; asm volatile("v_cvt_pk_bf16_f32 %0, %1, %2" : "=v"(r) : "v"(lo), "v"(hi)); return r; }
__device__ __forceinline__ float bf_lo(unsigned w) { return __builtin_bit_cast(float, w << 16); }
__device__ __forceinline__ float bf_hi(unsigned w) { return __builtin_bit_cast(float, w & 0xffff0000u); }
__device__ __forceinline__ float wave_sum(float v) {
#pragma unroll
    for (int o = 1; o < 64; o <<= 1) v += __shfl_xor(v, o);
    return v;
}
__device__ __forceinline__ float dot4(f32x4 a) { return (a.x * a.x + a.y * a.y) + (a.z * a.z + a.w * a.w); }

struct Frame {
    LAS unsigned char* lds; volatile LAS unsigned* MISC;
    int tid, lane, wave, gw, G;
};

__device__ __forceinline__ void tr_item(const float* __restrict__ W, int K, int N, bf16_t* __restrict__ WT, int mode, LAS float* scr, int item, int lane) {
    const int nblk = N >> 6, kb = item / nblk, nb = item - kb * nblk, k0 = kb << 6, n0 = nb << 6;
    f32x4 v[16];
    const float* src = W + (size_t)(k0 + (lane >> 4)) * N + n0 + 4 * (lane & 15);
#pragma unroll
    for (int i = 0; i < 16; ++i) v[i] = __builtin_nontemporal_load((const f32x4*)(src + (size_t)(4 * i) * N));
#pragma unroll
    for (int i = 0; i < 16; ++i) { LAS float* d = scr + (4 * i + (lane >> 4)) * 65 + 4 * (lane & 15); d[0] = v[i][0]; d[1] = v[i][1]; d[2] = v[i][2]; d[3] = v[i][3]; }
    LDS_WAIT();
    const int c = lane & 7;
#pragma unroll
    for (int p = 0; p < 8; ++p) { const int n = (lane >> 3) + 8 * p; const LAS float* s = scr + (8 * c) * 65 + n;
        u32x4 o; o.x = pk2(s[0], s[65]); o.y = pk2(s[130], s[195]); o.z = pk2(s[260], s[325]); o.w = pk2(s[390], s[455]);
        const int nn = n0 + n; const int row = mode == 0 ? nn : (((nn >> 7) << 8) + (nn & 127) + (mode == 2 ? 128 : 0));
        *(u32x4*)(WT + (size_t)row * K + k0 + 8 * c) = o; }
    LDS_WAIT();
}
__device__ __forceinline__ void tr_item8(const float* __restrict__ W, int K, int N, unsigned char* __restrict__ WT, int mode, LAS float* scr, int item, int lane) {
    const int nblk = N >> 6, kb = item / nblk, nb = item - kb * nblk, k0 = kb << 6, n0 = nb << 6;
    f32x4 v[16];
    const float* src = W + (size_t)(k0 + (lane >> 4)) * N + n0 + 4 * (lane & 15);
#pragma unroll
    for (int i = 0; i < 16; ++i) v[i] = __builtin_nontemporal_load((const f32x4*)(src + (size_t)(4 * i) * N));
#pragma unroll
    for (int i = 0; i < 16; ++i) { LAS float* d = scr + (4 * i + (lane >> 4)) * 65 + 4 * (lane & 15); d[0] = v[i][0]; d[1] = v[i][1]; d[2] = v[i][2]; d[3] = v[i][3]; }
    LDS_WAIT();
    const int c = lane & 7;
#pragma unroll
    for (int p = 0; p < 8; ++p) { const int n = (lane >> 3) + 8 * p; const LAS float* s = scr + (8 * c) * 65 + n;
        u32x2 o; o.x = pg8::pk4_fp8(s[0] * F8_SW, s[65] * F8_SW, s[130] * F8_SW, s[195] * F8_SW); o.y = pg8::pk4_fp8(s[260] * F8_SW, s[325] * F8_SW, s[390] * F8_SW, s[455] * F8_SW);
        const int nn = n0 + n; const int row = mode == 0 ? nn : (((nn >> 7) << 8) + (nn & 127) + (mode == 2 ? 128 : 0));
        *(u32x2*)(WT + (size_t)row * K + k0 + 8 * c) = o; }
    LDS_WAIT();
}
__device__ __forceinline__ void rms_row_bf16(const float* xrow, const float* g, bf16_t* orow, int lane) {
    const f32x4* xr = (const f32x4*)xrow + lane; const f32x4* gr = (const f32x4*)g + lane;
    f32x4 v[8]; float ss = 0.f;
#pragma unroll
    for (int j = 0; j < 8; ++j) { v[j] = xr[64 * j]; ss += dot4(v[j]); }
    const float rstd = 1.0f / sqrtf(wave_sum(ss) * (1.0f / D) + EPS);
    u32x2* o8 = (u32x2*)orow + lane;
#pragma unroll
    for (int j = 0; j < 8; ++j) { const f32x4 gg = gr[64 * j]; u32x2 w; w.x = pk2(v[j].x * rstd * gg.x, v[j].y * rstd * gg.y); w.y = pk2(v[j].z * rstd * gg.z, v[j].w * rstd * gg.w); o8[64 * j] = w; }
}
__device__ __forceinline__ void res_rms_row_bf16(const float* xsrc, const bf16_t* drow, float* xout, const float* g, bf16_t* orow, int lane) {
    const f32x4* xr = (const f32x4*)xsrc + lane; const u32x2* dr = (const u32x2*)drow + lane; const f32x4* gr = (const f32x4*)g + lane; f32x4* xo = (f32x4*)xout + lane;
    f32x4 v[8]; float ss = 0.f;
#pragma unroll
    for (int j = 0; j < 8; ++j) { const f32x4 a = xr[64 * j]; const u32x2 d = dr[64 * j]; v[j] = (f32x4){a.x + bf_lo(d.x), a.y + bf_hi(d.x), a.z + bf_lo(d.y), a.w + bf_hi(d.y)}; xo[64 * j] = v[j]; ss += dot4(v[j]); }
    const float rstd = 1.0f / sqrtf(wave_sum(ss) * (1.0f / D) + EPS);
    u32x2* o8 = (u32x2*)orow + lane;
#pragma unroll
    for (int j = 0; j < 8; ++j) { const f32x4 gg = gr[64 * j]; u32x2 w; w.x = pk2(v[j].x * rstd * gg.x, v[j].y * rstd * gg.y); w.y = pk2(v[j].z * rstd * gg.z, v[j].w * rstd * gg.w); o8[64 * j] = w; }
}
__device__ __forceinline__ int t5_bucket(int n) {
    if (n < 16) return n;
    int b = 16 + (int)(log((double)n / 16.0) / log(128.0) * 16.0);
    return b < 31 ? b : 31;
}

__device__ __forceinline__ void dma_tile_k(const bf16_t* base, size_t row_stride_bytes, LAS unsigned char* dst, const unsigned (&voff)[4]) {
#pragma unroll
    for (int i = 0; i < 8; ++i) {
        const char* ub = (const char*)base + (size_t)(4 * i) * row_stride_bytes;
        __builtin_amdgcn_global_load_lds((const unsigned*)(ub + voff[i & 3]), (LAS unsigned*)(dst + i * 1024), 16, 0, 0);
    }
}
__device__ __forceinline__ void dma_tile_v(const bf16_t* base, size_t row_stride_bytes, LAS unsigned char* dst, unsigned voff) {
#pragma unroll
    for (int i = 0; i < 8; ++i) {
        const char* ub = (const char*)base + (size_t)(4 * i) * row_stride_bytes;
        __builtin_amdgcn_global_load_lds((const unsigned*)(ub + voff), (LAS unsigned*)(dst + i * 1024), 16, 0, 0);
    }
}
#define TRRD(dst, addr, off) asm volatile("ds_read_b64_tr_b16 %0, %1 offset:%2" : "=&v"(dst) : "v"(addr), "i"(off) : "memory")

template <int MODE>
__device__ __forceinline__ void attn_item(LAS unsigned char* wl, const bf16_t* Qh, int qstride, const bf16_t* Kh, const bf16_t* Vh, bf16_t* Op, int ostride, float* lsep, int lstride,
                                          const LAS float* tb, int qg, int lane) {
    const int c = lane & 31, hi = lane >> 5;
    const int i0 = 32 * qg;
    constexpr size_t rstride = HD;
    bf16x8 qf[8];
    { const bf16_t* qrow = Qh + (size_t)(i0 + c) * qstride + 8 * hi;
#pragma unroll
      for (int s = 0; s < 8; ++s) qf[s] = *(const bf16x8*)(qrow + 16 * s); }
    f32x16 o[4];
#pragma unroll
    for (int b = 0; b < 4; ++b)
#pragma unroll
        for (int r = 0; r < 16; ++r) o[b][r] = 0.f;
    float mx = -1e30f, lsum = 0.f, carry = 0.f;
    const int kt_first = MODE == 0 ? (qg > 4 ? qg - 4 : 0) : qg, kt_last = MODE == 0 ? qg : 0, kstep = MODE == 0 ? 1 : -1;
    LAS unsigned char* Kl = wl; LAS unsigned char* Vl = wl + 8192;
    const LAS unsigned char* kbase = Kl + c * 256;
    unsigned vb[4];
    { const int g = lane >> 4, q = (lane & 15) >> 2, p = lane & 3, h = g >> 1;
#pragma unroll
      for (int b = 0; b < 4; ++b) vb[b] = (unsigned)(uintptr_t)Vl + (4 * h + q) * 256 + (((4 * b + 2 * (g & 1) + (p >> 1)) ^ (q << 2)) << 4) + 8 * (p & 1); }
    unsigned voffk[4], voffv;
    { const int rr = lane >> 4, p = lane & 15;
#pragma unroll
      for (int i = 0; i < 4; ++i) voffk[i] = (unsigned)(rr * (int)rstride * 2 + ((p ^ ((4 * i + rr) & 15)) << 4));
      voffv = (unsigned)(rr * (int)rstride * 2 + ((p ^ (rr << 2)) << 4)); }
    dma_tile_k(Kh + (size_t)(32 * kt_first) * rstride, rstride * 2, Kl, voffk);
    dma_tile_v(Vh + (size_t)(32 * kt_first) * rstride, rstride * 2, Vl, voffv);
    bool early = false;
    for (int kt = kt_first;; kt += kstep) {
        const bool has_next = (kt != kt_last);
        const int j0 = 32 * kt;
        asm volatile("s_waitcnt vmcnt(8)" ::: "memory");
        f32x16 S;
#pragma unroll
        for (int r = 0; r < 16; ++r) S[r] = 0.f;
#pragma unroll
        for (int s = 0; s < 8; ++s) {
            const bf16x8 kf = *(const LAS bf16x8*)(kbase + ((((2 * s + hi) ^ (c & 15))) << 4));
            S = __builtin_amdgcn_mfma_f32_32x32x16_bf16(kf, qf[s], S, 0, 0, 0);
        }
        asm volatile("" ::: "memory");
        if (has_next) dma_tile_k(Kh + (size_t)(j0 + 32 * kstep) * rstride, rstride * 2, Kl, voffk);
        bf16x8 pb[2];
        if constexpr (MODE == 0) {
            const int a = 160 - (i0 - j0) - c + 4 * hi;
            const LAS float* tp = tb + a;
            float x[16]; float pm = -3e38f;
#pragma unroll
            for (int r = 0; r < 16; ++r) { x[r] = fmaf(S[r], QSCALE * LOG2E, tp[8 * (r >> 2) + (r & 3)]); pm = fmaxf(pm, x[r]); }
            { auto rr = __builtin_amdgcn_permlane32_swap(__float_as_uint(pm), __float_as_uint(pm), false, false); pm = fmaxf(__uint_as_float(rr[0]), __uint_as_float(rr[1])); }
            const float mn = fmaxf(mx, pm); const float alpha = __builtin_amdgcn_exp2f(mx - mn); mx = mn;
            float ps = 0.f;
#pragma unroll
            for (int r = 0; r < 16; ++r) { x[r] = __builtin_amdgcn_exp2f(x[r] - mn); ps += x[r]; }
            { auto rr = __builtin_amdgcn_permlane32_swap(__float_as_uint(ps), __float_as_uint(ps), false, false); ps = __uint_as_float(rr[0]) + __uint_as_float(rr[1]); }
            lsum = lsum * alpha + ps;
            if (__any(alpha < 1.f)) {
#pragma unroll
                for (int b = 0; b < 4; ++b)
#pragma unroll
                    for (int r = 0; r < 16; ++r) o[b][r] *= alpha;
            }
#pragma unroll
            for (int s = 0; s < 2; ++s) { u32x4 w; w.x = pk2(x[8 * s], x[8 * s + 1]); w.y = pk2(x[8 * s + 2], x[8 * s + 3]); w.z = pk2(x[8 * s + 4], x[8 * s + 5]); w.w = pk2(x[8 * s + 6], x[8 * s + 7]); pb[s] = __builtin_bit_cast(bf16x8, w); }
        } else {
            const bool diag = (j0 == i0);
            float lk[16], ls[16];
#pragma unroll
            for (int r = 0; r < 16; ++r) {
                const float z = S[r] * QSCALE; const float az = fabsf(z);
                const float sp = fmaxf(z, 0.f) + LN2 * __builtin_amdgcn_logf(1.0f + __builtin_amdgcn_exp2f(-az * LOG2E));
                const int key = 8 * (r >> 2) + 4 * hi + (r & 3);
                const bool valid = !diag || key < c;
                lk[r] = valid ? -sp : 0.f; ls[r] = valid ? (z - sp) : -1e30f;
            }
            float gs[4];
#pragma unroll
            for (int g = 0; g < 4; ++g) gs[g] = (lk[4 * g] + lk[4 * g + 1]) + (lk[4 * g + 2] + lk[4 * g + 3]);
            float pg[4];
#pragma unroll
            for (int g = 0; g < 4; ++g) { auto rr = __builtin_amdgcn_permlane32_swap(__float_as_uint(gs[g]), __float_as_uint(gs[g]), false, false); pg[g] = hi ? __uint_as_float(rr[0]) : __uint_as_float(rr[1]); }
            float suf[4]; float run = carry;
#pragma unroll
            for (int g = 3; g >= 0; --g) { if (hi == 0) { suf[g] = run + pg[g]; run = suf[g] + gs[g]; } else { suf[g] = run; run = run + gs[g] + pg[g]; } }
            float av[16];
#pragma unroll
            for (int g = 0; g < 4; ++g) { float lt = suf[g];
#pragma unroll
                for (int e = 3; e >= 0; --e) { av[4 * g + e] = __builtin_amdgcn_exp2f((ls[4 * g + e] + lt) * LOG2E); lt += lk[4 * g + e]; } }
            carry = run;
            early = __all(carry < -105.f);
#pragma unroll
            for (int s = 0; s < 2; ++s) { u32x4 w; w.x = pk2(av[8 * s], av[8 * s + 1]); w.y = pk2(av[8 * s + 2], av[8 * s + 3]); w.z = pk2(av[8 * s + 4], av[8 * s + 5]); w.w = pk2(av[8 * s + 6], av[8 * s + 7]); pb[s] = __builtin_bit_cast(bf16x8, w); }
        }
        if (has_next) asm volatile("s_waitcnt vmcnt(8)" ::: "memory"); else asm volatile("s_waitcnt vmcnt(0)" ::: "memory");
#pragma unroll
        for (int b = 0; b < 4; ++b) {
            s16x4 l0, h0, l1, h1;
            TRRD(l0, vb[b], 0); TRRD(h0, vb[b], 2048); TRRD(l1, vb[b], 4096); TRRD(h1, vb[b], 6144);
            asm volatile("s_waitcnt lgkmcnt(0)" ::: "memory"); SBAR();
            o[b] = __builtin_amdgcn_mfma_f32_32x32x16_bf16((bf16x8){l0[0], l0[1], l0[2], l0[3], h0[0], h0[1], h0[2], h0[3]}, pb[0], o[b], 0, 0, 0);
            o[b] = __builtin_amdgcn_mfma_f32_32x32x16_bf16((bf16x8){l1[0], l1[1], l1[2], l1[3], h1[0], h1[1], h1[2], h1[3]}, pb[1], o[b], 0, 0, 0);
        }
        asm volatile("" ::: "memory");
        if (!has_next || (MODE == 1 && early)) break;
        dma_tile_v(Vh + (size_t)(j0 + 32 * kstep) * rstride, rstride * 2, Vl, voffv);
    }
    if (MODE == 1) VM_WAIT();
    const float inv = MODE == 0 ? __builtin_amdgcn_rcpf(lsum) : 1.0f;
    bf16_t* orow = Op + (size_t)(i0 + c) * ostride + 4 * hi;
#pragma unroll
    for (int b = 0; b < 4; ++b)
#pragma unroll
        for (int g = 0; g < 4; ++g) { u32x2 w; w.x = pk2(o[b][4 * g] * inv, o[b][4 * g + 1] * inv); w.y = pk2(o[b][4 * g + 2] * inv, o[b][4 * g + 3] * inv); *(u32x2*)(orow + 32 * b + 8 * g) = w; }
    if (MODE == 0 && hi == 0) lsep[(size_t)(i0 + c) * lstride] = (mx + __builtin_amdgcn_logf(lsum)) * LN2;
}

struct Params { const float* in[16]; float* out; unsigned char* ws; int ph_lo, ph_hi; };
enum { IN_X = 0, IN_RELB, IN_ANG, IN_WIN, IN_GDIL, IN_GSB, IN_WO, IN_FNG, IN_DWG, IN_DWU, IN_DWD, IN_RW, IN_MWG, IN_MWU, IN_MWD, IN_FING };
constexpr int N_PHASES = 18;

typedef const __attribute__((address_space(4))) Params* KPtr;
__device__ __forceinline__ KPtr kparams() { KPtr p = (KPtr)__builtin_amdgcn_kernarg_segment_ptr(); asm volatile("" : "+s"(p)); return p; }
#define WSP(T, off) ((T)(ws + (off)))
__device__ __forceinline__ Frame make_frame() {
    Frame F; int t = threadIdx.x; asm volatile("" : "+v"(t));
    extern __shared__ __attribute__((aligned(16))) unsigned char lds_raw[];
    F.lds = (LAS unsigned char*)lds_raw; F.MISC = (volatile LAS unsigned*)(F.lds + MISC_OFF);
    F.tid = t; F.lane = t & 63; F.wave = __builtin_amdgcn_readfirstlane(t >> 6); F.G = gridDim.x; F.gw = blockIdx.x * NWAVES + F.wave;
    return F;
}
#define PHASE_ARGS() KPtr kp = kparams(); unsigned char* const ws = kp->ws; (void)ws; const Frame F = make_frame(); const int NGW = F.G * NWAVES; (void)NGW


constexpr int I_WI = (D / 64) * (DQKV / 64), I_WO = (D / 64) * (D / 64), I_DG = (D / 64) * (DFF / 64), I_DD = (DFF / 64) * (D / 64), I_MG = (D / 64) * (DFE / 64), I_MD = (DFE / 64) * (D / 64);
constexpr int CONV_A = I_WI + I_WO + 2 * I_DG + I_DD;
constexpr int CONV_B = I_WI + I_WO + NE * (2 * I_MG + I_MD);
static_assert(CONV_B % 2 == 0, "deferred conversion split");
__device__ __forceinline__ void conv_item(KPtr kp, unsigned char* ws, int it, LAS float* scr, int lane) {
    int r = it;
    if (r < CONV_A) {
        if (r < I_WI) { tr_item(kp->in[IN_WIN], D, DQKV, WSP(bf16_t*, WS_WI), 0, scr, r, lane); return; } r -= I_WI;
        if (r < I_WO) { tr_item(kp->in[IN_WO], D, D, WSP(bf16_t*, WS_WO), 0, scr, r, lane); return; } r -= I_WO;
        if (r < I_DG) { tr_item(kp->in[IN_DWG], D, DFF, WSP(bf16_t*, WS_WGU_D), 1, scr, r, lane); return; } r -= I_DG;
        if (r < I_DG) { tr_item(kp->in[IN_DWU], D, DFF, WSP(bf16_t*, WS_WGU_D), 2, scr, r, lane); return; } r -= I_DG;
        tr_item(kp->in[IN_DWD], DFF, D, WSP(bf16_t*, WS_WD_D), 0, scr, r, lane); return;
    }
    r -= CONV_A;
    if (r < I_WI) { tr_item(kp->in[IN_WIN] + (size_t)D * DQKV, D, DQKV, WSP(bf16_t*, WS_WI) + (size_t)DQKV * D, 0, scr, r, lane); return; } r -= I_WI;
    if (r < I_WO) { tr_item(kp->in[IN_WO] + (size_t)D * D, D, D, WSP(bf16_t*, WS_WO) + (size_t)D * D, 0, scr, r, lane); return; } r -= I_WO;
    if (r < NE * I_MG) { const int e = r / I_MG; tr_item8(kp->in[IN_MWG] + (size_t)e * D * DFE, D, DFE, WSP(unsigned char*, WS_WGU_M) + (size_t)e * 2 * DFE * D, 1, scr, r - e * I_MG, lane); return; } r -= NE * I_MG;
    if (r < NE * I_MG) { const int e = r / I_MG; tr_item8(kp->in[IN_MWU] + (size_t)e * D * DFE, D, DFE, WSP(unsigned char*, WS_WGU_M) + (size_t)e * 2 * DFE * D, 2, scr, r - e * I_MG, lane); return; } r -= NE * I_MG;
    { const int e = r / I_MD; tr_item8(kp->in[IN_MWD] + (size_t)e * DFE * D, DFE, D, WSP(unsigned char*, WS_WD_M) + (size_t)e * D * DFE, 0, scr, r - e * I_MD, lane); }
}

__global__ void __launch_bounds__(NTHREADS, 2) mega_fwd(Params P) {
    const Frame F0 = make_frame();
    unsigned* ctl = (unsigned*)(P.ws + WS_CTL);
    for (int u = F0.tid; u < (LDS_BYTES - MISC_OFF) / 4; u += NTHREADS) ((LAS unsigned*)(F0.lds + MISC_OFF))[u] = 0u;
    __syncthreads();
    const int lo = P.ph_lo, hi = P.ph_hi;
    const bool one_phase = (hi - lo) == 1;
    XcdBarrier bar; bar.bar = ctl + CW_BAR; bar.x = 0; bar.st = nullptr;
    if (!one_phase) bar = xcd_barrier_post(ctl + CW_BAR, F0.MISC + 8);
    if (!one_phase && F0.tid == 0) { const unsigned x = xb_xcc_id(); const unsigned r = xb_add(ctl + CW_VCU + 64 * x, 1u); F0.MISC[12] = r; F0.MISC[13] = x; }
    __syncthreads();
#ifndef PH_MASK
#define PH_MASK 0x3ffffu
#endif
#ifndef PH_MASK2
#define PH_MASK2 0x3ffffu
#endif
#define IN(k) (((PH_MASK >> ((k) > 8 ? (k) - 8 : (k))) & 1u) != 0u && ((PH_MASK2 >> (k)) & 1u) != 0u && lo <= (k) && (k) < hi)
#define SEAM(k) do { if (IN(k) && IN((k) + 1)) xcd_barrier(bar); } while (0)
#ifndef REP_TYPES
#define REP_TYPES 0
#endif
#ifndef REP_PHASE
#define REP_PHASE -1
#endif
#ifndef REP_COUNT
#define REP_COUNT 2
#endif
#define PH_BEGIN(k) for (int _rep = 0; _rep < (((k) == REP_PHASE) ? REP_COUNT : 1); ++_rep) { if (_rep) xcd_barrier(bar); if (IN(k))
#define PH_END }
#define GEMM_C() ([&]() -> int { int c_ = (int)blockIdx.x; if (!one_phase) { bool ok_ = true; for (int j_ = 0; j_ < 8; ++j_) ok_ = ok_ && (xb_ld(ctl + CW_BAR + XB_XCNT(j_)) == (unsigned)(F.G / 8)); \
        if (ok_) c_ = (int)(F.MISC[12] * 8u + F.MISC[13]); } return __builtin_amdgcn_readfirstlane(c_); }())

    PH_BEGIN(0) {
        PHASE_ARGS(); bf16_t* const WI = WSP(bf16_t*, WS_WI); bf16_t* const WOt = WSP(bf16_t*, WS_WO); bf16_t* const WGUD = WSP(bf16_t*, WS_WGU_D); bf16_t* const WDD = WSP(bf16_t*, WS_WD_D);
        bf16_t* const WGUM = WSP(bf16_t*, WS_WGU_M); bf16_t* const WDM = WSP(bf16_t*, WS_WD_M); bf16_t* const H = WSP(bf16_t*, WS_H);
        if (blockIdx.x < 3 * NH) { float* tbg = WSP(float*, WS_BKT) + blockIdx.x * TBL_N; const int br = blockIdx.x / NH, h = blockIdx.x % NH, dd = br == 0 ? 1 : (br == 1 ? 4 : 16);
            if (F.tid < TBL_N) { const int m_ = 160 - F.tid; tbg[F.tid] = (m_ >= 0 && m_ <= 128) ? kp->in[IN_RELB][t5_bucket(dd * m_) * NH + h] * LOG2E : -1e30f; } }
        LAS float* scr = (LAS float*)(F.lds + F.wave * 16640);
        for (int it = F.gw; it < CONV_A; it += NGW) conv_item(kp, ws, it, scr, F.lane);
        for (int m = F.gw; m < T; m += NGW) rms_row_bf16(kp->in[IN_X] + (size_t)m * D, kp->in[IN_ANG], H + (size_t)m * D, F.lane);
    }
    PH_END SEAM(0);

    for (int layer = 0; layer < 2; ++layer) {
        const int pb = layer == 0 ? 1 : 9;
        PH_BEGIN(pb) {
            PHASE_ARGS(); bf16_t* const H = WSP(bf16_t*, WS_H); bf16_t* const WI = WSP(bf16_t*, WS_WI); bf16_t* const QKV = WSP(bf16_t*, WS_QKV);
            pg8::Gemm g{H, WI + (size_t)layer * DQKV * D, T, DQKV, D}; pg8::StaticOrder S; S.init(T, DQKV, F.G, GEMM_C());
            pg8::EpiQKV E{QKV};
            pg8::gemm_phase<pg8::EpiQKV, pg8::StaticOrder, true, true>(F.lds, g, S, E, F.tid);
        }
        PH_END SEAM(pb);
        PH_BEGIN(pb + 1) {
            PHASE_ARGS(); bf16_t* const QKV = WSP(bf16_t*, WS_QKV); bf16_t* const OD = WSP(bf16_t*, WS_OD); bf16_t* const OS = WSP(bf16_t*, WS_OS); float* const LSE = WSP(float*, WS_LSE);
            LAS float* tbl = (LAS float*)(F.lds + TBL_OFF);
            { const float* tbg = WSP(const float*, WS_BKT); for (int i = F.tid; i < 3 * NH * TBL_N; i += NTHREADS) tbl[i] = tbg[i]; }
            __syncthreads();
            LAS unsigned char* wl = F.lds + F.wave * 16640;
            const size_t TS = (size_t)T * DH;
            const int cbase = CONV_A + layer * (CONV_B / 2); int cit = F.gw; const int ncv = CONV_B / 2;
            const int natt = 4 * 4096; const int cper = (ncv / NGW + (natt / NGW) - 1) / (natt / NGW);
            for (int pass_ = 0; pass_ < (REP_TYPES ? 2 : 1); ++pass_)
            for (int it = F.gw; it < natt; it += NGW) {
                if (pass_ == 0) for (int k = 0; k < cper && cit < ncv; ++k, cit += NGW) conv_item(kp, ws, cbase + cit, (LAS float*)wl, F.lane);
                if (pass_ == 1 && !((REP_TYPES >> (it >> 12)) & 1)) continue;
                const int type = it >> 12, idx = it & 4095, bh = idx >> 7, rem = idx & 127, b = bh >> 3, h = bh & 7;
                const size_t hb = (size_t)(bh * SEQ) * HD;
                if (type < 3) {
                    const int sh = 2 * type, dil = 1 << sh;
                    const int gps = 128 >> sh, r = rem / gps, qg = rem - r * gps; const int tok0 = b * SEQ + r;
                    const size_t sub = hb + (size_t)r * (SEQ >> sh) * HD;
                    attn_item<0>(wl, QKV + hb + (size_t)r * HD, dil * HD, QKV + (1 + type) * TS + sub, QKV + (4 + type) * TS + sub,
                                 OD + (size_t)type * TS + (size_t)tok0 * DH + h * HD, dil * DH, LSE + (size_t)type * T * NH + (size_t)tok0 * NH + h, dil * NH, tbl + (type * NH + h) * TBL_N, qg, F.lane);
                } else {
                    attn_item<1>(wl, QKV + 7 * TS + hb, HD, QKV + 8 * TS + hb, QKV + 9 * TS + hb, OS + (size_t)(b * SEQ) * DH + h * HD, DH, nullptr, 0, nullptr, rem, F.lane);
                }
            }
            for (; cit < ncv; cit += NGW) conv_item(kp, ws, cbase + cit, (LAS float*)wl, F.lane);
        }
        PH_END SEAM(pb + 1);
        PH_BEGIN(pb + 2) {
            PHASE_ARGS(); bf16_t* const OD = WSP(bf16_t*, WS_OD); bf16_t* const OS = WSP(bf16_t*, WS_OS); float* const LSE = WSP(float*, WS_LSE); bf16_t* const O = WSP(bf16_t*, WS_O);
            const float* gd = kp->in[IN_GDIL] + (size_t)layer * DH; const float* gs = kp->in[IN_GSB] + (size_t)layer * DH;
            for (int t = F.gw; t < T; t += NGW) {
                const int h = F.lane >> 3;
                const float l0 = LSE[(size_t)t * NH + h], l1 = LSE[(size_t)(T + t) * NH + h], l2 = LSE[(size_t)(2 * T + t) * NH + h];
                const float lm = fmaxf(l0, fmaxf(l1, l2)); float w0 = __expf(l0 - lm), w1 = __expf(l1 - lm), w2 = __expf(l2 - lm); const float wi = 1.0f / (w0 + w1 + w2); w0 *= wi; w1 *= wi; w2 *= wi;
                const u32x4* p0 = (const u32x4*)(OD + (size_t)t * DH + 16 * F.lane); const u32x4* p1 = (const u32x4*)(OD + (size_t)(T + t) * DH + 16 * F.lane); const u32x4* p2 = (const u32x4*)(OD + (size_t)(2 * T + t) * DH + 16 * F.lane);
                const u32x4* ps = (const u32x4*)(OS + (size_t)t * DH + 16 * F.lane);
                u32x4 a[2], bq[2], cq[2], sq[2];
#pragma unroll
                for (int k = 0; k < 2; ++k) { a[k] = p0[k]; bq[k] = p1[k]; cq[k] = p2[k]; sq[k] = ps[k]; }
                float vd[16], vs[16]; float ssd = 0.f, sss = 0.f;
#pragma unroll
                for (int k = 0; k < 2; ++k)
#pragma unroll
                    for (int j = 0; j < 4; ++j) {
                        const float d0 = w0 * bf_lo(a[k][j]) + w1 * bf_lo(bq[k][j]) + w2 * bf_lo(cq[k][j]), d1 = w0 * bf_hi(a[k][j]) + w1 * bf_hi(bq[k][j]) + w2 * bf_hi(cq[k][j]);
                        vd[8 * k + 2 * j] = d0; vd[8 * k + 2 * j + 1] = d1; ssd += d0 * d0 + d1 * d1;
                        const float s0 = bf_lo(sq[k][j]), s1 = bf_hi(sq[k][j]); vs[8 * k + 2 * j] = s0; vs[8 * k + 2 * j + 1] = s1; sss += s0 * s0 + s1 * s1; }
                const float rd = 1.0f / sqrtf(wave_sum(ssd) * (1.0f / DH) + EPS), rs = 1.0f / sqrtf(wave_sum(sss) * (1.0f / DH) + EPS);
                const f32x4* gdp = (const f32x4*)(gd + 16 * F.lane); const f32x4* gsp = (const f32x4*)(gs + 16 * F.lane);
                u32x4 od[2], os[2];
#pragma unroll
                for (int k = 0; k < 2; ++k) { const f32x4 ga = gdp[2 * k], gb = gdp[2 * k + 1], ha = gsp[2 * k], hb = gsp[2 * k + 1];
                    od[k].x = pk2(vd[8 * k] * rd * ga.x, vd[8 * k + 1] * rd * ga.y); od[k].y = pk2(vd[8 * k + 2] * rd * ga.z, vd[8 * k + 3] * rd * ga.w);
                    od[k].z = pk2(vd[8 * k + 4] * rd * gb.x, vd[8 * k + 5] * rd * gb.y); od[k].w = pk2(vd[8 * k + 6] * rd * gb.z, vd[8 * k + 7] * rd * gb.w);
                    os[k].x = pk2(vs[8 * k] * rs * ha.x, vs[8 * k + 1] * rs * ha.y); os[k].y = pk2(vs[8 * k + 2] * rs * ha.z, vs[8 * k + 3] * rs * ha.w);
                    os[k].z = pk2(vs[8 * k + 4] * rs * hb.x, vs[8 * k + 5] * rs * hb.y); os[k].w = pk2(vs[8 * k + 6] * rs * hb.z, vs[8 * k + 7] * rs * hb.w); }
                u32x4* o0 = (u32x4*)(O + (size_t)t * D + 16 * F.lane); u32x4* o1 = (u32x4*)(O + (size_t)t * D + DH + 16 * F.lane);
                o0[0] = od[0]; o0[1] = od[1]; o1[0] = os[0]; o1[1] = os[1];
            }
        }
        PH_END SEAM(pb + 2);
        PH_BEGIN(pb + 3) {
            PHASE_ARGS(); bf16_t* const O = WSP(bf16_t*, WS_O); bf16_t* const WOt = WSP(bf16_t*, WS_WO); float* const X = WSP(float*, WS_X);
            pg8::Gemm g{O, WOt + (size_t)layer * D * D, T, D, D}; pg8::StaticOrder S; S.init(T, D, F.G, GEMM_C());
            pg8::EpiBf16 E{WSP(bf16_t*, WS_DELTA), D, 0, 0, 0};
            pg8::gemm_phase<pg8::EpiBf16, pg8::StaticOrder, true, true>(F.lds, g, S, E, F.tid);
        }
        PH_END SEAM(pb + 3);
        PH_BEGIN(pb + 4) {
            PHASE_ARGS(); float* const X = WSP(float*, WS_X); bf16_t* const H = WSP(bf16_t*, WS_H); int* const SEL = WSP(int*, WS_SEL); float* const GWT = WSP(float*, WS_GW); int* const HIST = WSP(int*, WS_HIST);
            const float* gF = kp->in[IN_FNG] + (size_t)layer * D;
            const bf16_t* const DELTA = WSP(const bf16_t*, WS_DELTA);
            if (layer == 0) { for (int m = F.gw; m < T; m += NGW) res_rms_row_bf16(kp->in[IN_X] + (size_t)m * D, DELTA + (size_t)m * D, X + (size_t)m * D, gF, H + (size_t)m * D, F.lane); }
            else {
                volatile LAS unsigned* hist = F.MISC + 16;
                const int rows_per_wg = T / F.G, rows_per_wave = rows_per_wg / NWAVES;
                { const f32x4* RW4 = (const f32x4*)kp->in[IN_RW]; LAS f32x4* RL = (LAS f32x4*)F.lds;
                  for (int u = F.tid; u < 4096; u += NTHREADS) { const int ln = u & 63, k = u >> 6, half = k & 1, qi = k >> 1, i = qi & 3, q = qi >> 2; RL[u] = RW4[(4 * (ln + 64 * q) + i) * 2 + half]; } }
                __syncthreads();
                const LAS f32x4* rl = (const LAS f32x4*)F.lds + F.lane;
                for (int j = 0; j < rows_per_wave; ++j) {
                    const int t = blockIdx.x * rows_per_wg + F.wave * rows_per_wave + j;
                    f32x4* xr = (f32x4*)(X + (size_t)t * D) + F.lane; const f32x4* gr = (const f32x4*)gF + F.lane; const u32x2* dr = (const u32x2*)(DELTA + (size_t)t * D) + F.lane;
                    f32x4 v[8]; float ss = 0.f;
#pragma unroll
                    for (int q = 0; q < 8; ++q) { const f32x4 a = xr[64 * q]; const u32x2 d = dr[64 * q]; v[q] = (f32x4){a.x + bf_lo(d.x), a.y + bf_hi(d.x), a.z + bf_lo(d.y), a.w + bf_hi(d.y)}; xr[64 * q] = v[q]; ss += dot4(v[q]); }
                    const float rstd = 1.0f / sqrtf(wave_sum(ss) * (1.0f / D) + EPS);
                    float lg[8];
#pragma unroll
                    for (int e = 0; e < 8; ++e) lg[e] = 0.f;
                    unsigned* o8 = (unsigned*)((unsigned char*)H + (size_t)t * D) + F.lane;
#pragma unroll
                    for (int q = 0; q < 8; ++q) { const f32x4 gg = gr[64 * q]; const f32x4 y = {v[q].x * rstd * gg.x, v[q].y * rstd * gg.y, v[q].z * rstd * gg.z, v[q].w * rstd * gg.w};
                        o8[64 * q] = pg8::pk4_fp8(y.x * F8_SH, y.y * F8_SH, y.z * F8_SH, y.w * F8_SH);
#pragma unroll
                        for (int i = 0; i < 4; ++i) { const f32x4 ra = rl[((q * 4 + i) * 2) * 64], rb = rl[((q * 4 + i) * 2 + 1) * 64]; const float yi = y[i];
                            lg[0] += yi * ra.x; lg[1] += yi * ra.y; lg[2] += yi * ra.z; lg[3] += yi * ra.w; lg[4] += yi * rb.x; lg[5] += yi * rb.y; lg[6] += yi * rb.z; lg[7] += yi * rb.w; } }
#pragma unroll
                    for (int e = 0; e < 8; ++e) lg[e] = wave_sum(lg[e]);
                    if (F.lane == 0) {
                        int e1 = 0; float v1 = lg[0];
#pragma unroll
                        for (int e = 1; e < 8; ++e) if (lg[e] > v1) { v1 = lg[e]; e1 = e; }
                        int e2 = -1; float v2 = -3e38f;
#pragma unroll
                        for (int e = 0; e < 8; ++e) if (e != e1 && lg[e] > v2) { v2 = lg[e]; e2 = e; }
                        const float ex = __expf(v2 - v1); const float w1 = 1.0f / (1.0f + ex), w2 = ex * w1;
                        SEL[2 * t] = e1; SEL[2 * t + 1] = e2; GWT[2 * t] = w1; GWT[2 * t + 1] = w2;
                        __hip_atomic_fetch_add((LAS unsigned*)&hist[e1], 1u, __ATOMIC_RELAXED, __HIP_MEMORY_SCOPE_WORKGROUP); __hip_atomic_fetch_add((LAS unsigned*)&hist[e2], 1u, __ATOMIC_RELAXED, __HIP_MEMORY_SCOPE_WORKGROUP);
                    }
                }
                __syncthreads();
                if (F.tid < 8) { HIST[blockIdx.x * 8 + F.tid] = (int)hist[F.tid]; }
            }
        }
        PH_END SEAM(pb + 4);
        if (layer == 0) {
            PH_BEGIN(6) {
                PHASE_ARGS(); bf16_t* const H = WSP(bf16_t*, WS_H); bf16_t* const WGUD = WSP(bf16_t*, WS_WGU_D); bf16_t* const ACT = WSP(bf16_t*, WS_ACT);
                pg8::Gemm g{H, WGUD, T, 2 * DFF, D}; pg8::StaticOrder S; S.init(T, 2 * DFF, F.G, GEMM_C());
                pg8::EpiSwiGLU E{ACT, DFF, DFF / 128};
                pg8::gemm_phase<pg8::EpiSwiGLU, pg8::StaticOrder, true, true>(F.lds, g, S, E, F.tid);
            }
            PH_END SEAM(6);
            PH_BEGIN(7) {
                PHASE_ARGS(); bf16_t* const ACT = WSP(bf16_t*, WS_ACT); bf16_t* const WDD = WSP(bf16_t*, WS_WD_D); float* const X = WSP(float*, WS_X);
                pg8::Gemm g{ACT, WDD, T, D, DFF}; pg8::StaticOrder S; S.init(T, D, F.G, GEMM_C());
                pg8::EpiBf16 E{WSP(bf16_t*, WS_DELTA), D, 0, 0, 0};
                pg8::gemm_phase<pg8::EpiBf16, pg8::StaticOrder, true, true>(F.lds, g, S, E, F.tid);
            }
            PH_END SEAM(7);
            PH_BEGIN(8) { PHASE_ARGS(); float* const X = WSP(float*, WS_X); bf16_t* const H = WSP(bf16_t*, WS_H); const bf16_t* const DELTA = WSP(const bf16_t*, WS_DELTA); for (int m = F.gw; m < T; m += NGW) res_rms_row_bf16(X + (size_t)m * D, DELTA + (size_t)m * D, X + (size_t)m * D, kp->in[IN_ANG] + D, H + (size_t)m * D, F.lane); }
            PH_END SEAM(8);
        }
    }
    PH_BEGIN(14) {
        PHASE_ARGS(); bf16_t* const H = WSP(bf16_t*, WS_H); unsigned char* const AS = WSP(unsigned char*, WS_AS); int* const SEL = WSP(int*, WS_SEL); int* const POS = WSP(int*, WS_POS); int* const HIST = WSP(int*, WS_HIST); int* const MOEINFO = WSP(int*, WS_MOEINFO);
        volatile LAS unsigned* tot = F.MISC + 32; volatile LAS unsigned* pre = F.MISC + 40; volatile LAS unsigned* rbase = F.MISC + 48; volatile LAS unsigned* ent = F.MISC + 64;
        if (F.tid < 16) F.MISC[32 + F.tid] = 0u;
        __syncthreads();
        { const int e = F.tid & 7, ch = F.tid >> 3; unsigned st = 0, sp = 0;
#pragma unroll
          for (int k = 0; k < 4; ++k) { const int w = 4 * ch + k; const unsigned hv = (unsigned)HIST[w * 8 + e]; st += hv; if (w < (int)blockIdx.x) sp += hv; }
          __hip_atomic_fetch_add((LAS unsigned*)&tot[e], st, __ATOMIC_RELAXED, __HIP_MEMORY_SCOPE_WORKGROUP); __hip_atomic_fetch_add((LAS unsigned*)&pre[e], sp, __ATOMIC_RELAXED, __HIP_MEMORY_SCOPE_WORKGROUP); }
        __syncthreads();
        if (F.tid == 0) { unsigned tbv = 0;
            for (int e = 0; e < 8; ++e) { rbase[e] = tbv * 256u + pre[e]; if (blockIdx.x == 0) MOEINFO[e] = (int)tbv; tbv += (tot[e] + 255u) >> 8; }
            if (blockIdx.x == 0) MOEINFO[8] = (int)tbv; }
        const int t0 = blockIdx.x * 64;
        if (F.tid < 128) ent[F.tid] = (unsigned)SEL[2 * t0 + F.tid];
        __syncthreads();
        if (F.tid < 128) { const unsigned e = ent[F.tid]; unsigned rank = 0; for (int j = 0; j < F.tid; ++j) rank += (ent[j] == e) ? 1u : 0u;
            const unsigned pos = rbase[e] + rank; POS[2 * t0 + F.tid] = (int)pos; F.MISC[192 + F.tid] = pos; }
        __syncthreads();
        for (int q = 0; q < 16; q += 8) {
            u32x4 v[8][2];
#pragma unroll
            for (int k = 0; k < 8; ++k) { const int en = 16 * F.wave + q + k; const u32x4* src = (const u32x4*)((const unsigned char*)H + (size_t)(t0 + (en >> 1)) * D) + F.lane;
                v[k][0] = src[0]; v[k][1] = src[64]; }
#pragma unroll
            for (int k = 0; k < 8; ++k) { const int en = 16 * F.wave + q + k; u32x4* dst = (u32x4*)(AS + (size_t)F.MISC[192 + en] * D) + F.lane;
                dst[0] = v[k][0]; dst[64] = v[k][1]; }
        }
    }
    PH_END SEAM(14);
    if (IN(15) || IN(16)) {
        PHASE_ARGS(); int* const MOEINFO = WSP(int*, WS_MOEINFO); const bf16_t* const AS = WSP(const bf16_t*, WS_AS); const bf16_t* const WGUM = WSP(const bf16_t*, WS_WGU_M); unsigned char* const ACTM = WSP(unsigned char*, WS_ACTM); const bf16_t* const WDM = WSP(const bf16_t*, WS_WD_M); bf16_t* const Y = WSP(bf16_t*, WS_Y);
        int tbv[9];
#pragma unroll
        for (int k = 0; k < 9; ++k) tbv[k] = __builtin_amdgcn_readfirstlane((int)__hip_atomic_load((unsigned*)MOEINFO + k, __ATOMIC_RELAXED, __HIP_MEMORY_SCOPE_AGENT));
        PH_BEGIN(15) {
            pg8::Gemm g{AS, WGUM, MOE_ROWS, NE * 2 * DFE, D / 2}; pg8::GroupedOrder S; S.init(tbv[8], 2 * DFE / 256, F.G, GEMM_C());
#pragma unroll
            for (int k = 0; k < 9; ++k) S.tb[k] = tbv[k];
            pg8::EpiSwiGLU8 E{ACTM, DFE, 2 * DFE / 256, 1.0f / (F8_SH * F8_SW), F8_SACT};
            pg8::gemm_phase<pg8::EpiSwiGLU8, pg8::GroupedOrder, true, true, true>(F.lds, g, S, E, F.tid);
        }
        PH_END SEAM(15);
        PH_BEGIN(16) {
            pg8::Gemm g{(const bf16_t*)ACTM, WDM, MOE_ROWS, NE * D, DFE / 2}; pg8::GroupedOrder S; S.init(tbv[8], D / 256, F.G, GEMM_C());
#pragma unroll
            for (int k = 0; k < 9; ++k) S.tb[k] = tbv[k];
            pg8::EpiBf16G E{Y, D, D / 256};
            pg8::gemm_phase<pg8::EpiBf16G, pg8::GroupedOrder, true, true, true>(F.lds, g, S, E, F.tid);
        } PH_END
    }
    SEAM(16);
    PH_BEGIN(17) {
        PHASE_ARGS(); float* const X = WSP(float*, WS_X); bf16_t* const Y = WSP(bf16_t*, WS_Y); int* const POS = WSP(int*, WS_POS); float* const GWT = WSP(float*, WS_GW);
        const float* gfin = kp->in[IN_FING];
        for (int t = F.gw; t < T; t += NGW) {
            const int p0 = POS[2 * t], p1 = POS[2 * t + 1]; const float w0 = GWT[2 * t] * (1.0f / (F8_SACT * F8_SW)), w1 = GWT[2 * t + 1] * (1.0f / (F8_SACT * F8_SW));
            const f32x4* xr = (const f32x4*)(X + (size_t)t * D) + F.lane; const u32x2* y0 = (const u32x2*)(Y + (size_t)p0 * D) + F.lane; const u32x2* y1 = (const u32x2*)(Y + (size_t)p1 * D) + F.lane;
            f32x4 v[8]; float ss = 0.f;
#pragma unroll
            for (int j = 0; j < 8; ++j) { const f32x4 xv = xr[64 * j]; const u32x2 a = y0[64 * j], b = y1[64 * j];
                v[j].x = xv.x + w0 * bf_lo(a.x) + w1 * bf_lo(b.x); v[j].y = xv.y + w0 * bf_hi(a.x) + w1 * bf_hi(b.x); v[j].z = xv.z + w0 * bf_lo(a.y) + w1 * bf_lo(b.y); v[j].w = xv.w + w0 * bf_hi(a.y) + w1 * bf_hi(b.y);
                ss += dot4(v[j]); }
            const float rstd = 1.0f / sqrtf(wave_sum(ss) * (1.0f / D) + EPS);
            f32x4* orow = (f32x4*)(kp->out + (size_t)t * D) + F.lane; const f32x4* gr = (const f32x4*)gfin + F.lane;
#pragma unroll
            for (int j = 0; j < 8; ++j) { const f32x4 gg = gr[64 * j]; orow[64 * j] = (f32x4){v[j].x * rstd * gg.x, v[j].y * rstd * gg.y, v[j].z * rstd * gg.z, v[j].w * rstd * gg.w}; }
        }
    } PH_END
#undef IN
#undef SEAM
}

#ifndef MK_ONE_LAUNCH
#define MK_ONE_LAUNCH 1
#endif
extern "C" void kernel_launch(void* const* d_in, const int* in_sizes, int n_in, void* d_out, int out_size, void* d_ws, size_t ws_size, hipStream_t stream) {
    static int grid = 0;
    if (grid == 0) {
        if (n_in != 16 || in_sizes[0] != T * D || out_size != T * D || ws_size < WS_END) { fprintf(stderr, "kernel_launch: shape/workspace mismatch (n_in %d, in0 %d, out %d, ws %zu, need %zu)\n", n_in, n_in > 0 ? in_sizes[0] : -1, out_size, ws_size, (size_t)WS_END); grid = -1; return; }
        int dev = 0, cus = 0, per_cu = 0;
        if (hipGetDevice(&dev) != hipSuccess || hipDeviceGetAttribute(&cus, hipDeviceAttributeMultiprocessorCount, dev) != hipSuccess) { grid = -1; return; }
        if (hipFuncSetAttribute((const void*)mega_fwd, hipFuncAttributeMaxDynamicSharedMemorySize, LDS_BYTES) != hipSuccess) { fprintf(stderr, "kernel_launch: hipFuncSetAttribute failed\n"); grid = -1; return; }
        if (hipOccupancyMaxActiveBlocksPerMultiprocessor(&per_cu, (const void*)mega_fwd, NTHREADS, LDS_BYTES) != hipSuccess || per_cu < 1) fprintf(stderr, "kernel_launch: occupancy query says %d\n", per_cu);
        (void)hipGetLastError();
        grid = cus;
        if (grid != 256) { fprintf(stderr, "kernel_launch: built for 256 CUs, found %d\n", cus); grid = -1; return; }
    }
    if (grid < 0) return;
    (void)hipMemsetAsync((char*)d_ws + WS_CTL, 0, CTL_ZERO_BYTES, stream);
    Params p{};
    for (int i = 0; i < 16; ++i) p.in[i] = (const float*)d_in[i];
    p.out = (float*)d_out; p.ws = (unsigned char*)d_ws;
#if MK_ONE_LAUNCH
    p.ph_lo = 0; p.ph_hi = N_PHASES;
    hipLaunchKernelGGL(mega_fwd, dim3(grid), dim3(NTHREADS), LDS_BYTES, stream, p);
#else
    for (int ph = 0; ph < N_PHASES; ++ph) { p.ph_lo = ph; p.ph_hi = ph + 1; hipLaunchKernelGGL(mega_fwd, dim3(grid), dim3(NTHREADS), LDS_BYTES, stream, p); }
#endif
}
```

```cpp
#include <hip/hip_runtime.h>
#include <cstdio>
#include <cstdint>
namespace pg8 {
#define PG8_LAS __attribute__((address_space(3)))
typedef unsigned short bf16_t;
typedef short bf16x8 __attribute__((ext_vector_type(8)));
typedef float f32x4 __attribute__((ext_vector_type(4)));
typedef unsigned u32x4 __attribute__((ext_vector_type(4)));
typedef int i32x4 __attribute__((ext_vector_type(4)));
typedef int v8i32 __attribute__((ext_vector_type(8)));
typedef unsigned u32x2 __attribute__((ext_vector_type(2)));
constexpr int BM = 256, BK = 64, HALF = 128, HTB = HALF * BK * 2  , STAGE_BYTES = 8 * HTB, NXCD = 8, WGM = 8;

__host__ __device__ __forceinline__ int lds_byte(int r, int c) { const int st = (r >> 4) * 2 + (c >> 5), rr = r & 15, cc = c & 31, ob = rr * 64 + cc * 2; return st * 1024 + (ob ^ (((ob >> 9) & 1) << 5)); }
__host__ __device__ __forceinline__ void stage_rc(int b, int& R, int& C) { const int st = b / 1024, sb = b % 1024, swz = sb ^ (((sb >> 9) & 1) << 5); R = (st >> 1) * 16 + swz / 64; C = (st & 1) * 32 + (swz % 64) / 2; }
__host__ __device__ __forceinline__ int perm32(int rho) { const int n = rho >> 4, i = rho & 15; return 8 * (i >> 2) + 4 * n + (i & 3); }

struct Unit { int pm, pn; };
struct Gemm { const bf16_t* A; const bf16_t* Bt; int M, N, K; };

struct StaticOrder {
    int nM, nN, nwg, G, c;
    __host__ __device__ void init(int M, int N, int G_, int c_) { nM = M / BM; nN = N / BM; nwg = nM * nN; G = G_; c = c_; }
    __host__ __device__ bool next(int i, Unit& u) const {
        const long L = (long)i * G + c; if (L >= nwg) return false;
        int wgid = (int)L; { const int q = nwg / NXCD, r = nwg % NXCD, xcd = wgid % NXCD, off = wgid / NXCD; wgid = (xcd < r ? xcd * (q + 1) : r * (q + 1) + (xcd - r) * q) + off; }
        const int nig = WGM * nN, gid = wgid / nig, fm = gid * WGM, gsz = (nM - fm) < WGM ? (nM - fm) : WGM;
        u.pm = fm + ((wgid % nig) % gsz); u.pn = (wgid % nig) / gsz; return true;
    }
    __device__ __forceinline__ void a_ready(const Unit&) const {}
    __device__ __forceinline__ void done(const Unit&) const {}
};

__device__ __forceinline__ unsigned cvt_pk_bf16(float lo, float hi) { unsigned r; asm volatile("v_cvt_pk_bf16_f32 %0, %1, %2" : "=v"(r) : "v"(lo), "v"(hi)); return r; }

struct EpiBf16 {
    static constexpr bool PERM = true, AFTER_DRAIN = false;
    bf16_t* O; int ldc; int split_cols; size_t split_stride; int tpe;
    __device__ __forceinline__ void operator()(const f32x4 (&acc)[2][2][4][2], const Unit& u, int wr, int wc, int fr, int fq) const {
        const int row0 = u.pm * BM + wr * 64 + fr; int colt = (tpe ? (u.pn % tpe) : u.pn) * BM; bf16_t* base = O;
        if (split_cols) { const int t = colt / split_cols; base += (size_t)t * split_stride; colt -= t * split_cols; }
        const int col0 = colt + wc * 32 + 8 * fq;
#pragma unroll
        for (int ai = 0; ai < 2; ++ai)
#pragma unroll
            for (int m = 0; m < 4; ++m) { bf16_t* rowp = base + (size_t)(row0 + ai * HALF + m * 16) * ldc + col0;
#pragma unroll
                for (int bj = 0; bj < 2; ++bj) { const f32x4 v0 = acc[ai][bj][m][0], v1 = acc[ai][bj][m][1];
                    u32x4 w; w.x = cvt_pk_bf16(v0[0], v0[1]); w.y = cvt_pk_bf16(v0[2], v0[3]); w.z = cvt_pk_bf16(v1[0], v1[1]); w.w = cvt_pk_bf16(v1[2], v1[3]);
                    *(u32x4*)(rowp + bj * HALF) = w; } }
    }
};


struct EpiBf16G {
    static constexpr bool PERM = true, AFTER_DRAIN = false;
    bf16_t* O; int ldc; int tpe;
    __device__ __forceinline__ void operator()(const f32x4 (&acc)[2][2][4][2], const Unit& u, int wr, int wc, int fr, int fq) const {
        const unsigned off0 = (unsigned)(u.pm * BM + wr * 64 + fr) * (unsigned)ldc + (unsigned)((u.pn % tpe) * BM + wc * 32 + 8 * fq);
#pragma unroll
        for (int ai = 0; ai < 2; ++ai)
#pragma unroll
            for (int m = 0; m < 4; ++m)
#pragma unroll
                for (int bj = 0; bj < 2; ++bj) { const f32x4 v0 = acc[ai][bj][m][0], v1 = acc[ai][bj][m][1];
                    u32x4 w; w.x = cvt_pk_bf16(v0[0], v0[1]); w.y = cvt_pk_bf16(v0[2], v0[3]); w.z = cvt_pk_bf16(v1[0], v1[1]); w.w = cvt_pk_bf16(v1[2], v1[3]);
                    *(u32x4*)(O + (off0 + (unsigned)((ai * HALF + m * 16) * ldc + bj * HALF))) = w; }
    }
};
struct EpiQKV {
    static constexpr bool PERM = true, AFTER_DRAIN = false;
    bf16_t* O;
    __device__ __forceinline__ void operator()(const f32x4 (&acc)[2][2][4][2], const Unit& u, int wr, int wc, int fr, int fq) const {
        const int t = u.pn >> 2, hp = u.pn & 3; const int m0 = u.pm * BM, b = m0 >> 12, s0 = (m0 & 4095) + wr * 64 + fr;
        const size_t TS = (size_t)16384 * 1024; const int slot = t == 0 ? 0 : (t == 1 ? 1 : (t == 2 ? 4 : t + 4)); const bool three = (t == 1 || t == 2);
        bf16_t* base = O + (size_t)slot * TS + wc * 32 + 8 * fq;
#pragma unroll
        for (int ai = 0; ai < 2; ++ai)
#pragma unroll
            for (int m = 0; m < 4; ++m) { const int s = s0 + ai * HALF + m * 16;
#pragma unroll
                for (int bj = 0; bj < 2; ++bj) { const f32x4 v0 = acc[ai][bj][m][0], v1 = acc[ai][bj][m][1];
                    u32x4 w; w.x = cvt_pk_bf16(v0[0], v0[1]); w.y = cvt_pk_bf16(v0[2], v0[3]); w.z = cvt_pk_bf16(v1[0], v1[1]); w.w = cvt_pk_bf16(v1[2], v1[3]);
                    const size_t hb = (size_t)((b * 8 + 2 * hp + bj) * 4096);
                    *(u32x4*)(base + (hb + s) * 128) = w;
                    if (three) { *(u32x4*)(base + TS + (hb + (s & 3) * 1024 + (s >> 2)) * 128) = w; *(u32x4*)(base + 2 * TS + (hb + (s & 15) * 256 + (s >> 4)) * 128) = w; } } }
    }
};
struct EpiResF32 {
    static constexpr bool PERM = false, AFTER_DRAIN = false;
    const float* base; float* out; int ldc;
    __device__ __forceinline__ void operator()(const f32x4 (&acc)[2][2][4][2], const Unit& u, int wr, int wc, int fr, int fq) const {
        const int row0 = u.pm * BM + wr * 64 + fr, col0 = u.pn * BM + wc * 32 + 4 * fq;
#pragma unroll
        for (int ai = 0; ai < 2; ++ai)
#pragma unroll
            for (int m = 0; m < 4; ++m) { const size_t off = (size_t)(row0 + ai * HALF + m * 16) * ldc + col0;
                f32x4 bs[2][2];
#pragma unroll
                for (int bj = 0; bj < 2; ++bj)
#pragma unroll
                    for (int n = 0; n < 2; ++n) bs[bj][n] = *(const f32x4*)(base + off + bj * HALF + n * 16);
#pragma unroll
                for (int bj = 0; bj < 2; ++bj)
#pragma unroll
                    for (int n = 0; n < 2; ++n) *(f32x4*)(out + off + bj * HALF + n * 16) = bs[bj][n] + acc[ai][bj][m][n];
                asm volatile("" ::: "memory"); }
    }
};
__device__ __forceinline__ float silu_mul(float g, float u) { return g * u * __builtin_amdgcn_rcpf(1.0f + __builtin_amdgcn_exp2f(g * -1.4426950408889634f)); }
struct EpiSwiGLU {
    static constexpr bool PERM = true, AFTER_DRAIN = false;
    bf16_t* O; int ldc; int tpe;
    __device__ __forceinline__ void operator()(const f32x4 (&acc)[2][2][4][2], const Unit& u, int wr, int wc, int fr, int fq) const {
        const int row0 = u.pm * BM + wr * 64 + fr, col0 = (u.pn % tpe) * HALF + wc * 32 + 8 * fq;
#pragma unroll
        for (int ai = 0; ai < 2; ++ai)
#pragma unroll
            for (int m = 0; m < 4; ++m) { bf16_t* rowp = O + (size_t)(row0 + ai * HALF + m * 16) * ldc + col0;
                const f32x4 g0 = acc[ai][0][m][0], g1 = acc[ai][0][m][1], u0 = acc[ai][1][m][0], u1 = acc[ai][1][m][1];
                u32x4 w; w.x = cvt_pk_bf16(silu_mul(g0[0], u0[0]), silu_mul(g0[1], u0[1])); w.y = cvt_pk_bf16(silu_mul(g0[2], u0[2]), silu_mul(g0[3], u0[3]));
                w.z = cvt_pk_bf16(silu_mul(g1[0], u1[0]), silu_mul(g1[1], u1[1])); w.w = cvt_pk_bf16(silu_mul(g1[2], u1[2]), silu_mul(g1[3], u1[3]));
                *(u32x4*)rowp = w; }
    }
};

__device__ __forceinline__ unsigned pk4_fp8(float a, float b, float c, float d) {
    a = __builtin_amdgcn_fmed3f(a, -448.f, 448.f); b = __builtin_amdgcn_fmed3f(b, -448.f, 448.f); c = __builtin_amdgcn_fmed3f(c, -448.f, 448.f); d = __builtin_amdgcn_fmed3f(d, -448.f, 448.f);
    int p = __builtin_amdgcn_cvt_pk_fp8_f32(a, b, 0, false); p = __builtin_amdgcn_cvt_pk_fp8_f32(c, d, p, true); return (unsigned)p;
}
struct EpiSwiGLU8 {
    static constexpr bool PERM = true, AFTER_DRAIN = false;
    unsigned char* O; int ldc; int tpe; float in_scale, out_scale;
    __device__ __forceinline__ void operator()(const f32x4 (&acc)[2][2][4][2], const Unit& u, int wr, int wc, int fr, int fq) const {
        const int row0 = u.pm * BM + wr * 64 + fr, col0 = (u.pn % tpe) * HALF + wc * 32 + 8 * fq;
#pragma unroll
        for (int ai = 0; ai < 2; ++ai)
#pragma unroll
            for (int m = 0; m < 4; ++m) { unsigned char* rowp = O + (size_t)(row0 + ai * HALF + m * 16) * ldc + col0;
                const f32x4 g0 = acc[ai][0][m][0] * in_scale, g1 = acc[ai][0][m][1] * in_scale, u0 = acc[ai][1][m][0] * (in_scale * out_scale), u1 = acc[ai][1][m][1] * (in_scale * out_scale);
                u32x2 w; w.x = pk4_fp8(silu_mul(g0[0], u0[0]), silu_mul(g0[1], u0[1]), silu_mul(g0[2], u0[2]), silu_mul(g0[3], u0[3]));
                w.y = pk4_fp8(silu_mul(g1[0], u1[0]), silu_mul(g1[1], u1[1]), silu_mul(g1[2], u1[2]), silu_mul(g1[3], u1[3]));
                *(u32x2*)rowp = w; }
    }
};
struct GroupedOrder {
    int nM, nN, nwg, G, c; int tb[9];
    __device__ __forceinline__ void init(int RT, int nN_, int G_, int c_) { nM = RT; nN = nN_; nwg = nM * nN; G = G_; c = c_; }
    __device__ __forceinline__ bool next(int i, Unit& u) const {
        const long L = (long)i * G + c; if (L >= nwg) return false;
        int wgid = (int)L; { const int q = nwg / NXCD, r = nwg % NXCD, xcd = wgid % NXCD, off = wgid / NXCD; wgid = (xcd < r ? xcd * (q + 1) : r * (q + 1) + (xcd - r) * q) + off; }
        const int nig = WGM * nN, gid = wgid / nig, fm = gid * WGM, gsz = (nM - fm) < WGM ? (nM - fm) : WGM;
        const int pm = fm + ((wgid % nig) % gsz), pn = (wgid % nig) / gsz; int e = 0;
#pragma unroll
        for (int k = 1; k < 8; ++k) e += (pm >= tb[k]) ? 1 : 0;
        u.pm = pm; u.pn = e * nN + pn; return true;
    }
    __device__ __forceinline__ void a_ready(const Unit&) const {}
    __device__ __forceinline__ void done(const Unit&) const {}
};
template <class Epi, class Sched, bool ALIGN_EPI = false, bool SP2 = false, bool F8 = false>
__device__ __forceinline__ void gemm_phase(PG8_LAS unsigned char* lds, const Gemm g, const Sched& S, const Epi& E, const int tid) {
    const int wid = __builtin_amdgcn_readfirstlane(tid >> 6), lane = tid & 63, wr = wid >> 2, wc = wid & 3, fr = lane & 15, fq = lane >> 4;
    const int K = g.K, nt = K / BK;
    unsigned voffA[2], voffB[2];
#pragma unroll
    for (int i = 0; i < 2; ++i) { int R, C; stage_rc(tid * 16 + i * 8192, R, C); const int Rb = Epi::PERM ? ((R & ~31) + perm32(R & 31)) : R;
        voffA[i] = (unsigned)(R * K + C) * 2u; voffB[i] = (unsigned)(Rb * K + C) * 2u; }
    const size_t kstep = (size_t)(BK * 2);
    const size_t hstep = (size_t)HALF * K * 2;
    const size_t tstep = 2 * hstep;
    const unsigned ldsw = (unsigned)wid * 1024u;
    const unsigned ldsb = (unsigned)__builtin_amdgcn_readfirstlane((int)((unsigned)(size_t)lds + ldsw));
    const int aoff = lds_byte(wr * 64 + fr, fq * 8), boff = lds_byte(wc * 32 + fr, fq * 8);
#define PG8_SA(b, h) (((b) * 2 + (h)) * HTB)
#define PG8_SB(b, h) ((4 + (b) * 2 + (h)) * HTB)
#define PG8_STAGE(bufoff, gbase, voff) do { _Pragma("unroll") for (int _i = 0; _i < 2; ++_i) { unsigned _keep; \
        asm volatile("s_mov_b32 %0, m0\n\ts_mov_b32 m0, %3\n\ts_nop 0\n\tglobal_load_lds_dwordx4 %1, %2\n\ts_mov_b32 m0, %0" : "=&s"(_keep) : "v"((voff)[_i]), "s"((const char*)(gbase)), "s"(ldsb + (unsigned)((bufoff) + _i * 8192)) : "memory"); } } while (0)
#define PG8_LDA(dst, b, h) do { _Pragma("unroll") for (int m = 0; m < 4; ++m) _Pragma("unroll") for (int k = 0; k < 2; ++k) dst[m][k] = *(const PG8_LAS bf16x8*)(lds + PG8_SA(b, h) + aoff + m * 2048 + k * 1024); } while (0)
#define PG8_LDB(dst, b, h) do { _Pragma("unroll") for (int n = 0; n < 2; ++n) _Pragma("unroll") for (int k = 0; k < 2; ++k) dst[n][k] = *(const PG8_LAS bf16x8*)(lds + PG8_SB(b, h) + boff + n * 2048 + k * 1024); } while (0)
#define PG8_CAT(x) __builtin_bit_cast(v8i32, __builtin_shufflevector(__builtin_bit_cast(i32x4, (x)[0]), __builtin_bit_cast(i32x4, (x)[1]), 0, 1, 2, 3, 4, 5, 6, 7))
#define PG8_MMA(ai, bj, At, Bt) do { __builtin_amdgcn_s_setprio(1); if constexpr (F8) asm volatile("s_nop 4" ::: "memory"); _Pragma("unroll") for (int m = 0; m < 4; ++m) _Pragma("unroll") for (int n = 0; n < 2; ++n) { \
        if constexpr (F8) { asm volatile("v_mfma_scale_f32_16x16x128_f8f6f4 %0, %1, %2, %0, %3, %3 op_sel_hi:[0,0,0]" : "+v"(acc[ai][bj][m][n]) : "v"(PG8_CAT(Bt[n])), "v"(PG8_CAT(At[m])), "v"(f8sc)); } \
        else { _Pragma("unroll") for (int k = 0; k < 2; ++k) acc[ai][bj][m][n] = __builtin_amdgcn_mfma_f32_16x16x32_bf16(Bt[n][k], At[m][k], acc[ai][bj][m][n], 0, 0, 0); } } __builtin_amdgcn_s_setprio(0); } while (0)
#define PG8_WAIT_V(n) asm volatile("s_waitcnt vmcnt(" #n ")" ::: "memory")
#define PG8_WAIT_L(n) asm volatile("s_waitcnt lgkmcnt(" #n ")" ::: "memory")
#define PG8_BAR __builtin_amdgcn_s_barrier()
#define PG8_SCHED __builtin_amdgcn_sched_barrier(0)
    const int f8sc = 0x7f7f7f7f;
    Unit cur, nxt; int ui = 0;
    if (!S.next(0, cur)) return;
    f32x4 acc[2][2][4][2];
#pragma unroll
    for (int a = 0; a < 2; ++a)
#pragma unroll
        for (int b = 0; b < 2; ++b)
#pragma unroll
            for (int m = 0; m < 4; ++m)
#pragma unroll
                for (int n = 0; n < 2; ++n) acc[a][b][m][n] = (f32x4){0.f, 0.f, 0.f, 0.f};
    bf16x8 At[4][2], B0[2][2], B1[2][2];
    const char* cA = (const char*)g.A + (size_t)cur.pm * tstep; const char* cB = (const char*)g.Bt + (size_t)cur.pn * tstep;
    S.a_ready(cur);
    if constexpr (SP2) {
        PG8_STAGE(PG8_SB(0, 0), cB, voffB); PG8_STAGE(PG8_SB(0, 1), cB + hstep, voffB); PG8_STAGE(PG8_SA(0, 0), cA, voffA); PG8_STAGE(PG8_SA(0, 1), cA + hstep, voffA);
        if (wr == 1) PG8_BAR;
        PG8_WAIT_V(2); PG8_BAR;
        PG8_STAGE(PG8_SB(1, 0), cB + kstep, voffB); PG8_STAGE(PG8_SA(1, 0), cA + kstep, voffA); PG8_STAGE(PG8_SB(1, 1), cB + hstep + kstep, voffB);
        PG8_WAIT_V(6); PG8_BAR;
    } else {
        PG8_STAGE(PG8_SB(0, 0), cB, voffB); PG8_STAGE(PG8_SA(0, 0), cA, voffA); PG8_STAGE(PG8_SB(0, 1), cB + hstep, voffB); PG8_STAGE(PG8_SA(0, 1), cA + hstep, voffA);
        if (wr == 1) PG8_BAR;
        PG8_WAIT_V(4); PG8_BAR;
        PG8_STAGE(PG8_SB(1, 0), cB + kstep, voffB); PG8_STAGE(PG8_SA(1, 0), cA + kstep, voffA); PG8_STAGE(PG8_SB(1, 1), cB + hstep + kstep, voffB);
        PG8_WAIT_V(6); PG8_BAR;
    }
    for (;;) {
        const bool has_next = S.next(ui + 1, nxt);
        const char* nA = has_next ? (const char*)g.A + (size_t)nxt.pm * tstep : cA; const char* nB = has_next ? (const char*)g.Bt + (size_t)nxt.pn * tstep : cB;
        for (int t = 0; t < nt; t += 2) {
            const bool last = (t == nt - 2);
            const char* a1 = cA + (size_t)(t + 1) * kstep;
            const char* a2 = last ? nA : cA + (size_t)(t + 2) * kstep; const char* b2 = last ? nB : cB + (size_t)(t + 2) * kstep;
            const char* a3 = a2 + kstep; const char* b3 = b2 + kstep;
            if (last && has_next) S.a_ready(nxt);
            if constexpr (SP2) {
            PG8_LDB(B0, 0, 0); PG8_LDB(B1, 0, 1); PG8_SCHED; PG8_LDA(At, 0, 0); PG8_STAGE(PG8_SA(1, 1), a1 + hstep, voffA);
            PG8_WAIT_V(8); PG8_WAIT_L(0); PG8_BAR; PG8_MMA(0, 0, At, B0); PG8_MMA(0, 1, At, B1); PG8_BAR; PG8_SCHED;
            PG8_LDA(At, 0, 1); PG8_STAGE(PG8_SB(0, 0), b2, voffB); PG8_STAGE(PG8_SB(0, 1), b2 + hstep, voffB); PG8_STAGE(PG8_SA(0, 0), a2, voffA);
            PG8_WAIT_V(8); PG8_WAIT_L(0); PG8_BAR; PG8_MMA(1, 0, At, B0); PG8_MMA(1, 1, At, B1); PG8_BAR; PG8_SCHED;
            PG8_LDB(B0, 1, 0); PG8_LDB(B1, 1, 1); PG8_SCHED; PG8_LDA(At, 1, 0); PG8_STAGE(PG8_SA(0, 1), a2 + hstep, voffA);
            PG8_WAIT_V(8); PG8_WAIT_L(0); PG8_BAR; PG8_MMA(0, 0, At, B0); PG8_MMA(0, 1, At, B1); PG8_BAR; PG8_SCHED;
            PG8_LDA(At, 1, 1); PG8_STAGE(PG8_SB(1, 0), b3, voffB); PG8_STAGE(PG8_SB(1, 1), b3 + hstep, voffB); PG8_STAGE(PG8_SA(1, 0), a3, voffA);
            PG8_WAIT_V(8); PG8_WAIT_L(0); PG8_BAR; PG8_MMA(1, 0, At, B0); PG8_MMA(1, 1, At, B1); PG8_BAR; PG8_SCHED;
            } else {
            PG8_LDB(B0, 0, 0); PG8_SCHED; PG8_LDA(At, 0, 0); PG8_STAGE(PG8_SA(1, 1), a1 + hstep, voffA);
            PG8_WAIT_L(8); PG8_BAR; PG8_WAIT_L(0); PG8_MMA(0, 0, At, B0); PG8_BAR; PG8_SCHED;
            PG8_LDB(B1, 0, 1); PG8_STAGE(PG8_SB(0, 0), b2, voffB);
            PG8_BAR; PG8_WAIT_L(0); PG8_MMA(0, 1, At, B1); PG8_BAR;
            PG8_LDA(At, 0, 1); PG8_STAGE(PG8_SA(0, 0), a2, voffA);
            PG8_BAR; PG8_WAIT_L(0); PG8_MMA(1, 0, At, B0); PG8_BAR; PG8_SCHED;
            PG8_STAGE(PG8_SB(0, 1), b2 + hstep, voffB);
            PG8_WAIT_V(6); PG8_BAR; PG8_MMA(1, 1, At, B1); PG8_BAR;
            PG8_LDB(B0, 1, 0); PG8_SCHED; PG8_LDA(At, 1, 0); PG8_STAGE(PG8_SA(0, 1), a2 + hstep, voffA);
            PG8_WAIT_L(8); PG8_BAR; PG8_WAIT_L(0); PG8_MMA(0, 0, At, B0); PG8_BAR; PG8_SCHED;
            PG8_LDB(B1, 1, 1); PG8_STAGE(PG8_SB(1, 0), b3, voffB);
            PG8_BAR; PG8_WAIT_L(0); PG8_MMA(0, 1, At, B1); PG8_BAR;
            PG8_LDA(At, 1, 1); PG8_STAGE(PG8_SA(1, 0), a3, voffA);
            PG8_BAR; PG8_WAIT_L(0); PG8_MMA(1, 0, At, B0); PG8_BAR; PG8_SCHED;
            PG8_STAGE(PG8_SB(1, 1), b3 + hstep, voffB);
            PG8_WAIT_V(6); PG8_BAR; PG8_MMA(1, 1, At, B1); PG8_BAR;
            }
        }
        if constexpr (ALIGN_EPI) { if (wr == 0) PG8_BAR; }
        if constexpr (F8) asm volatile("s_nop 15\n\ts_nop 15" ::: "memory");
        if constexpr (!Epi::AFTER_DRAIN) { E(acc, cur, wr, wc, fr, fq); S.done(cur); }
        if (!has_next) break;
#pragma unroll
        for (int a = 0; a < 2; ++a)
#pragma unroll
            for (int b = 0; b < 2; ++b)
#pragma unroll
                for (int m = 0; m < 4; ++m)
#pragma unroll
                    for (int n = 0; n < 2; ++n) acc[a][b][m][n] = (f32x4){0.f, 0.f, 0.f, 0.f};
        cur = nxt; cA = nA; cB = nB; ++ui;
        if constexpr (ALIGN_EPI) { if (wr == 1) PG8_BAR; }
    }
    PG8_WAIT_V(0);
    if constexpr (!ALIGN_EPI) { if (wr == 0) PG8_BAR; }
    PG8_BAR;
    if constexpr (Epi::AFTER_DRAIN) { E.fused(acc, cur, wr, wc, fr, fq, lds, wid, lane); S.done(cur); }
#undef PG8_SA
#undef PG8_SB
#undef PG8_STAGE
#undef PG8_LDA
#undef PG8_LDB
#undef PG8_MMA
#undef PG8_CAT
#undef PG8_WAIT_V
#undef PG8_WAIT_L
#undef PG8_BAR
#undef PG8_SCHED
}
}

#define GAS __attribute__((address_space(1)))
#define LAS __attribute__((address_space(3)))
typedef unsigned short bf16_t;
typedef short bf16x8 __attribute__((ext_vector_type(8)));
typedef short s16x4 __attribute__((ext_vector_type(4)));
typedef float f32x4 __attribute__((ext_vector_type(4)));
typedef float f32x16 __attribute__((ext_vector_type(16)));
typedef unsigned u32x4 __attribute__((ext_vector_type(4)));
typedef unsigned u32x2 __attribute__((ext_vector_type(2)));
#define LDS_WAIT() asm volatile("s_waitcnt lgkmcnt(0)" ::: "memory")
#define VM_WAIT() asm volatile("s_waitcnt vmcnt(0)" ::: "memory")
#define SBAR() __builtin_amdgcn_sched_barrier(0)

constexpr int BATCH = 4, SEQ = 4096, T = BATCH * SEQ, D = 2048, NH = 8, HD = 128, DH = NH * HD  , DQKV = 6144;
constexpr int DFF = 5504, DFE = 7168, NE = 8, MOE_ROWS = 2 * T + NE * 256;
constexpr float EPS = 1e-6f;
constexpr int NWAVES = 8, NTHREADS = 512;
constexpr float LOG2E = 1.4426950408889634f, LN2 = 0.6931471805599453f;
constexpr float QSCALE = 0.08838834764831845f;
constexpr float F8_SH = 16.f, F8_SW = 512.f, F8_SACT = 8.f;

constexpr size_t MiB = 1u << 20;
constexpr size_t WS_CTL = 0, CTL_ZERO_BYTES = 1 * MiB;
constexpr size_t WS_BKT = 1 * MiB;
constexpr size_t WS_SEL = 2 * MiB;
constexpr size_t WS_GW = WS_SEL + 256 * 1024;
constexpr size_t WS_POS = WS_GW + 256 * 1024;
constexpr size_t WS_HIST = WS_POS + 256 * 1024;
constexpr size_t WS_MOEINFO = WS_HIST + 64 * 1024;
constexpr size_t WS_LSE = 3 * MiB;
constexpr size_t WS_WI = 8 * MiB;
constexpr size_t WS_WO = WS_WI + 2 * (size_t)DQKV * D * 2;
constexpr size_t WS_WGU_D = WS_WO + 2 * (size_t)D * D * 2;
constexpr size_t WS_WD_D = WS_WGU_D + (size_t)2 * DFF * D * 2;
constexpr size_t WS_WGU_M = WS_WD_D + (size_t)D * DFF * 2 + 512 * 1024;
constexpr size_t WS_WD_M = WS_WGU_M + (size_t)NE * 2 * DFE * D;
constexpr size_t WS_X = WS_WD_M + (size_t)NE * D * DFE;
constexpr size_t WS_H = WS_X + (size_t)T * D * 4;
constexpr size_t WS_R = WS_H + (size_t)T * D * 2;
constexpr size_t WS_QKV = WS_R;
constexpr size_t WS_OD = WS_QKV + (size_t)10 * T * DH * 2;
constexpr size_t WS_OS = WS_OD + (size_t)3 * T * DH * 2;
constexpr size_t WS_O = WS_OS + (size_t)T * DH * 2;
constexpr size_t WS_ACT = WS_R;
constexpr size_t WS_AS = WS_R + (size_t)MOE_ROWS * D * 2;
constexpr size_t WS_ACTM = WS_AS + (size_t)MOE_ROWS * D;
constexpr size_t WS_Y = WS_R;
constexpr size_t WS_END_MOE = WS_ACTM + (size_t)MOE_ROWS * DFE, WS_END_ATT = WS_O + (size_t)T * D * 2, WS_END = WS_END_MOE > WS_END_ATT ? WS_END_MOE : WS_END_ATT;
static_assert(WS_ACT + (size_t)T * DFF * 2 <= WS_END, "region R");
static_assert(WS_END <= 1879048192ull, "workspace");
static_assert(WS_WI % 256 == 0 && WS_WO % 256 == 0 && WS_WGU_D % 256 == 0 && WS_WD_D % 256 == 0 && WS_WGU_M % 256 == 0 && WS_WD_M % 256 == 0 && WS_X % 256 == 0 && WS_H % 256 == 0 && WS_R % 256 == 0 && WS_ACTM % 256 == 0, "alignment");
constexpr int CW_BAR = 4096;

constexpr int SCR_BYTES = 133120;
constexpr int TBL_OFF = SCR_BYTES, TBL_N = 200, TBL_BYTES = 3 * NH * TBL_N * 4;
constexpr int MISC_OFF = 152576;
constexpr int LDS_BYTES = 155648;
static_assert(TBL_OFF + TBL_BYTES <= MISC_OFF && MISC_OFF + 3072 <= LDS_BYTES, "LDS map");

#define XB_TMO      128
#define XB_XCNT(j)  (256  + 64 * (j))
#define XB_XSUB(j)  (1280 + 64 * (j))
#define XB_XGEN(j)  (2304 + 64 * (j))
#define XB_TOP      3328
#define XB_TOPGEN   3392
#define XCD_BAR_WORDS 3456
#define XB_SPIN_CAP (1u << 20)
__device__ __forceinline__ unsigned xb_ld(unsigned* p)              { return __hip_atomic_load(p, __ATOMIC_RELAXED, __HIP_MEMORY_SCOPE_AGENT); }
__device__ __forceinline__ unsigned xb_add(unsigned* p, unsigned v) { return __hip_atomic_fetch_add(p, v, __ATOMIC_RELAXED, __HIP_MEMORY_SCOPE_AGENT); }
__device__ __forceinline__ unsigned xb_xcc_id() { return (unsigned)__builtin_amdgcn_s_getreg((3 << 11) | 20) & 0xFu; }
#define XB_SPIN(cond, bar) do { unsigned _sp = 0; while (cond) { __builtin_amdgcn_s_sleep(1); \
    if ((++_sp & 255u) == 0u) { if (xb_ld(&(bar)[XB_TMO])) break; if (_sp > XB_SPIN_CAP) { atomicAdd(&(bar)[XB_TMO], 1u); break; } } } } while (0)
struct XcdBarrier { unsigned* bar; unsigned x; volatile LAS unsigned* st; };
__device__ __forceinline__ XcdBarrier xcd_barrier_post(unsigned* bar, volatile LAS unsigned* st) {
    XcdBarrier b; b.bar = bar; b.x = xb_xcc_id(); b.st = st;
    if (threadIdx.x == 0) (void)xb_add(&bar[XB_XCNT(b.x)], 1u);
    return b;
}
__device__ __forceinline__ void xcd_barrier_complete(unsigned* bar, unsigned x, unsigned& nloc, unsigned& nx) {
    const unsigned G = gridDim.x * gridDim.y * gridDim.z;
    unsigned sum, cnt, mine, sp = 0u;
    for (;;) {
        sum = 0u; cnt = 0u; mine = 0u;
#pragma unroll
        for (unsigned j = 0; j < 16; ++j) { const unsigned c = xb_ld(&bar[XB_XCNT(j)]); sum += c; cnt += (c > 0u) ? 1u : 0u; mine = (j == x) ? c : mine; }
        if (sum == G) break;
        __builtin_amdgcn_s_sleep(1);
        if ((++sp & 255u) == 0u) { if (xb_ld(&bar[XB_TMO])) break; if (sp > XB_SPIN_CAP) { atomicAdd(&bar[XB_TMO], 1u); break; } }
    }
    nloc = mine > 0u ? mine : 1u; nx = cnt > 0u ? cnt : 1u;
}
__device__ __forceinline__ void xcd_barrier(const XcdBarrier& b) {
    asm volatile("s_waitcnt vmcnt(0)" ::: "memory");
    __syncthreads();
    if (threadIdx.x == 0) {
        unsigned* bar = b.bar;
        __builtin_amdgcn_s_waitcnt(0);
        unsigned nloc = b.st[0], nx = b.st[1];
        if (nloc == 0u) { xcd_barrier_complete(bar, b.x, nloc, nx); b.st[0] = nloc; b.st[1] = nx; }
        const unsigned old = xb_add(&bar[XB_XSUB(b.x)], 1u);
        const unsigned gen = old / nloc;
        if (old + 1u == (gen + 1u) * nloc) {
            __builtin_amdgcn_fence(__ATOMIC_RELEASE, "agent");
            asm volatile("s_waitcnt vmcnt(0)" ::: "memory");
            const unsigned og = xb_add(&bar[XB_TOP], 1u);
            const unsigned tg = og / nx;
            if (og + 1u == (tg + 1u) * nx) xb_add(&bar[XB_TOPGEN], 1u);
            else XB_SPIN(xb_ld(&bar[XB_TOPGEN]) == tg, bar);
            __builtin_amdgcn_fence(__ATOMIC_ACQUIRE, "agent");
            xb_add(&bar[XB_XGEN(b.x)], 1u);
            asm volatile("s_waitcnt vmcnt(0)" ::: "memory");
        } else {
            XB_SPIN(xb_ld(&bar[XB_XGEN(b.x)]) == gen, bar);
            __builtin_amdgcn_fence(__ATOMIC_ACQUIRE, "agent");
            asm volatile("s_waitcnt vmcnt(0)" ::: "memory");
        }
    }
    __syncthreads();
}

__device__ __forceinline__ unsigned pk2(float lo, float hi) { unsigned r; asm volatile("v_cvt_pk_bf16_f32 %0, %1, %2" : "=v"(r) : "v"(lo), "v"(hi)); return r; }
__device__ __forceinline__ float bf_lo(unsigned w) { return __builtin_bit_cast(float, w << 16); }
__device__ __forceinline__ float bf_hi(unsigned w) { return __builtin_bit_cast(float, w & 0xffff0000u); }
__device__ __forceinline__ float wave_sum(float v) {
#pragma unroll
    for (int o = 1; o < 64; o <<= 1) v += __shfl_xor(v, o);
    return v;
}
__device__ __forceinline__ float dot4(f32x4 a) { return (a.x * a.x + a.y * a.y) + (a.z * a.z + a.w * a.w); }

struct Frame {
    LAS unsigned char* lds; volatile LAS unsigned* MISC;
    int tid, lane, wave, gw, G;
};

__device__ __forceinline__ void tr_item(const float* __restrict__ W, int K, int N, bf16_t* __restrict__ WT, int mode, LAS float* scr, int item, int lane) {
    const int nblk = N >> 6, kb = item / nblk, nb = item - kb * nblk, k0 = kb << 6, n0 = nb << 6;
    f32x4 v[16];
    const float* src = W + (size_t)(k0 + (lane >> 4)) * N + n0 + 4 * (lane & 15);
#pragma unroll
    for (int i = 0; i < 16; ++i) v[i] = __builtin_nontemporal_load((const f32x4*)(src + (size_t)(4 * i) * N));
#pragma unroll
    for (int i = 0; i < 16; ++i) { LAS float* d = scr + (4 * i + (lane >> 4)) * 65 + 4 * (lane & 15); d[0] = v[i][0]; d[1] = v[i][1]; d[2] = v[i][2]; d[3] = v[i][3]; }
    LDS_WAIT();
    const int c = lane & 7;
#pragma unroll
    for (int p = 0; p < 8; ++p) { const int n = (lane >> 3) + 8 * p; const LAS float* s = scr + (8 * c) * 65 + n;
        u32x4 o; o.x = pk2(s[0], s[65]); o.y = pk2(s[130], s[195]); o.z = pk2(s[260], s[325]); o.w = pk2(s[390], s[455]);
        const int nn = n0 + n; const int row = mode == 0 ? nn : (((nn >> 7) << 8) + (nn & 127) + (mode == 2 ? 128 : 0));
        *(u32x4*)(WT + (size_t)row * K + k0 + 8 * c) = o; }
    LDS_WAIT();
}
__device__ __forceinline__ void tr_item8(const float* __restrict__ W, int K, int N, unsigned char* __restrict__ WT, int mode, LAS float* scr, int item, int lane) {
    const int nblk = N >> 6, kb = item / nblk, nb = item - kb * nblk, k0 = kb << 6, n0 = nb << 6;
    f32x4 v[16];
    const float* src = W + (size_t)(k0 + (lane >> 4)) * N + n0 + 4 * (lane & 15);
#pragma unroll
    for (int i = 0; i < 16; ++i) v[i] = __builtin_nontemporal_load((const f32x4*)(src + (size_t)(4 * i) * N));
#pragma unroll
    for (int i = 0; i < 16; ++i) { LAS float* d = scr + (4 * i + (lane >> 4)) * 65 + 4 * (lane & 15); d[0] = v[i][0]; d[1] = v[i][1]; d[2] = v[i][2]; d[3] = v[i][3]; }
    LDS_WAIT();
    const int c = lane & 7;
#pragma unroll
    for (int p = 0; p < 8; ++p) { const int n = (lane >> 3) + 8 * p; const LAS float* s = scr + (8 * c) * 65 + n;
        u32x2 o; o.x = pg8::pk4_fp8(s[0] * F8_SW, s[65] * F8_SW, s[130] * F8_SW, s[195] * F8_SW); o.y = pg8::pk4_fp8(s[260] * F8_SW, s[325] * F8_SW, s[390] * F8_SW, s[455] * F8_SW);
        const int nn = n0 + n; const int row = mode == 0 ? nn : (((nn >> 7) << 8) + (nn & 127) + (mode == 2 ? 128 : 0));
        *(u32x2*)(WT + (size_t)row * K + k0 + 8 * c) = o; }
    LDS_WAIT();
}

struct ConvDesc { const float* W; unsigned char* WT; int K, N, mode, f8, item; };
__device__ __forceinline__ void tr_load(const ConvDesc& d, f32x4 (&v)[16], int lane) {
    const int nblk = d.N >> 6, kb = d.item / nblk, nb = d.item - kb * nblk, k0 = kb << 6, n0 = nb << 6;
    const unsigned voff = (unsigned)(((lane >> 4) * d.N + 4 * (lane & 15)) * 4);
    const char* ub = (const char*)(d.W + (size_t)k0 * d.N + n0);
#pragma unroll
    for (int i = 0; i < 16; ++i) v[i] = __builtin_nontemporal_load((const f32x4*)(ub + (size_t)(4 * i) * d.N * 4 + voff));
}
__device__ __forceinline__ void tr_finish(const ConvDesc& d, const f32x4 (&v)[16], LAS float* scr, int lane) {
    const int nblk = d.N >> 6, kb = d.item / nblk, nb = d.item - kb * nblk, k0 = kb << 6, n0 = nb << 6;
#pragma unroll
    for (int i = 0; i < 16; ++i) { LAS float* q = scr + (4 * i + (lane >> 4)) * 65 + 4 * (lane & 15); q[0] = v[i][0]; q[1] = v[i][1]; q[2] = v[i][2]; q[3] = v[i][3]; }
    LDS_WAIT();
    const int c = lane & 7;
#pragma unroll
    for (int p = 0; p < 8; ++p) { const int n = (lane >> 3) + 8 * p; const LAS float* s = scr + (8 * c) * 65 + n;
        const int nn = n0 + n; const int row = d.mode == 0 ? nn : (((nn >> 7) << 8) + (nn & 127) + (d.mode == 2 ? 128 : 0));
        if (d.f8) { u32x2 o; o.x = pg8::pk4_fp8(s[0] * F8_SW, s[65] * F8_SW, s[130] * F8_SW, s[195] * F8_SW); o.y = pg8::pk4_fp8(s[260] * F8_SW, s[325] * F8_SW, s[390] * F8_SW, s[455] * F8_SW);
            *(u32x2*)(d.WT + (size_t)row * d.K + k0 + 8 * c) = o; }
        else { u32x4 o; o.x = pk2(s[0], s[65]); o.y = pk2(s[130], s[195]); o.z = pk2(s[260], s[325]); o.w = pk2(s[390], s[455]);
            *(u32x4*)(d.WT + ((size_t)row * d.K + k0 + 8 * c) * 2) = o; } }
    LDS_WAIT();
}
__device__ __forceinline__ void rms_row_bf16(const float* xrow, const float* g, bf16_t* orow, int lane) {
    const f32x4* xr = (const f32x4*)xrow + lane; const f32x4* gr = (const f32x4*)g + lane;
    f32x4 v[8]; float ss = 0.f;
#pragma unroll
    for (int j = 0; j < 8; ++j) { v[j] = xr[64 * j]; ss += dot4(v[j]); }
    const float rstd = 1.0f / sqrtf(wave_sum(ss) * (1.0f / D) + EPS);
    u32x2* o8 = (u32x2*)orow + lane;
#pragma unroll
    for (int j = 0; j < 8; ++j) { const f32x4 gg = gr[64 * j]; u32x2 w; w.x = pk2(v[j].x * rstd * gg.x, v[j].y * rstd * gg.y); w.y = pk2(v[j].z * rstd * gg.z, v[j].w * rstd * gg.w); o8[64 * j] = w; }
}
__device__ __forceinline__ int t5_bucket(int n) {
    if (n < 16) return n;
    int b = 16 + (int)(log((double)n / 16.0) / log(128.0) * 16.0);
    return b < 31 ? b : 31;
}

__device__ __forceinline__ void dma_tile_k(const bf16_t* base, size_t row_stride_bytes, LAS unsigned char* dst, const unsigned (&voff)[4]) {
#pragma unroll
    for (int i = 0; i < 8; ++i) {
        const char* ub = (const char*)base + (size_t)(4 * i) * row_stride_bytes;
        __builtin_amdgcn_global_load_lds((const unsigned*)(ub + voff[i & 3]), (LAS unsigned*)(dst + i * 1024), 16, 0, 0);
    }
}
__device__ __forceinline__ void dma_tile_v(const bf16_t* base, size_t row_stride_bytes, LAS unsigned char* dst, unsigned voff) {
#pragma unroll
    for (int i = 0; i < 8; ++i) {
        const char* ub = (const char*)base + (size_t)(4 * i) * row_stride_bytes;
        __builtin_amdgcn_global_load_lds((const unsigned*)(ub + voff), (LAS unsigned*)(dst + i * 1024), 16, 0, 0);
    }
}
#define TRRD(dst, addr, off) asm volatile("ds_read_b64_tr_b16 %0, %1 offset:%2" : "=&v"(dst) : "v"(addr), "i"(off) : "memory")

template <int MODE>
__device__ __forceinline__ void attn_item(LAS unsigned char* wl, const bf16_t* Qh, int qstride, const bf16_t* Kh, const bf16_t* Vh, bf16_t* Op, int ostride, float* lsep, int lstride,
                                          const LAS float* tb, int qg, int lane) {
    const int c = lane & 31, hi = lane >> 5;
    const int i0 = 32 * qg;
    constexpr size_t rstride = HD;
    bf16x8 qf[8];
    { const bf16_t* qrow = Qh + (size_t)(i0 + c) * qstride + 8 * hi;
#pragma unroll
      for (int s = 0; s < 8; ++s) qf[s] = *(const bf16x8*)(qrow + 16 * s); }
    f32x16 o[4];
#pragma unroll
    for (int b = 0; b < 4; ++b)
#pragma unroll
        for (int r = 0; r < 16; ++r) o[b][r] = 0.f;
    float mx = -1e30f, lsum = 0.f, carry = 0.f;
    const int kt_first = MODE == 0 ? (qg > 4 ? qg - 4 : 0) : qg, kt_last = MODE == 0 ? qg : 0, kstep = MODE == 0 ? 1 : -1;
    LAS unsigned char* Kl = wl; LAS unsigned char* Vl = wl + 8192;
    const LAS unsigned char* kbase = Kl + c * 256;
    unsigned vb[4];
    { const int g = lane >> 4, q = (lane & 15) >> 2, p = lane & 3, h = g >> 1;
#pragma unroll
      for (int b = 0; b < 4; ++b) vb[b] = (unsigned)(uintptr_t)Vl + (4 * h + q) * 256 + (((4 * b + 2 * (g & 1) + (p >> 1)) ^ (q << 2)) << 4) + 8 * (p & 1); }
    unsigned voffk[4], voffv;
    { const int rr = lane >> 4, p = lane & 15;
#pragma unroll
      for (int i = 0; i < 4; ++i) voffk[i] = (unsigned)(rr * (int)rstride * 2 + ((p ^ ((4 * i + rr) & 15)) << 4));
      voffv = (unsigned)(rr * (int)rstride * 2 + ((p ^ (rr << 2)) << 4)); }
    dma_tile_k(Kh + (size_t)(32 * kt_first) * rstride, rstride * 2, Kl, voffk);
    dma_tile_v(Vh + (size_t)(32 * kt_first) * rstride, rstride * 2, Vl, voffv);
    bool early = false;
    for (int kt = kt_first;; kt += kstep) {
        const bool has_next = (kt != kt_last);
        const int j0 = 32 * kt;
        asm volatile("s_waitcnt vmcnt(8)" ::: "memory");
        f32x16 S;
#pragma unroll
        for (int r = 0; r < 16; ++r) S[r] = 0.f;
#pragma unroll
        for (int s = 0; s < 8; ++s) {
            const bf16x8 kf = *(const LAS bf16x8*)(kbase + ((((2 * s + hi) ^ (c & 15))) << 4));
            S = __builtin_amdgcn_mfma_f32_32x32x16_bf16(kf, qf[s], S, 0, 0, 0);
        }
        asm volatile("" ::: "memory");
        if (has_next) dma_tile_k(Kh + (size_t)(j0 + 32 * kstep) * rstride, rstride * 2, Kl, voffk);
        bf16x8 pb[2];
        if constexpr (MODE == 0) {
            const int a = 160 - (i0 - j0) - c + 4 * hi;
            const LAS float* tp = tb + a;
            float x[16]; float pm = -3e38f;
#pragma unroll
            for (int r = 0; r < 16; ++r) { x[r] = fmaf(S[r], QSCALE * LOG2E, tp[8 * (r >> 2) + (r & 3)]); pm = fmaxf(pm, x[r]); }
            { auto rr = __builtin_amdgcn_permlane32_swap(__float_as_uint(pm), __float_as_uint(pm), false, false); pm = fmaxf(__uint_as_float(rr[0]), __uint_as_float(rr[1])); }
            const float mn = fmaxf(mx, pm); const float alpha = __builtin_amdgcn_exp2f(mx - mn); mx = mn;
            float ps = 0.f;
#pragma unroll
            for (int r = 0; r < 16; ++r) { x[r] = __builtin_amdgcn_exp2f(x[r] - mn); ps += x[r]; }
            { auto rr = __builtin_amdgcn_permlane32_swap(__float_as_uint(ps), __float_as_uint(ps), false, false); ps = __uint_as_float(rr[0]) + __uint_as_float(rr[1]); }
            lsum = lsum * alpha + ps;
            if (__any(alpha < 1.f)) {
#pragma unroll
                for (int b = 0; b < 4; ++b)
#pragma unroll
                    for (int r = 0; r < 16; ++r) o[b][r] *= alpha;
            }
#pragma unroll
            for (int s = 0; s < 2; ++s) { u32x4 w; w.x = pk2(x[8 * s], x[8 * s + 1]); w.y = pk2(x[8 * s + 2], x[8 * s + 3]); w.z = pk2(x[8 * s + 4], x[8 * s + 5]); w.w = pk2(x[8 * s + 6], x[8 * s + 7]); pb[s] = __builtin_bit_cast(bf16x8, w); }
        } else {
            const bool diag = (j0 == i0);
            float lk[16], ls[16];
#pragma unroll
            for (int r = 0; r < 16; ++r) {
                const float z = S[r] * QSCALE; const float az = fabsf(z);
                const float sp = fmaxf(z, 0.f) + LN2 * __builtin_amdgcn_logf(1.0f + __builtin_amdgcn_exp2f(-az * LOG2E));
                const int key = 8 * (r >> 2) + 4 * hi + (r & 3);
                const bool valid = !diag || key < c;
                lk[r] = valid ? -sp : 0.f; ls[r] = valid ? (z - sp) : -1e30f;
            }
            float gs[4];
#pragma unroll
            for (int g = 0; g < 4; ++g) gs[g] = (lk[4 * g] + lk[4 * g + 1]) + (lk[4 * g + 2] + lk[4 * g + 3]);
            float pg[4];
#pragma unroll
            for (int g = 0; g < 4; ++g) { auto rr = __builtin_amdgcn_permlane32_swap(__float_as_uint(gs[g]), __float_as_uint(gs[g]), false, false); pg[g] = hi ? __uint_as_float(rr[0]) : __uint_as_float(rr[1]); }
            float suf[4]; float run = carry;
#pragma unroll
            for (int g = 3; g >= 0; --g) { if (hi == 0) { suf[g] = run + pg[g]; run = suf[g] + gs[g]; } else { suf[g] = run; run = run + gs[g] + pg[g]; } }
            float av[16];
#pragma unroll
            for (int g = 0; g < 4; ++g) { float lt = suf[g];
#pragma unroll
                for (int e = 3; e >= 0; --e) { av[4 * g + e] = __builtin_amdgcn_exp2f((ls[4 * g + e] + lt) * LOG2E); lt += lk[4 * g + e]; } }
            carry = run;
            early = __all(carry < -105.f);
#pragma unroll
            for (int s = 0; s < 2; ++s) { u32x4 w; w.x = pk2(av[8 * s], av[8 * s + 1]); w.y = pk2(av[8 * s + 2], av[8 * s + 3]); w.z = pk2(av[8 * s + 4], av[8 * s + 5]); w.w = pk2(av[8 * s + 6], av[8 * s + 7]); pb[s] = __builtin_bit_cast(bf16x8, w); }
        }
        if (has_next) asm volatile("s_waitcnt vmcnt(8)" ::: "memory"); else asm volatile("s_waitcnt vmcnt(0)" ::: "memory");
#pragma unroll
        for (int b = 0; b < 4; ++b) {
            s16x4 l0, h0, l1, h1;
            TRRD(l0, vb[b], 0); TRRD(h0, vb[b], 2048); TRRD(l1, vb[b], 4096); TRRD(h1, vb[b], 6144);
            asm volatile("s_waitcnt lgkmcnt(0)" ::: "memory"); SBAR();
            o[b] = __builtin_amdgcn_mfma_f32_32x32x16_bf16((bf16x8){l0[0], l0[1], l0[2], l0[3], h0[0], h0[1], h0[2], h0[3]}, pb[0], o[b], 0, 0, 0);
            o[b] = __builtin_amdgcn_mfma_f32_32x32x16_bf16((bf16x8){l1[0], l1[1], l1[2], l1[3], h1[0], h1[1], h1[2], h1[3]}, pb[1], o[b], 0, 0, 0);
        }
        asm volatile("" ::: "memory");
        if (!has_next || (MODE == 1 && early)) break;
        dma_tile_v(Vh + (size_t)(j0 + 32 * kstep) * rstride, rstride * 2, Vl, voffv);
    }
    if (MODE == 1) VM_WAIT();
    const float inv = MODE == 0 ? __builtin_amdgcn_rcpf(lsum) : 1.0f;
    bf16_t* orow = Op + (size_t)(i0 + c) * ostride + 4 * hi;
#pragma unroll
    for (int b = 0; b < 4; ++b)
#pragma unroll
        for (int g = 0; g < 4; ++g) { u32x2 w; w.x = pk2(o[b][4 * g] * inv, o[b][4 * g + 1] * inv); w.y = pk2(o[b][4 * g + 2] * inv, o[b][4 * g + 3] * inv); *(u32x2*)(orow + 32 * b + 8 * g) = w; }
    if (MODE == 0 && hi == 0) lsep[(size_t)(i0 + c) * lstride] = (mx + __builtin_amdgcn_logf(lsum)) * LN2;
}

struct Params { const float* in[16]; float* out; unsigned char* ws; int ph_lo, ph_hi; };
enum { IN_X = 0, IN_RELB, IN_ANG, IN_WIN, IN_GDIL, IN_GSB, IN_WO, IN_FNG, IN_DWG, IN_DWU, IN_DWD, IN_RW, IN_MWG, IN_MWU, IN_MWD, IN_FING };
constexpr int N_PHASES = 18;

typedef const __attribute__((address_space(4))) Params* KPtr;
__device__ __forceinline__ KPtr kparams() { KPtr p = (KPtr)__builtin_amdgcn_kernarg_segment_ptr(); asm volatile("" : "+s"(p)); return p; }
#define WSP(T, off) ((T)(ws + (off)))
__device__ __forceinline__ Frame make_frame() {
    Frame F; int t = threadIdx.x; asm volatile("" : "+v"(t));
    extern __shared__ __attribute__((aligned(16))) unsigned char lds_raw[];
    F.lds = (LAS unsigned char*)lds_raw; F.MISC = (volatile LAS unsigned*)(F.lds + MISC_OFF);
    F.tid = t; F.lane = t & 63; F.wave = __builtin_amdgcn_readfirstlane(t >> 6); F.G = gridDim.x; F.gw = blockIdx.x * NWAVES + F.wave;
    return F;
}
#define PHASE_ARGS() KPtr kp = kparams(); unsigned char* const ws = kp->ws; (void)ws; const Frame F = make_frame(); const int NGW = F.G * NWAVES; (void)NGW


constexpr int I_WI = (D / 64) * (DQKV / 64), I_WO = (D / 64) * (D / 64), I_DG = (D / 64) * (DFF / 64), I_DD = (DFF / 64) * (D / 64), I_MG = (D / 64) * (DFE / 64), I_MD = (DFE / 64) * (D / 64);
constexpr int CONV_A = I_WI + I_WO + 2 * I_DG + I_DD;
constexpr int CONV_B = I_WI + I_WO + NE * (2 * I_MG + I_MD);
static_assert(CONV_B % 2 == 0, "deferred conversion split");
__device__ __forceinline__ void conv_item(KPtr kp, unsigned char* ws, int it, LAS float* scr, int lane) {
    int r = it;
    if (r < CONV_A) {
        if (r < I_WI) { tr_item(kp->in[IN_WIN], D, DQKV, WSP(bf16_t*, WS_WI), 0, scr, r, lane); return; } r -= I_WI;
        if (r < I_WO) { tr_item(kp->in[IN_WO], D, D, WSP(bf16_t*, WS_WO), 0, scr, r, lane); return; } r -= I_WO;
        if (r < I_DG) { tr_item(kp->in[IN_DWG], D, DFF, WSP(bf16_t*, WS_WGU_D), 1, scr, r, lane); return; } r -= I_DG;
        if (r < I_DG) { tr_item(kp->in[IN_DWU], D, DFF, WSP(bf16_t*, WS_WGU_D), 2, scr, r, lane); return; } r -= I_DG;
        tr_item(kp->in[IN_DWD], DFF, D, WSP(bf16_t*, WS_WD_D), 0, scr, r, lane); return;
    }
    r -= CONV_A;
    if (r < I_WI) { tr_item(kp->in[IN_WIN] + (size_t)D * DQKV, D, DQKV, WSP(bf16_t*, WS_WI) + (size_t)DQKV * D, 0, scr, r, lane); return; } r -= I_WI;
    if (r < I_WO) { tr_item(kp->in[IN_WO] + (size_t)D * D, D, D, WSP(bf16_t*, WS_WO) + (size_t)D * D, 0, scr, r, lane); return; } r -= I_WO;
    if (r < NE * I_MG) { const int e = r / I_MG; tr_item8(kp->in[IN_MWG] + (size_t)e * D * DFE, D, DFE, WSP(unsigned char*, WS_WGU_M) + (size_t)e * 2 * DFE * D, 1, scr, r - e * I_MG, lane); return; } r -= NE * I_MG;
    if (r < NE * I_MG) { const int e = r / I_MG; tr_item8(kp->in[IN_MWU] + (size_t)e * D * DFE, D, DFE, WSP(unsigned char*, WS_WGU_M) + (size_t)e * 2 * DFE * D, 2, scr, r - e * I_MG, lane); return; } r -= NE * I_MG;
    { const int e = r / I_MD; tr_item8(kp->in[IN_MWD] + (size_t)e * DFE * D, DFE, D, WSP(unsigned char*, WS_WD_M) + (size_t)e * D * DFE, 0, scr, r - e * I_MD, lane); }
}

__device__ __forceinline__ ConvDesc conv_desc_b(KPtr kp, unsigned char* ws, int r) {
    ConvDesc d;
    if (r < I_WI) { d.W = kp->in[IN_WIN] + (size_t)D * DQKV; d.WT = WSP(unsigned char*, WS_WI) + (size_t)DQKV * D * 2; d.K = D; d.N = DQKV; d.mode = 0; d.f8 = 0; d.item = r; return d; } r -= I_WI;
    if (r < I_WO) { d.W = kp->in[IN_WO] + (size_t)D * D; d.WT = WSP(unsigned char*, WS_WO) + (size_t)D * D * 2; d.K = D; d.N = D; d.mode = 0; d.f8 = 0; d.item = r; return d; } r -= I_WO;
    if (r < NE * I_MG) { const int e = r / I_MG; d.W = kp->in[IN_MWG] + (size_t)e * D * DFE; d.WT = WSP(unsigned char*, WS_WGU_M) + (size_t)e * 2 * DFE * D; d.K = D; d.N = DFE; d.mode = 1; d.f8 = 1; d.item = r - e * I_MG; return d; } r -= NE * I_MG;
    if (r < NE * I_MG) { const int e = r / I_MG; d.W = kp->in[IN_MWU] + (size_t)e * D * DFE; d.WT = WSP(unsigned char*, WS_WGU_M) + (size_t)e * 2 * DFE * D; d.K = D; d.N = DFE; d.mode = 2; d.f8 = 1; d.item = r - e * I_MG; return d; } r -= NE * I_MG;
    { const int e = r / I_MD; d.W = kp->in[IN_MWD] + (size_t)e * DFE * D; d.WT = WSP(unsigned char*, WS_WD_M) + (size_t)e * D * DFE; d.K = DFE; d.N = D; d.mode = 0; d.f8 = 1; d.item = r - e * I_MD; return d; }
}

__global__ void __launch_bounds__(NTHREADS, 2) mega_fwd(Params P) {
    const Frame F0 = make_frame();
    unsigned* ctl = (unsigned*)(P.ws + WS_CTL);
    for (int u = F0.tid; u < (LDS_BYTES - MISC_OFF) / 4; u += NTHREADS) ((LAS unsigned*)(F0.lds + MISC_OFF))[u] = 0u;
    __syncthreads();
    const int lo = P.ph_lo, hi = P.ph_hi;
    const bool one_phase = (hi - lo) == 1;
    XcdBarrier bar; bar.bar = ctl + CW_BAR; bar.x = 0; bar.st = nullptr;
    if (!one_phase) bar = xcd_barrier_post(ctl + CW_BAR, F0.MISC + 8);
#ifndef PH_MASK
#define PH_MASK 0x3ffffu
#endif
#ifndef PH_MASK2
#define PH_MASK2 0x3ffffu
#endif
#define IN(k) (((PH_MASK >> ((k) > 8 ? (k) - 8 : (k))) & 1u) != 0u && ((PH_MASK2 >> (k)) & 1u) != 0u && lo <= (k) && (k) < hi)
#define SEAM(k) do { if (IN(k) && IN((k) + 1)) xcd_barrier(bar); } while (0)
#ifndef REP_TYPES
#define REP_TYPES 0
#endif
#ifndef REP_PHASE
#define REP_PHASE -1
#endif
#ifndef REP_COUNT
#define REP_COUNT 2
#endif
#define PH_BEGIN(k) for (int _rep = 0; _rep < (((k) == REP_PHASE) ? REP_COUNT : 1); ++_rep) { if (_rep) xcd_barrier(bar); if (IN(k))
#define PH_END }

    PH_BEGIN(0) {
        PHASE_ARGS(); bf16_t* const WI = WSP(bf16_t*, WS_WI); bf16_t* const WOt = WSP(bf16_t*, WS_WO); bf16_t* const WGUD = WSP(bf16_t*, WS_WGU_D); bf16_t* const WDD = WSP(bf16_t*, WS_WD_D);
        bf16_t* const WGUM = WSP(bf16_t*, WS_WGU_M); bf16_t* const WDM = WSP(bf16_t*, WS_WD_M); bf16_t* const H = WSP(bf16_t*, WS_H);
        if (blockIdx.x < 3 * NH) { float* tbg = WSP(float*, WS_BKT) + blockIdx.x * TBL_N; const int br = blockIdx.x / NH, h = blockIdx.x % NH, dd = br == 0 ? 1 : (br == 1 ? 4 : 16);
            if (F.tid < TBL_N) { const int m_ = 160 - F.tid; tbg[F.tid] = (m_ >= 0 && m_ <= 128) ? kp->in[IN_RELB][t5_bucket(dd * m_) * NH + h] * LOG2E : -1e30f; } }
        LAS float* scr = (LAS float*)(F.lds + F.wave * 16640);
        for (int it = F.gw; it < CONV_A; it += NGW) conv_item(kp, ws, it, scr, F.lane);
        for (int m = F.gw; m < T; m += NGW) rms_row_bf16(kp->in[IN_X] + (size_t)m * D, kp->in[IN_ANG], H + (size_t)m * D, F.lane);
    }
    PH_END SEAM(0);

    for (int layer = 0; layer < 2; ++layer) {
        const int pb = layer == 0 ? 1 : 9;
        PH_BEGIN(pb) {
            PHASE_ARGS(); bf16_t* const H = WSP(bf16_t*, WS_H); bf16_t* const WI = WSP(bf16_t*, WS_WI); bf16_t* const QKV = WSP(bf16_t*, WS_QKV);
            pg8::Gemm g{H, WI + (size_t)layer * DQKV * D, T, DQKV, D}; pg8::StaticOrder S; S.init(T, DQKV, F.G, (int)blockIdx.x);
            pg8::EpiQKV E{QKV};
            pg8::gemm_phase<pg8::EpiQKV, pg8::StaticOrder, true, true>(F.lds, g, S, E, F.tid);
        }
        PH_END SEAM(pb);
        PH_BEGIN(pb + 1) {
            PHASE_ARGS(); bf16_t* const QKV = WSP(bf16_t*, WS_QKV); bf16_t* const OD = WSP(bf16_t*, WS_OD); bf16_t* const OS = WSP(bf16_t*, WS_OS); float* const LSE = WSP(float*, WS_LSE);
            LAS float* tbl = (LAS float*)(F.lds + TBL_OFF);
            { const float* tbg = WSP(const float*, WS_BKT); for (int i = F.tid; i < 3 * NH * TBL_N; i += NTHREADS) tbl[i] = tbg[i]; }
            __syncthreads();
            LAS unsigned char* wl = F.lds + F.wave * 16640;
            const size_t TS = (size_t)T * DH;
            const int cbase = CONV_A + layer * (CONV_B / 2); const int ncv = CONV_B / 2; const int natt = 4 * 4096;
            const int NHW = F.G * 4;
            constexpr int CONV_PER_CWAVE = 36;
            if (F.wave >= 4) {
                const Frame FC = make_frame();
                const int c0 = blockIdx.x * 4 + (F.wave - 4); const int roff = cbase - CONV_A;
                static_assert((CONV_B / 2) == 44 * 1024, "conversion split: 36 items per converting wave + 8 per attention wave");
                const int npair = CONV_PER_CWAVE / 2;
                f32x4 va[16], vb[16];
                ConvDesc da = conv_desc_b(kp, ws, roff + c0), db;
                tr_load(da, va, FC.lane);
                for (int p = 0; p < npair - 1; ++p) {
                    db = conv_desc_b(kp, ws, roff + c0 + (2 * p + 1) * NHW); tr_load(db, vb, FC.lane);
                    tr_finish(da, va, (LAS float*)wl, FC.lane);
                    da = conv_desc_b(kp, ws, roff + c0 + (2 * p + 2) * NHW); tr_load(da, va, FC.lane);
                    tr_finish(db, vb, (LAS float*)wl, FC.lane);
                }
                db = conv_desc_b(kp, ws, roff + c0 + (2 * npair - 1) * NHW); tr_load(db, vb, FC.lane);
                tr_finish(da, va, (LAS float*)wl, FC.lane);
                tr_finish(db, vb, (LAS float*)wl, FC.lane);
            } else {
                const Frame FA = make_frame();
                for (int pass_ = 0; pass_ < (REP_TYPES ? 2 : 1); ++pass_)
                for (int it = blockIdx.x * 4 + F.wave, ai_ = 0; it < natt; it += NHW, ++ai_) {
                    if (pass_ == 0 && (ai_ & 1)) conv_item(kp, ws, cbase + CONV_PER_CWAVE * NHW + (ai_ >> 1) * NHW + blockIdx.x * 4 + F.wave, (LAS float*)wl, FA.lane);
                    if (pass_ == 1 && !((REP_TYPES >> (it >> 12)) & 1)) continue;
                    const int type = it >> 12, idx = it & 4095, bh = idx >> 7, rem = idx & 127, b = bh >> 3, h = bh & 7;
                    const size_t hb = (size_t)(bh * SEQ) * HD;
                    if (type < 3) {
                        const int sh = 2 * type, dil = 1 << sh;
                        const int gps = 128 >> sh, r = rem / gps, qg = rem - r * gps; const int tok0 = b * SEQ + r;
                        const size_t sub = hb + (size_t)r * (SEQ >> sh) * HD;
                        attn_item<0>(wl, QKV + hb + (size_t)r * HD, dil * HD, QKV + (1 + type) * TS + sub, QKV + (4 + type) * TS + sub,
                                     OD + (size_t)type * TS + (size_t)tok0 * DH + h * HD, dil * DH, LSE + (size_t)type * T * NH + (size_t)tok0 * NH + h, dil * NH, tbl + (type * NH + h) * TBL_N, qg, FA.lane);
                    } else {
                        attn_item<1>(wl, QKV + 7 * TS + hb, HD, QKV + 8 * TS + hb, QKV + 9 * TS + hb, OS + (size_t)(b * SEQ) * DH + h * HD, DH, nullptr, 0, nullptr, rem, FA.lane);
                    }
                }
            }
        }
        PH_END SEAM(pb + 1);
        PH_BEGIN(pb + 2) {
            PHASE_ARGS(); bf16_t* const OD = WSP(bf16_t*, WS_OD); bf16_t* const OS = WSP(bf16_t*, WS_OS); float* const LSE = WSP(float*, WS_LSE); bf16_t* const O = WSP(bf16_t*, WS_O);
            const float* gd = kp->in[IN_GDIL] + (size_t)layer * DH; const float* gs = kp->in[IN_GSB] + (size_t)layer * DH;
            for (int t = F.gw; t < T; t += NGW) {
                const int h = F.lane >> 3;
                const float l0 = LSE[(size_t)t * NH + h], l1 = LSE[(size_t)(T + t) * NH + h], l2 = LSE[(size_t)(2 * T + t) * NH + h];
                const float lm = fmaxf(l0, fmaxf(l1, l2)); float w0 = __expf(l0 - lm), w1 = __expf(l1 - lm), w2 = __expf(l2 - lm); const float wi = 1.0f / (w0 + w1 + w2); w0 *= wi; w1 *= wi; w2 *= wi;
                const u32x4* p0 = (const u32x4*)(OD + (size_t)t * DH + 16 * F.lane); const u32x4* p1 = (const u32x4*)(OD + (size_t)(T + t) * DH + 16 * F.lane); const u32x4* p2 = (const u32x4*)(OD + (size_t)(2 * T + t) * DH + 16 * F.lane);
                const u32x4* ps = (const u32x4*)(OS + (size_t)t * DH + 16 * F.lane);
                u32x4 a[2], bq[2], cq[2], sq[2];
#pragma unroll
                for (int k = 0; k < 2; ++k) { a[k] = p0[k]; bq[k] = p1[k]; cq[k] = p2[k]; sq[k] = ps[k]; }
                float vd[16], vs[16]; float ssd = 0.f, sss = 0.f;
#pragma unroll
                for (int k = 0; k < 2; ++k)
#pragma unroll
                    for (int j = 0; j < 4; ++j) {
                        const float d0 = w0 * bf_lo(a[k][j]) + w1 * bf_lo(bq[k][j]) + w2 * bf_lo(cq[k][j]), d1 = w0 * bf_hi(a[k][j]) + w1 * bf_hi(bq[k][j]) + w2 * bf_hi(cq[k][j]);
                        vd[8 * k + 2 * j] = d0; vd[8 * k + 2 * j + 1] = d1; ssd += d0 * d0 + d1 * d1;
                        const float s0 = bf_lo(sq[k][j]), s1 = bf_hi(sq[k][j]); vs[8 * k + 2 * j] = s0; vs[8 * k + 2 * j + 1] = s1; sss += s0 * s0 + s1 * s1; }
                const float rd = 1.0f / sqrtf(wave_sum(ssd) * (1.0f / DH) + EPS), rs = 1.0f / sqrtf(wave_sum(sss) * (1.0f / DH) + EPS);
                const f32x4* gdp = (const f32x4*)(gd + 16 * F.lane); const f32x4* gsp = (const f32x4*)(gs + 16 * F.lane);
                u32x4 od[2], os[2];
#pragma unroll
                for (int k = 0; k < 2; ++k) { const f32x4 ga = gdp[2 * k], gb = gdp[2 * k + 1], ha = gsp[2 * k], hb = gsp[2 * k + 1];
                    od[k].x = pk2(vd[8 * k] * rd * ga.x, vd[8 * k + 1] * rd * ga.y); od[k].y = pk2(vd[8 * k + 2] * rd * ga.z, vd[8 * k + 3] * rd * ga.w);
                    od[k].z = pk2(vd[8 * k + 4] * rd * gb.x, vd[8 * k + 5] * rd * gb.y); od[k].w = pk2(vd[8 * k + 6] * rd * gb.z, vd[8 * k + 7] * rd * gb.w);
                    os[k].x = pk2(vs[8 * k] * rs * ha.x, vs[8 * k + 1] * rs * ha.y); os[k].y = pk2(vs[8 * k + 2] * rs * ha.z, vs[8 * k + 3] * rs * ha.w);
                    os[k].z = pk2(vs[8 * k + 4] * rs * hb.x, vs[8 * k + 5] * rs * hb.y); os[k].w = pk2(vs[8 * k + 6] * rs * hb.z, vs[8 * k + 7] * rs * hb.w); }
                u32x4* o0 = (u32x4*)(O + (size_t)t * D + 16 * F.lane); u32x4* o1 = (u32x4*)(O + (size_t)t * D + DH + 16 * F.lane);
                o0[0] = od[0]; o0[1] = od[1]; o1[0] = os[0]; o1[1] = os[1];
            }
        }
        PH_END SEAM(pb + 2);
        PH_BEGIN(pb + 3) {
            PHASE_ARGS(); bf16_t* const O = WSP(bf16_t*, WS_O); bf16_t* const WOt = WSP(bf16_t*, WS_WO); float* const X = WSP(float*, WS_X);
            pg8::Gemm g{O, WOt + (size_t)layer * D * D, T, D, D}; pg8::StaticOrder S; S.init(T, D, F.G, (int)blockIdx.x);
            pg8::EpiResF32 E{layer == 0 ? kp->in[IN_X] : (const float*)X, X, D};
            pg8::gemm_phase<pg8::EpiResF32, pg8::StaticOrder, true, true>(F.lds, g, S, E, F.tid);
        }
        PH_END SEAM(pb + 3);
        PH_BEGIN(pb + 4) {
            PHASE_ARGS(); float* const X = WSP(float*, WS_X); bf16_t* const H = WSP(bf16_t*, WS_H); int* const SEL = WSP(int*, WS_SEL); float* const GWT = WSP(float*, WS_GW); int* const HIST = WSP(int*, WS_HIST);
            const float* gF = kp->in[IN_FNG] + (size_t)layer * D;
            if (layer == 0) { for (int m = F.gw; m < T; m += NGW) rms_row_bf16(X + (size_t)m * D, gF, H + (size_t)m * D, F.lane); }
            else {
                volatile LAS unsigned* hist = F.MISC + 16;
                const int rows_per_wg = T / F.G, rows_per_wave = rows_per_wg / NWAVES;
                { const f32x4* RW4 = (const f32x4*)kp->in[IN_RW]; LAS f32x4* RL = (LAS f32x4*)F.lds;
                  for (int u = F.tid; u < 4096; u += NTHREADS) { const int ln = u & 63, k = u >> 6, half = k & 1, qi = k >> 1, i = qi & 3, q = qi >> 2; RL[u] = RW4[(4 * (ln + 64 * q) + i) * 2 + half]; } }
                __syncthreads();
                const LAS f32x4* rl = (const LAS f32x4*)F.lds + F.lane;
                for (int j = 0; j < rows_per_wave; ++j) {
                    const int t = blockIdx.x * rows_per_wg + F.wave * rows_per_wave + j;
                    const f32x4* xr = (const f32x4*)(X + (size_t)t * D) + F.lane; const f32x4* gr = (const f32x4*)gF + F.lane;
                    f32x4 v[8]; float ss = 0.f;
#pragma unroll
                    for (int q = 0; q < 8; ++q) { v[q] = xr[64 * q]; ss += dot4(v[q]); }
                    const float rstd = 1.0f / sqrtf(wave_sum(ss) * (1.0f / D) + EPS);
                    float lg[8];
#pragma unroll
                    for (int e = 0; e < 8; ++e) lg[e] = 0.f;
                    unsigned* o8 = (unsigned*)((unsigned char*)H + (size_t)t * D) + F.lane;
#pragma unroll
                    for (int q = 0; q < 8; ++q) { const f32x4 gg = gr[64 * q]; const f32x4 y = {v[q].x * rstd * gg.x, v[q].y * rstd * gg.y, v[q].z * rstd * gg.z, v[q].w * rstd * gg.w};
                        o8[64 * q] = pg8::pk4_fp8(y.x * F8_SH, y.y * F8_SH, y.z * F8_SH, y.w * F8_SH);
#pragma unroll
                        for (int i = 0; i < 4; ++i) { const f32x4 ra = rl[((q * 4 + i) * 2) * 64], rb = rl[((q * 4 + i) * 2 + 1) * 64]; const float yi = y[i];
                            lg[0] += yi * ra.x; lg[1] += yi * ra.y; lg[2] += yi * ra.z; lg[3] += yi * ra.w; lg[4] += yi * rb.x; lg[5] += yi * rb.y; lg[6] += yi * rb.z; lg[7] += yi * rb.w; } }
#pragma unroll
                    for (int e = 0; e < 8; ++e) lg[e] = wave_sum(lg[e]);
                    if (F.lane == 0) {
                        int e1 = 0; float v1 = lg[0];
#pragma unroll
                        for (int e = 1; e < 8; ++e) if (lg[e] > v1) { v1 = lg[e]; e1 = e; }
                        int e2 = -1; float v2 = -3e38f;
#pragma unroll
                        for (int e = 0; e < 8; ++e) if (e != e1 && lg[e] > v2) { v2 = lg[e]; e2 = e; }
                        const float ex = __expf(v2 - v1); const float w1 = 1.0f / (1.0f + ex), w2 = ex * w1;
                        SEL[2 * t] = e1; SEL[2 * t + 1] = e2; GWT[2 * t] = w1; GWT[2 * t + 1] = w2;
                        __hip_atomic_fetch_add((LAS unsigned*)&hist[e1], 1u, __ATOMIC_RELAXED, __HIP_MEMORY_SCOPE_WORKGROUP); __hip_atomic_fetch_add((LAS unsigned*)&hist[e2], 1u, __ATOMIC_RELAXED, __HIP_MEMORY_SCOPE_WORKGROUP);
                    }
                }
                __syncthreads();
                if (F.tid < 8) { HIST[blockIdx.x * 8 + F.tid] = (int)hist[F.tid]; }
            }
        }
        PH_END SEAM(pb + 4);
        if (layer == 0) {
            PH_BEGIN(6) {
                PHASE_ARGS(); bf16_t* const H = WSP(bf16_t*, WS_H); bf16_t* const WGUD = WSP(bf16_t*, WS_WGU_D); bf16_t* const ACT = WSP(bf16_t*, WS_ACT);
                pg8::Gemm g{H, WGUD, T, 2 * DFF, D}; pg8::StaticOrder S; S.init(T, 2 * DFF, F.G, (int)blockIdx.x);
                pg8::EpiSwiGLU E{ACT, DFF, DFF / 128};
                pg8::gemm_phase<pg8::EpiSwiGLU, pg8::StaticOrder, true, true>(F.lds, g, S, E, F.tid);
            }
            PH_END SEAM(6);
            PH_BEGIN(7) {
                PHASE_ARGS(); bf16_t* const ACT = WSP(bf16_t*, WS_ACT); bf16_t* const WDD = WSP(bf16_t*, WS_WD_D); float* const X = WSP(float*, WS_X);
                pg8::Gemm g{ACT, WDD, T, D, DFF}; pg8::StaticOrder S; S.init(T, D, F.G, (int)blockIdx.x);
                pg8::EpiResF32 E{X, X, D};
                pg8::gemm_phase<pg8::EpiResF32, pg8::StaticOrder, true, true>(F.lds, g, S, E, F.tid);
            }
            PH_END SEAM(7);
            PH_BEGIN(8) { PHASE_ARGS(); float* const X = WSP(float*, WS_X); bf16_t* const H = WSP(bf16_t*, WS_H); for (int m = F.gw; m < T; m += NGW) rms_row_bf16(X + (size_t)m * D, kp->in[IN_ANG] + D, H + (size_t)m * D, F.lane); }
            PH_END SEAM(8);
        }
    }
    PH_BEGIN(14) {
        PHASE_ARGS(); bf16_t* const H = WSP(bf16_t*, WS_H); unsigned char* const AS = WSP(unsigned char*, WS_AS); int* const SEL = WSP(int*, WS_SEL); int* const POS = WSP(int*, WS_POS); int* const HIST = WSP(int*, WS_HIST); int* const MOEINFO = WSP(int*, WS_MOEINFO);
        volatile LAS unsigned* tot = F.MISC + 32; volatile LAS unsigned* pre = F.MISC + 40; volatile LAS unsigned* rbase = F.MISC + 48; volatile LAS unsigned* ent = F.MISC + 64;
        if (F.tid < 16) F.MISC[32 + F.tid] = 0u;
        __syncthreads();
        { const int e = F.tid & 7, ch = F.tid >> 3; unsigned st = 0, sp = 0;
#pragma unroll
          for (int k = 0; k < 4; ++k) { const int w = 4 * ch + k; const unsigned hv = (unsigned)HIST[w * 8 + e]; st += hv; if (w < (int)blockIdx.x) sp += hv; }
          __hip_atomic_fetch_add((LAS unsigned*)&tot[e], st, __ATOMIC_RELAXED, __HIP_MEMORY_SCOPE_WORKGROUP); __hip_atomic_fetch_add((LAS unsigned*)&pre[e], sp, __ATOMIC_RELAXED, __HIP_MEMORY_SCOPE_WORKGROUP); }
        __syncthreads();
        if (F.tid == 0) { unsigned tbv = 0;
            for (int e = 0; e < 8; ++e) { rbase[e] = tbv * 256u + pre[e]; if (blockIdx.x == 0) MOEINFO[e] = (int)tbv; tbv += (tot[e] + 255u) >> 8; }
            if (blockIdx.x == 0) MOEINFO[8] = (int)tbv; }
        const int t0 = blockIdx.x * 64;
        if (F.tid < 128) ent[F.tid] = (unsigned)SEL[2 * t0 + F.tid];
        __syncthreads();
        if (F.tid < 128) { const unsigned e = ent[F.tid]; unsigned rank = 0; for (int j = 0; j < F.tid; ++j) rank += (ent[j] == e) ? 1u : 0u;
            const unsigned pos = rbase[e] + rank; POS[2 * t0 + F.tid] = (int)pos; F.MISC[192 + F.tid] = pos; }
        __syncthreads();
        for (int q = 0; q < 16; q += 8) {
            u32x4 v[8][2];
#pragma unroll
            for (int k = 0; k < 8; ++k) { const int en = 16 * F.wave + q + k; const u32x4* src = (const u32x4*)((const unsigned char*)H + (size_t)(t0 + (en >> 1)) * D) + F.lane;
                v[k][0] = src[0]; v[k][1] = src[64]; }
#pragma unroll
            for (int k = 0; k < 8; ++k) { const int en = 16 * F.wave + q + k; u32x4* dst = (u32x4*)(AS + (size_t)F.MISC[192 + en] * D) + F.lane;
                dst[0] = v[k][0]; dst[64] = v[k][1]; }
        }
    }
    PH_END SEAM(14);
    if (IN(15) || IN(16)) {
        PHASE_ARGS(); int* const MOEINFO = WSP(int*, WS_MOEINFO); const bf16_t* const AS = WSP(const bf16_t*, WS_AS); const bf16_t* const WGUM = WSP(const bf16_t*, WS_WGU_M); unsigned char* const ACTM = WSP(unsigned char*, WS_ACTM); const bf16_t* const WDM = WSP(const bf16_t*, WS_WD_M); bf16_t* const Y = WSP(bf16_t*, WS_Y);
        int tbv[9];
#pragma unroll
        for (int k = 0; k < 9; ++k) tbv[k] = __builtin_amdgcn_readfirstlane((int)__hip_atomic_load((unsigned*)MOEINFO + k, __ATOMIC_RELAXED, __HIP_MEMORY_SCOPE_AGENT));
        PH_BEGIN(15) {
            pg8::Gemm g{AS, WGUM, MOE_ROWS, NE * 2 * DFE, D / 2}; pg8::GroupedOrder S; S.init(tbv[8], 2 * DFE / 256, F.G, (int)blockIdx.x);
#pragma unroll
            for (int k = 0; k < 9; ++k) S.tb[k] = tbv[k];
            pg8::EpiSwiGLU8 E{ACTM, DFE, 2 * DFE / 256, 1.0f / (F8_SH * F8_SW), F8_SACT};
            pg8::gemm_phase<pg8::EpiSwiGLU8, pg8::GroupedOrder, true, true, true>(F.lds, g, S, E, F.tid);
        }
        PH_END SEAM(15);
        PH_BEGIN(16) {
            pg8::Gemm g{(const bf16_t*)ACTM, WDM, MOE_ROWS, NE * D, DFE / 2}; pg8::GroupedOrder S; S.init(tbv[8], D / 256, F.G, (int)blockIdx.x);
#pragma unroll
            for (int k = 0; k < 9; ++k) S.tb[k] = tbv[k];
            pg8::EpiBf16G E{Y, D, D / 256};
            pg8::gemm_phase<pg8::EpiBf16G, pg8::GroupedOrder, true, true, true>(F.lds, g, S, E, F.tid);
        } PH_END
    }
    SEAM(16);
    PH_BEGIN(17) {
        PHASE_ARGS(); float* const X = WSP(float*, WS_X); bf16_t* const Y = WSP(bf16_t*, WS_Y); int* const POS = WSP(int*, WS_POS); float* const GWT = WSP(float*, WS_GW);
        const float* gfin = kp->in[IN_FING];
        for (int t = F.gw; t < T; t += NGW) {
            const int p0 = POS[2 * t], p1 = POS[2 * t + 1]; const float w0 = GWT[2 * t] * (1.0f / (F8_SACT * F8_SW)), w1 = GWT[2 * t + 1] * (1.0f / (F8_SACT * F8_SW));
            const f32x4* xr = (const f32x4*)(X + (size_t)t * D) + F.lane; const u32x2* y0 = (const u32x2*)(Y + (size_t)p0 * D) + F.lane; const u32x2* y1 = (const u32x2*)(Y + (size_t)p1 * D) + F.lane;
            f32x4 v[8]; float ss = 0.f;
#pragma unroll
            for (int j = 0; j < 8; ++j) { const f32x4 xv = xr[64 * j]; const u32x2 a = y0[64 * j], b = y1[64 * j];
                v[j].x = xv.x + w0 * bf_lo(a.x) + w1 * bf_lo(b.x); v[j].y = xv.y + w0 * bf_hi(a.x) + w1 * bf_hi(b.x); v[j].z = xv.z + w0 * bf_lo(a.y) + w1 * bf_lo(b.y); v[j].w = xv.w + w0 * bf_hi(a.y) + w1 * bf_hi(b.y);
                ss += dot4(v[j]); }
            const float rstd = 1.0f / sqrtf(wave_sum(ss) * (1.0f / D) + EPS);
            f32x4* orow = (f32x4*)(kp->out + (size_t)t * D) + F.lane; const f32x4* gr = (const f32x4*)gfin + F.lane;
#pragma unroll
            for (int j = 0; j < 8; ++j) { const f32x4 gg = gr[64 * j]; orow[64 * j] = (f32x4){v[j].x * rstd * gg.x, v[j].y * rstd * gg.y, v[j].z * rstd * gg.z, v[j].w * rstd * gg.w}; }
        }
    } PH_END
#undef IN
#undef SEAM
}

#ifndef MK_ONE_LAUNCH
#define MK_ONE_LAUNCH 1
#endif
extern "C" void kernel_launch(void* const* d_in, const int* in_sizes, int n_in, void* d_out, int out_size, void* d_ws, size_t ws_size, hipStream_t stream) {
    static int grid = 0;
    if (grid == 0) {
        if (n_in != 16 || in_sizes[0] != T * D || out_size != T * D || ws_size < WS_END) { fprintf(stderr, "kernel_launch: shape/workspace mismatch (n_in %d, in0 %d, out %d, ws %zu, need %zu)\n", n_in, n_in > 0 ? in_sizes[0] : -1, out_size, ws_size, (size_t)WS_END); grid = -1; return; }
        int dev = 0, cus = 0, per_cu = 0;
        if (hipGetDevice(&dev) != hipSuccess || hipDeviceGetAttribute(&cus, hipDeviceAttributeMultiprocessorCount, dev) != hipSuccess) { grid = -1; return; }
        if (hipFuncSetAttribute((const void*)mega_fwd, hipFuncAttributeMaxDynamicSharedMemorySize, LDS_BYTES) != hipSuccess) { fprintf(stderr, "kernel_launch: hipFuncSetAttribute failed\n"); grid = -1; return; }
        if (hipOccupancyMaxActiveBlocksPerMultiprocessor(&per_cu, (const void*)mega_fwd, NTHREADS, LDS_BYTES) != hipSuccess || per_cu < 1) fprintf(stderr, "kernel_launch: occupancy query says %d\n", per_cu);
        (void)hipGetLastError();
        grid = cus;
        if (grid != 256) { fprintf(stderr, "kernel_launch: built for 256 CUs, found %d\n", cus); grid = -1; return; }
    }
    if (grid < 0) return;
    (void)hipMemsetAsync((char*)d_ws + WS_CTL, 0, CTL_ZERO_BYTES, stream);
    Params p{};
    for (int i = 0; i < 16; ++i) p.in[i] = (const float*)d_in[i];
    p.out = (float*)d_out; p.ws = (unsigned char*)d_ws;
#if MK_ONE_LAUNCH
    p.ph_lo = 0; p.ph_hi = N_PHASES;
    hipLaunchKernelGGL(mega_fwd, dim3(grid), dim3(NTHREADS), LDS_BYTES, stream, p);
#else
    for (int ph = 0; ph < N_PHASES; ++ph) { p.ph_lo = ph; p.ph_hi = ph + 1; hipLaunchKernelGGL(mega_fwd, dim3(grid), dim3(NTHREADS), LDS_BYTES, stream, p); }
#endif
}
```

```cpp
#include <hip/hip_runtime.h>
#include <cstdio>
#include <cstdint>
namespace pg8 {
#define PG8_LAS __attribute__((address_space(3)))
typedef unsigned short bf16_t;
typedef short bf16x8 __attribute__((ext_vector_type(8)));
typedef float f32x4 __attribute__((ext_vector_type(4)));
typedef unsigned u32x4 __attribute__((ext_vector_type(4)));
typedef int i32x4 __attribute__((ext_vector_type(4)));
typedef int v8i32 __attribute__((ext_vector_type(8)));
typedef unsigned u32x2 __attribute__((ext_vector_type(2)));
constexpr int BM = 256, BK = 64, HALF = 128, HTB = HALF * BK * 2  , STAGE_BYTES = 8 * HTB, NXCD = 8, WGM = 8;

__host__ __device__ __forceinline__ int lds_byte(int r, int c) { const int st = (r >> 4) * 2 + (c >> 5), rr = r & 15, cc = c & 31, ob = rr * 64 + cc * 2; return st * 1024 + (ob ^ (((ob >> 9) & 1) << 5)); }
__host__ __device__ __forceinline__ void stage_rc(int b, int& R, int& C) { const int st = b / 1024, sb = b % 1024, swz = sb ^ (((sb >> 9) & 1) << 5); R = (st >> 1) * 16 + swz / 64; C = (st & 1) * 32 + (swz % 64) / 2; }
__host__ __device__ __forceinline__ int perm32(int rho) { const int n = rho >> 4, i = rho & 15; return 8 * (i >> 2) + 4 * n + (i & 3); }

struct Unit { int pm, pn; };
struct Gemm { const bf16_t* A; const bf16_t* Bt; int M, N, K; };

struct StaticOrder {
    int nM, nN, nwg, G, c;
    __host__ __device__ void init(int M, int N, int G_, int c_) { nM = M / BM; nN = N / BM; nwg = nM * nN; G = G_; c = c_; }
    __host__ __device__ bool next(int i, Unit& u) const {
        const long L = (long)i * G + c; if (L >= nwg) return false;
        int wgid = (int)L; { const int q = nwg / NXCD, r = nwg % NXCD, xcd = wgid % NXCD, off = wgid / NXCD; wgid = (xcd < r ? xcd * (q + 1) : r * (q + 1) + (xcd - r) * q) + off; }
        const int nig = WGM * nN, gid = wgid / nig, fm = gid * WGM, gsz = (nM - fm) < WGM ? (nM - fm) : WGM;
        u.pm = fm + ((wgid % nig) % gsz); u.pn = (wgid % nig) / gsz; return true;
    }
    __device__ __forceinline__ void a_ready(const Unit&) const {}
    __device__ __forceinline__ void done(const Unit&) const {}
};

__device__ __forceinline__ unsigned cvt_pk_bf16(float lo, float hi) { unsigned r; asm volatile("v_cvt_pk_bf16_f32 %0, %1, %2" : "=v"(r) : "v"(lo), "v"(hi)); return r; }

struct EpiBf16 {
    static constexpr bool PERM = true, AFTER_DRAIN = false;
    bf16_t* O; int ldc; int split_cols; size_t split_stride; int tpe;
    __device__ __forceinline__ void operator()(const f32x4 (&acc)[2][2][4][2], const Unit& u, int wr, int wc, int fr, int fq) const {
        const int row0 = u.pm * BM + wr * 64 + fr; int colt = (tpe ? (u.pn % tpe) : u.pn) * BM; bf16_t* base = O;
        if (split_cols) { const int t = colt / split_cols; base += (size_t)t * split_stride; colt -= t * split_cols; }
        const int col0 = colt + wc * 32 + 8 * fq;
#pragma unroll
        for (int ai = 0; ai < 2; ++ai)
#pragma unroll
            for (int m = 0; m < 4; ++m) { bf16_t* rowp = base + (size_t)(row0 + ai * HALF + m * 16) * ldc + col0;
#pragma unroll
                for (int bj = 0; bj < 2; ++bj) { const f32x4 v0 = acc[ai][bj][m][0], v1 = acc[ai][bj][m][1];
                    u32x4 w; w.x = cvt_pk_bf16(v0[0], v0[1]); w.y = cvt_pk_bf16(v0[2], v0[3]); w.z = cvt_pk_bf16(v1[0], v1[1]); w.w = cvt_pk_bf16(v1[2], v1[3]);
                    *(u32x4*)(rowp + bj * HALF) = w; } }
    }
};


struct EpiBf16G {
    static constexpr bool PERM = true, AFTER_DRAIN = false;
    bf16_t* O; int ldc; int tpe;
    __device__ __forceinline__ void operator()(const f32x4 (&acc)[2][2][4][2], const Unit& u, int wr, int wc, int fr, int fq) const {
        const unsigned off0 = (unsigned)(u.pm * BM + wr * 64 + fr) * (unsigned)ldc + (unsigned)((u.pn % tpe) * BM + wc * 32 + 8 * fq);
#pragma unroll
        for (int ai = 0; ai < 2; ++ai)
#pragma unroll
            for (int m = 0; m < 4; ++m)
#pragma unroll
                for (int bj = 0; bj < 2; ++bj) { const f32x4 v0 = acc[ai][bj][m][0], v1 = acc[ai][bj][m][1];
                    u32x4 w; w.x = cvt_pk_bf16(v0[0], v0[1]); w.y = cvt_pk_bf16(v0[2], v0[3]); w.z = cvt_pk_bf16(v1[0], v1[1]); w.w = cvt_pk_bf16(v1[2], v1[3]);
                    *(u32x4*)(O + (off0 + (unsigned)((ai * HALF + m * 16) * ldc + bj * HALF))) = w; }
    }
};
struct EpiQKV {
    static constexpr bool PERM = true, AFTER_DRAIN = false;
    bf16_t* O;
    __device__ __forceinline__ void operator()(const f32x4 (&acc)[2][2][4][2], const Unit& u, int wr, int wc, int fr, int fq) const {
        const int t = u.pn >> 2, hp = u.pn & 3; const int m0 = u.pm * BM, b = m0 >> 12, s0 = (m0 & 4095) + wr * 64 + fr;
        const size_t TS = (size_t)16384 * 1024;
        bf16_t* base = O + (size_t)t * TS + wc * 32 + 8 * fq;
#pragma unroll
        for (int ai = 0; ai < 2; ++ai)
#pragma unroll
            for (int m = 0; m < 4; ++m) { const int s = s0 + ai * HALF + m * 16;
#pragma unroll
                for (int bj = 0; bj < 2; ++bj) { const f32x4 v0 = acc[ai][bj][m][0], v1 = acc[ai][bj][m][1];
                    u32x4 w; w.x = cvt_pk_bf16(v0[0], v0[1]); w.y = cvt_pk_bf16(v0[2], v0[3]); w.z = cvt_pk_bf16(v1[0], v1[1]); w.w = cvt_pk_bf16(v1[2], v1[3]);
                    const size_t hb = (size_t)((b * 8 + 2 * hp + bj) * 4096);
                    *(u32x4*)(base + (hb + s) * 128) = w; } }
    }
};
struct EpiResF32 {
    static constexpr bool PERM = false, AFTER_DRAIN = false;
    const float* base; float* out; int ldc; float scale;
    __device__ __forceinline__ void operator()(const f32x4 (&acc)[2][2][4][2], const Unit& u, int wr, int wc, int fr, int fq) const {
        const int row0 = u.pm * BM + wr * 64 + fr, col0 = u.pn * BM + wc * 32 + 4 * fq;
#pragma unroll
        for (int ai = 0; ai < 2; ++ai)
#pragma unroll
            for (int m = 0; m < 4; ++m) { const size_t off = (size_t)(row0 + ai * HALF + m * 16) * ldc + col0;
                f32x4 bs[2][2];
#pragma unroll
                for (int bj = 0; bj < 2; ++bj)
#pragma unroll
                    for (int n = 0; n < 2; ++n) bs[bj][n] = *(const f32x4*)(base + off + bj * HALF + n * 16);
#pragma unroll
                for (int bj = 0; bj < 2; ++bj)
#pragma unroll
                    for (int n = 0; n < 2; ++n) *(f32x4*)(out + off + bj * HALF + n * 16) = bs[bj][n] + acc[ai][bj][m][n] * scale;
                asm volatile("" ::: "memory"); }
    }
};
__device__ __forceinline__ float silu_mul(float g, float u) { return g * u * __builtin_amdgcn_rcpf(1.0f + __builtin_amdgcn_exp2f(g * -1.4426950408889634f)); }
struct EpiSwiGLU {
    static constexpr bool PERM = true, AFTER_DRAIN = false;
    bf16_t* O; int ldc; int tpe;
    __device__ __forceinline__ void operator()(const f32x4 (&acc)[2][2][4][2], const Unit& u, int wr, int wc, int fr, int fq) const {
        const int row0 = u.pm * BM + wr * 64 + fr, col0 = (u.pn % tpe) * HALF + wc * 32 + 8 * fq;
#pragma unroll
        for (int ai = 0; ai < 2; ++ai)
#pragma unroll
            for (int m = 0; m < 4; ++m) { bf16_t* rowp = O + (size_t)(row0 + ai * HALF + m * 16) * ldc + col0;
                const f32x4 g0 = acc[ai][0][m][0], g1 = acc[ai][0][m][1], u0 = acc[ai][1][m][0], u1 = acc[ai][1][m][1];
                u32x4 w; w.x = cvt_pk_bf16(silu_mul(g0[0], u0[0]), silu_mul(g0[1], u0[1])); w.y = cvt_pk_bf16(silu_mul(g0[2], u0[2]), silu_mul(g0[3], u0[3]));
                w.z = cvt_pk_bf16(silu_mul(g1[0], u1[0]), silu_mul(g1[1], u1[1])); w.w = cvt_pk_bf16(silu_mul(g1[2], u1[2]), silu_mul(g1[3], u1[3]));
                *(u32x4*)rowp = w; }
    }
};

__device__ __forceinline__ unsigned pk4_fp8(float a, float b, float c, float d) {
    a = __builtin_amdgcn_fmed3f(a, -448.f, 448.f); b = __builtin_amdgcn_fmed3f(b, -448.f, 448.f); c = __builtin_amdgcn_fmed3f(c, -448.f, 448.f); d = __builtin_amdgcn_fmed3f(d, -448.f, 448.f);
    int p = __builtin_amdgcn_cvt_pk_fp8_f32(a, b, 0, false); p = __builtin_amdgcn_cvt_pk_fp8_f32(c, d, p, true); return (unsigned)p;
}
struct EpiSwiGLU8 {
    static constexpr bool PERM = true, AFTER_DRAIN = false;
    unsigned char* O; int ldc; int tpe; float in_scale, out_scale;
    __device__ __forceinline__ void operator()(const f32x4 (&acc)[2][2][4][2], const Unit& u, int wr, int wc, int fr, int fq) const {
        const int row0 = u.pm * BM + wr * 64 + fr, col0 = (u.pn % tpe) * HALF + wc * 32 + 8 * fq;
#pragma unroll
        for (int ai = 0; ai < 2; ++ai)
#pragma unroll
            for (int m = 0; m < 4; ++m) { unsigned char* rowp = O + (size_t)(row0 + ai * HALF + m * 16) * ldc + col0;
                const f32x4 g0 = acc[ai][0][m][0] * in_scale, g1 = acc[ai][0][m][1] * in_scale, u0 = acc[ai][1][m][0] * (in_scale * out_scale), u1 = acc[ai][1][m][1] * (in_scale * out_scale);
                u32x2 w; w.x = pk4_fp8(silu_mul(g0[0], u0[0]), silu_mul(g0[1], u0[1]), silu_mul(g0[2], u0[2]), silu_mul(g0[3], u0[3]));
                w.y = pk4_fp8(silu_mul(g1[0], u1[0]), silu_mul(g1[1], u1[1]), silu_mul(g1[2], u1[2]), silu_mul(g1[3], u1[3]));
                *(u32x2*)rowp = w; }
    }
};
struct GroupedOrder {
    int nM, nN, nwg, G, c; int tb[9];
    __device__ __forceinline__ void init(int RT, int nN_, int G_, int c_) { nM = RT; nN = nN_; nwg = nM * nN; G = G_; c = c_; }
    __device__ __forceinline__ bool next(int i, Unit& u) const {
        const long L = (long)i * G + c; if (L >= nwg) return false;
        int wgid = (int)L; { const int q = nwg / NXCD, r = nwg % NXCD, xcd = wgid % NXCD, off = wgid / NXCD; wgid = (xcd < r ? xcd * (q + 1) : r * (q + 1) + (xcd - r) * q) + off; }
        const int nig = WGM * nN, gid = wgid / nig, fm = gid * WGM, gsz = (nM - fm) < WGM ? (nM - fm) : WGM;
        const int pm = fm + ((wgid % nig) % gsz), pn = (wgid % nig) / gsz; int e = 0;
#pragma unroll
        for (int k = 1; k < 8; ++k) e += (pm >= tb[k]) ? 1 : 0;
        u.pm = pm; u.pn = e * nN + pn; return true;
    }
    __device__ __forceinline__ void a_ready(const Unit&) const {}
    __device__ __forceinline__ void done(const Unit&) const {}
};
template <class Epi, class Sched, bool ALIGN_EPI = false, bool SP2 = false, bool F8 = false>
__device__ __forceinline__ void gemm_phase(PG8_LAS unsigned char* lds, const Gemm g, const Sched& S, const Epi& E, const int tid) {
    const int wid = __builtin_amdgcn_readfirstlane(tid >> 6), lane = tid & 63, wr = wid >> 2, wc = wid & 3, fr = lane & 15, fq = lane >> 4;
    const int K = g.K, nt = K / BK;
    unsigned voffA[2], voffB[2];
#pragma unroll
    for (int i = 0; i < 2; ++i) { int R, C; stage_rc(tid * 16 + i * 8192, R, C); const int Rb = Epi::PERM ? ((R & ~31) + perm32(R & 31)) : R;
        voffA[i] = (unsigned)(R * K + C) * 2u; voffB[i] = (unsigned)(Rb * K + C) * 2u; }
    const size_t kstep = (size_t)(BK * 2);
    const size_t hstep = (size_t)HALF * K * 2;
    const size_t tstep = 2 * hstep;
    const unsigned ldsw = (unsigned)wid * 1024u;
    const unsigned ldsb = (unsigned)__builtin_amdgcn_readfirstlane((int)((unsigned)(size_t)lds + ldsw));
    const int aoff = lds_byte(wr * 64 + fr, fq * 8), boff = lds_byte(wc * 32 + fr, fq * 8);
#define PG8_SA(b, h) (((b) * 2 + (h)) * HTB)
#define PG8_SB(b, h) ((4 + (b) * 2 + (h)) * HTB)
#define PG8_STAGE(bufoff, gbase, voff) do { _Pragma("unroll") for (int _i = 0; _i < 2; ++_i) { unsigned _keep; \
        asm volatile("s_mov_b32 %0, m0\n\ts_mov_b32 m0, %3\n\ts_nop 0\n\tglobal_load_lds_dwordx4 %1, %2\n\ts_mov_b32 m0, %0" : "=&s"(_keep) : "v"((voff)[_i]), "s"((const char*)(gbase)), "s"(ldsb + (unsigned)((bufoff) + _i * 8192)) : "memory"); } } while (0)
#define PG8_LDA(dst, b, h) do { _Pragma("unroll") for (int m = 0; m < 4; ++m) _Pragma("unroll") for (int k = 0; k < 2; ++k) dst[m][k] = *(const PG8_LAS bf16x8*)(lds + PG8_SA(b, h) + aoff + m * 2048 + k * 1024); } while (0)
#define PG8_LDB(dst, b, h) do { _Pragma("unroll") for (int n = 0; n < 2; ++n) _Pragma("unroll") for (int k = 0; k < 2; ++k) dst[n][k] = *(const PG8_LAS bf16x8*)(lds + PG8_SB(b, h) + boff + n * 2048 + k * 1024); } while (0)
#define PG8_CAT(x) __builtin_bit_cast(v8i32, __builtin_shufflevector(__builtin_bit_cast(i32x4, (x)[0]), __builtin_bit_cast(i32x4, (x)[1]), 0, 1, 2, 3, 4, 5, 6, 7))
#define PG8_MMA(ai, bj, At, Bt) do { __builtin_amdgcn_s_setprio(1); if constexpr (F8) asm volatile("s_nop 4" ::: "memory"); _Pragma("unroll") for (int m = 0; m < 4; ++m) _Pragma("unroll") for (int n = 0; n < 2; ++n) { \
        if constexpr (F8) { asm volatile("v_mfma_scale_f32_16x16x128_f8f6f4 %0, %1, %2, %0, %3, %3 op_sel_hi:[0,0,0]" : "+v"(acc[ai][bj][m][n]) : "v"(PG8_CAT(Bt[n])), "v"(PG8_CAT(At[m])), "v"(f8sc)); } \
        else { _Pragma("unroll") for (int k = 0; k < 2; ++k) acc[ai][bj][m][n] = __builtin_amdgcn_mfma_f32_16x16x32_bf16(Bt[n][k], At[m][k], acc[ai][bj][m][n], 0, 0, 0); } } __builtin_amdgcn_s_setprio(0); } while (0)
#define PG8_WAIT_V(n) asm volatile("s_waitcnt vmcnt(" #n ")" ::: "memory")
#define PG8_WAIT_L(n) asm volatile("s_waitcnt lgkmcnt(" #n ")" ::: "memory")
#define PG8_BAR __builtin_amdgcn_s_barrier()
#define PG8_SCHED __builtin_amdgcn_sched_barrier(0)
    const int f8sc = 0x7f7f7f7f;
    Unit cur, nxt; int ui = 0;
    if (!S.next(0, cur)) return;
    f32x4 acc[2][2][4][2];
#pragma unroll
    for (int a = 0; a < 2; ++a)
#pragma unroll
        for (int b = 0; b < 2; ++b)
#pragma unroll
            for (int m = 0; m < 4; ++m)
#pragma unroll
                for (int n = 0; n < 2; ++n) acc[a][b][m][n] = (f32x4){0.f, 0.f, 0.f, 0.f};
    bf16x8 At[4][2], B0[2][2], B1[2][2];
    const char* cA = (const char*)g.A + (size_t)cur.pm * tstep; const char* cB = (const char*)g.Bt + (size_t)cur.pn * tstep;
    S.a_ready(cur);
    if constexpr (SP2) {
        PG8_STAGE(PG8_SB(0, 0), cB, voffB); PG8_STAGE(PG8_SB(0, 1), cB + hstep, voffB); PG8_STAGE(PG8_SA(0, 0), cA, voffA); PG8_STAGE(PG8_SA(0, 1), cA + hstep, voffA);
        if (wr == 1) PG8_BAR;
        PG8_WAIT_V(2); PG8_BAR;
        PG8_STAGE(PG8_SB(1, 0), cB + kstep, voffB); PG8_STAGE(PG8_SA(1, 0), cA + kstep, voffA); PG8_STAGE(PG8_SB(1, 1), cB + hstep + kstep, voffB);
        PG8_WAIT_V(6); PG8_BAR;
    } else {
        PG8_STAGE(PG8_SB(0, 0), cB, voffB); PG8_STAGE(PG8_SA(0, 0), cA, voffA); PG8_STAGE(PG8_SB(0, 1), cB + hstep, voffB); PG8_STAGE(PG8_SA(0, 1), cA + hstep, voffA);
        if (wr == 1) PG8_BAR;
        PG8_WAIT_V(4); PG8_BAR;
        PG8_STAGE(PG8_SB(1, 0), cB + kstep, voffB); PG8_STAGE(PG8_SA(1, 0), cA + kstep, voffA); PG8_STAGE(PG8_SB(1, 1), cB + hstep + kstep, voffB);
        PG8_WAIT_V(6); PG8_BAR;
    }
    for (;;) {
        const bool has_next = S.next(ui + 1, nxt);
        const char* nA = has_next ? (const char*)g.A + (size_t)nxt.pm * tstep : cA; const char* nB = has_next ? (const char*)g.Bt + (size_t)nxt.pn * tstep : cB;
        for (int t = 0; t < nt; t += 2) {
            const bool last = (t == nt - 2);
            const char* a1 = cA + (size_t)(t + 1) * kstep;
            const char* a2 = last ? nA : cA + (size_t)(t + 2) * kstep; const char* b2 = last ? nB : cB + (size_t)(t + 2) * kstep;
            const char* a3 = a2 + kstep; const char* b3 = b2 + kstep;
            if (last && has_next) S.a_ready(nxt);
            if constexpr (SP2) {
            PG8_LDB(B0, 0, 0); PG8_LDB(B1, 0, 1); PG8_SCHED; PG8_LDA(At, 0, 0); PG8_STAGE(PG8_SA(1, 1), a1 + hstep, voffA);
            PG8_WAIT_V(8); PG8_WAIT_L(0); PG8_BAR; PG8_MMA(0, 0, At, B0); PG8_MMA(0, 1, At, B1); PG8_BAR; PG8_SCHED;
            PG8_LDA(At, 0, 1); PG8_STAGE(PG8_SB(0, 0), b2, voffB); PG8_STAGE(PG8_SB(0, 1), b2 + hstep, voffB); PG8_STAGE(PG8_SA(0, 0), a2, voffA);
            PG8_WAIT_V(8); PG8_WAIT_L(0); PG8_BAR; PG8_MMA(1, 0, At, B0); PG8_MMA(1, 1, At, B1); PG8_BAR; PG8_SCHED;
            PG8_LDB(B0, 1, 0); PG8_LDB(B1, 1, 1); PG8_SCHED; PG8_LDA(At, 1, 0); PG8_STAGE(PG8_SA(0, 1), a2 + hstep, voffA);
            PG8_WAIT_V(8); PG8_WAIT_L(0); PG8_BAR; PG8_MMA(0, 0, At, B0); PG8_MMA(0, 1, At, B1); PG8_BAR; PG8_SCHED;
            PG8_LDA(At, 1, 1); PG8_STAGE(PG8_SB(1, 0), b3, voffB); PG8_STAGE(PG8_SB(1, 1), b3 + hstep, voffB); PG8_STAGE(PG8_SA(1, 0), a3, voffA);
            PG8_WAIT_V(8); PG8_WAIT_L(0); PG8_BAR; PG8_MMA(1, 0, At, B0); PG8_MMA(1, 1, At, B1); PG8_BAR; PG8_SCHED;
            } else {
            PG8_LDB(B0, 0, 0); PG8_SCHED; PG8_LDA(At, 0, 0); PG8_STAGE(PG8_SA(1, 1), a1 + hstep, voffA);
            PG8_WAIT_L(8); PG8_BAR; PG8_WAIT_L(0); PG8_MMA(0, 0, At, B0); PG8_BAR; PG8_SCHED;
            PG8_LDB(B1, 0, 1); PG8_STAGE(PG8_SB(0, 0), b2, voffB);
            PG8_BAR; PG8_WAIT_L(0); PG8_MMA(0, 1, At, B1); PG8_BAR;
            PG8_LDA(At, 0, 1); PG8_STAGE(PG8_SA(0, 0), a2, voffA);
            PG8_BAR; PG8_WAIT_L(0); PG8_MMA(1, 0, At, B0); PG8_BAR; PG8_SCHED;
            PG8_STAGE(PG8_SB(0, 1), b2 + hstep, voffB);
            PG8_WAIT_V(6); PG8_BAR; PG8_MMA(1, 1, At, B1); PG8_BAR;
            PG8_LDB(B0, 1, 0); PG8_SCHED; PG8_LDA(At, 1, 0); PG8_STAGE(PG8_SA(0, 1), a2 + hstep, voffA);
            PG8_WAIT_L(8); PG8_BAR; PG8_WAIT_L(0); PG8_MMA(0, 0, At, B0); PG8_BAR; PG8_SCHED;
            PG8_LDB(B1, 1, 1); PG8_STAGE(PG8_SB(1, 0), b3, voffB);
            PG8_BAR; PG8_WAIT_L(0); PG8_MMA(0, 1, At, B1); PG8_BAR;
            PG8_LDA(At, 1, 1); PG8_STAGE(PG8_SA(1, 0), a3, voffA);
            PG8_BAR; PG8_WAIT_L(0); PG8_MMA(1, 0, At, B0); PG8_BAR; PG8_SCHED;
            PG8_STAGE(PG8_SB(1, 1), b3 + hstep, voffB);
            PG8_WAIT_V(6); PG8_BAR; PG8_MMA(1, 1, At, B1); PG8_BAR;
            }
        }
        if constexpr (ALIGN_EPI) { if (wr == 0) PG8_BAR; }
        if constexpr (F8) asm volatile("s_nop 15\n\ts_nop 15" ::: "memory");
        if constexpr (!Epi::AFTER_DRAIN) { E(acc, cur, wr, wc, fr, fq); S.done(cur); }
        if (!has_next) break;
#pragma unroll
        for (int a = 0; a < 2; ++a)
#pragma unroll
            for (int b = 0; b < 2; ++b)
#pragma unroll
                for (int m = 0; m < 4; ++m)
#pragma unroll
                    for (int n = 0; n < 2; ++n) acc[a][b][m][n] = (f32x4){0.f, 0.f, 0.f, 0.f};
        cur = nxt; cA = nA; cB = nB; ++ui;
        if constexpr (ALIGN_EPI) { if (wr == 1) PG8_BAR; }
    }
    PG8_WAIT_V(0);
    if constexpr (!ALIGN_EPI) { if (wr == 0) PG8_BAR; }
    PG8_BAR;
    if constexpr (Epi::AFTER_DRAIN) { E.fused(acc, cur, wr, wc, fr, fq, lds, wid, lane); S.done(cur); }
#undef PG8_SA
#undef PG8_SB
#undef PG8_STAGE
#undef PG8_LDA
#undef PG8_LDB
#undef PG8_MMA
#undef PG8_CAT
#undef PG8_WAIT_V
#undef PG8_WAIT_L
#undef PG8_BAR
#undef PG8_SCHED
}
}

#define GAS __attribute__((address_space(1)))
#define LAS __attribute__((address_space(3)))
typedef unsigned short bf16_t;
typedef short bf16x8 __attribute__((ext_vector_type(8)));
typedef short s16x4 __attribute__((ext_vector_type(4)));
typedef float f32x4 __attribute__((ext_vector_type(4)));
typedef float f32x16 __attribute__((ext_vector_type(16)));
typedef unsigned u32x4 __attribute__((ext_vector_type(4)));
typedef unsigned u32x2 __attribute__((ext_vector_type(2)));
#define LDS_WAIT() asm volatile("s_waitcnt lgkmcnt(0)" ::: "memory")
#define VM_WAIT() asm volatile("s_waitcnt vmcnt(0)" ::: "memory")
#define SBAR() __builtin_amdgcn_sched_barrier(0)

constexpr int BATCH = 4, SEQ = 4096, T = BATCH * SEQ, D = 2048, NH = 8, HD = 128, DH = NH * HD  , DQKV = 6144;
constexpr int DFF = 5504, DFFP = 5632  , DFE = 7168, NE = 8, MOE_ROWS = 2 * T + NE * 256;
#ifndef DENSE_F8
#define DENSE_F8 0
#endif
constexpr float EPS = 1e-6f;
constexpr int NWAVES = 8, NTHREADS = 512;
constexpr float LOG2E = 1.4426950408889634f, LN2 = 0.6931471805599453f;
constexpr float QSCALE = 0.08838834764831845f;
constexpr float F8_SH = 16.f, F8_SW = 512.f, F8_SACT = 8.f;

constexpr size_t MiB = 1u << 20;
constexpr size_t WS_CTL = 0, CTL_ZERO_BYTES = 1 * MiB;
constexpr size_t WS_BKT = 1 * MiB;
constexpr size_t WS_SEL = 2 * MiB;
constexpr size_t WS_GW = WS_SEL + 256 * 1024;
constexpr size_t WS_POS = WS_GW + 256 * 1024;
constexpr size_t WS_HIST = WS_POS + 256 * 1024;
constexpr size_t WS_MOEINFO = WS_HIST + 64 * 1024;
constexpr size_t WS_LSE = 3 * MiB;
constexpr size_t WS_WI = 8 * MiB;
constexpr size_t WS_WO = WS_WI + 2 * (size_t)DQKV * D * 2;
constexpr size_t WS_WGU_D = WS_WO + 2 * (size_t)D * D * 2;
constexpr size_t WS_WD_D = WS_WGU_D + (size_t)2 * DFF * D * 2;
constexpr size_t WS_WGU_M = WS_WD_D + (size_t)D * DFF * 2 + 512 * 1024;
constexpr size_t WS_WD_M = WS_WGU_M + (size_t)NE * 2 * DFE * D;
constexpr size_t WS_X = WS_WD_M + (size_t)NE * D * DFE;
constexpr size_t WS_H = WS_X + (size_t)T * D * 4;
constexpr size_t WS_R = WS_H + (size_t)T * D * 2;
constexpr size_t WS_QKV = WS_R;
constexpr size_t WS_OD = WS_QKV + (size_t)6 * T * DH * 2;
constexpr size_t WS_OS = WS_OD + (size_t)3 * T * DH * 2;
constexpr size_t WS_O = WS_OS + (size_t)T * DH * 2;
constexpr size_t WS_ACT = WS_R;
constexpr size_t WS_AS = WS_R + (size_t)MOE_ROWS * D * 2;
constexpr size_t WS_ACTM = WS_AS + (size_t)MOE_ROWS * D;
constexpr size_t WS_Y = WS_R;
constexpr size_t WS_END_MOE = WS_ACTM + (size_t)MOE_ROWS * DFE, WS_END_ATT = WS_O + (size_t)T * D * 2, WS_END = WS_END_MOE > WS_END_ATT ? WS_END_MOE : WS_END_ATT;
static_assert(WS_ACT + (size_t)T * DFF * 2 <= WS_END, "region R");
static_assert(WS_END <= 1879048192ull, "workspace");
static_assert(WS_WI % 256 == 0 && WS_WO % 256 == 0 && WS_WGU_D % 256 == 0 && WS_WD_D % 256 == 0 && WS_WGU_M % 256 == 0 && WS_WD_M % 256 == 0 && WS_X % 256 == 0 && WS_H % 256 == 0 && WS_R % 256 == 0 && WS_ACTM % 256 == 0, "alignment");
constexpr int CW_BAR = 4096;

constexpr int SCR_BYTES = 133120;
constexpr int TBL_OFF = SCR_BYTES, TBL_N = 200, TBL_BYTES = 3 * NH * TBL_N * 4;
constexpr int MISC_OFF = 152576;
constexpr int LDS_BYTES = 155648;
static_assert(TBL_OFF + TBL_BYTES <= MISC_OFF && MISC_OFF + 3072 <= LDS_BYTES, "LDS map");

#define XB_TMO      128
#define XB_XCNT(j)  (256  + 64 * (j))
#define XB_XSUB(j)  (1280 + 64 * (j))
#define XB_XGEN(j)  (2304 + 64 * (j))
#define XB_TOP      3328
#define XB_TOPGEN   3392
#define XCD_BAR_WORDS 3456
#define XB_SPIN_CAP (1u << 20)
__device__ __forceinline__ unsigned xb_ld(unsigned* p)              { return __hip_atomic_load(p, __ATOMIC_RELAXED, __HIP_MEMORY_SCOPE_AGENT); }
__device__ __forceinline__ unsigned xb_add(unsigned* p, unsigned v) { return __hip_atomic_fetch_add(p, v, __ATOMIC_RELAXED, __HIP_MEMORY_SCOPE_AGENT); }
__device__ __forceinline__ unsigned xb_xcc_id() { return (unsigned)__builtin_amdgcn_s_getreg((3 << 11) | 20) & 0xFu; }
#define XB_SPIN(cond, bar) do { unsigned _sp = 0; while (cond) { __builtin_amdgcn_s_sleep(1); \
    if ((++_sp & 255u) == 0u) { if (xb_ld(&(bar)[XB_TMO])) break; if (_sp > XB_SPIN_CAP) { atomicAdd(&(bar)[XB_TMO], 1u); break; } } } } while (0)
struct XcdBarrier { unsigned* bar; unsigned x; volatile LAS unsigned* st; };
__device__ __forceinline__ XcdBarrier xcd_barrier_post(unsigned* bar, volatile LAS unsigned* st) {
    XcdBarrier b; b.bar = bar; b.x = xb_xcc_id(); b.st = st;
    if (threadIdx.x == 0) (void)xb_add(&bar[XB_XCNT(b.x)], 1u);
    return b;
}
__device__ __forceinline__ void xcd_barrier_complete(unsigned* bar, unsigned x, unsigned& nloc, unsigned& nx) {
    const unsigned G = gridDim.x * gridDim.y * gridDim.z;
    unsigned sum, cnt, mine, sp = 0u;
    for (;;) {
        sum = 0u; cnt = 0u; mine = 0u;
#pragma unroll
        for (unsigned j = 0; j < 16; ++j) { const unsigned c = xb_ld(&bar[XB_XCNT(j)]); sum += c; cnt += (c > 0u) ? 1u : 0u; mine = (j == x) ? c : mine; }
        if (sum == G) break;
        __builtin_amdgcn_s_sleep(1);
        if ((++sp & 255u) == 0u) { if (xb_ld(&bar[XB_TMO])) break; if (sp > XB_SPIN_CAP) { atomicAdd(&bar[XB_TMO], 1u); break; } }
    }
    nloc = mine > 0u ? mine : 1u; nx = cnt > 0u ? cnt : 1u;
}
__device__ __forceinline__ void xcd_barrier(const XcdBarrier& b) {
    asm volatile("s_waitcnt vmcnt(0)" ::: "memory");
    __syncthreads();
    if (threadIdx.x == 0) {
        unsigned* bar = b.bar;
        __builtin_amdgcn_s_waitcnt(0);
        unsigned nloc = b.st[0], nx = b.st[1];
        if (nloc == 0u) { xcd_barrier_complete(bar, b.x, nloc, nx); b.st[0] = nloc; b.st[1] = nx; }
        const unsigned old = xb_add(&bar[XB_XSUB(b.x)], 1u);
        const unsigned gen = old / nloc;
        if (old + 1u == (gen + 1u) * nloc) {
            __builtin_amdgcn_fence(__ATOMIC_RELEASE, "agent");
            asm volatile("s_waitcnt vmcnt(0)" ::: "memory");
            const unsigned og = xb_add(&bar[XB_TOP], 1u);
            const unsigned tg = og / nx;
            if (og + 1u == (tg + 1u) * nx) xb_add(&bar[XB_TOPGEN], 1u);
            else XB_SPIN(xb_ld(&bar[XB_TOPGEN]) == tg, bar);
            __builtin_amdgcn_fence(__ATOMIC_ACQUIRE, "agent");
            xb_add(&bar[XB_XGEN(b.x)], 1u);
            asm volatile("s_waitcnt vmcnt(0)" ::: "memory");
        } else {
            XB_SPIN(xb_ld(&bar[XB_XGEN(b.x)]) == gen, bar);
            __builtin_amdgcn_fence(__ATOMIC_ACQUIRE, "agent");
            asm volatile("s_waitcnt vmcnt(0)" ::: "memory");
        }
    }
    __syncthreads();
}

__device__ __forceinline__ unsigned pk2(float lo, float hi) { unsigned r; asm volatile("v_cvt_pk_bf16_f32 %0, %1, %2" : "=v"(r) : "v"(lo), "v"(hi)); return r; }
__device__ __forceinline__ float bf_lo(unsigned w) { return __builtin_bit_cast(float, w << 16); }
__device__ __forceinline__ float bf_hi(unsigned w) { return __builtin_bit_cast(float, w & 0xffff0000u); }
__device__ __forceinline__ float wave_sum(float v) {
#pragma unroll
    for (int o = 1; o < 64; o <<= 1) v += __shfl_xor(v, o);
    return v;
}
__device__ __forceinline__ float dot4(f32x4 a) { return (a.x * a.x + a.y * a.y) + (a.z * a.z + a.w * a.w); }

struct Frame {
    LAS unsigned char* lds; volatile LAS unsigned* MISC;
    int tid, lane, wave, gw, G;
};

__device__ __forceinline__ void tr_item(const float* __restrict__ W, int K, int N, bf16_t* __restrict__ WT, int mode, LAS float* scr, int item, int lane) {
    const int nblk = N >> 6, kb = item / nblk, nb = item - kb * nblk, k0 = kb << 6, n0 = nb << 6;
    f32x4 v[16];
    const float* src = W + (size_t)(k0 + (lane >> 4)) * N + n0 + 4 * (lane & 15);
#pragma unroll
    for (int i = 0; i < 16; ++i) v[i] = __builtin_nontemporal_load((const f32x4*)(src + (size_t)(4 * i) * N));
#pragma unroll
    for (int i = 0; i < 16; ++i) { LAS float* d = scr + (4 * i + (lane >> 4)) * 65 + 4 * (lane & 15); d[0] = v[i][0]; d[1] = v[i][1]; d[2] = v[i][2]; d[3] = v[i][3]; }
    LDS_WAIT();
    const int c = lane & 7;
#pragma unroll
    for (int p = 0; p < 8; ++p) { const int n = (lane >> 3) + 8 * p; const LAS float* s = scr + (8 * c) * 65 + n;
        u32x4 o; o.x = pk2(s[0], s[65]); o.y = pk2(s[130], s[195]); o.z = pk2(s[260], s[325]); o.w = pk2(s[390], s[455]);
        const int nn = n0 + n; const int row = mode == 0 ? nn : (((nn >> 7) << 8) + (nn & 127) + (mode == 2 ? 128 : 0));
        *(u32x4*)(WT + (size_t)row * K + k0 + 8 * c) = o; }
    LDS_WAIT();
}
__device__ __forceinline__ void tr_item8(const float* __restrict__ W, int K, int N, unsigned char* __restrict__ WT, int ldk, int mode, LAS float* scr, int item, int lane) {
    const int nblk = N >> 6, kb = item / nblk, nb = item - kb * nblk, k0 = kb << 6, n0 = nb << 6;
    f32x4 v[16];
    const float* src = W + (size_t)(k0 + (lane >> 4)) * N + n0 + 4 * (lane & 15);
#pragma unroll
    for (int i = 0; i < 16; ++i) v[i] = __builtin_nontemporal_load((const f32x4*)(src + (size_t)(4 * i) * N));
#pragma unroll
    for (int i = 0; i < 16; ++i) { LAS float* d = scr + (4 * i + (lane >> 4)) * 65 + 4 * (lane & 15); d[0] = v[i][0]; d[1] = v[i][1]; d[2] = v[i][2]; d[3] = v[i][3]; }
    LDS_WAIT();
    const int c = lane & 7;
#pragma unroll
    for (int p = 0; p < 8; ++p) { const int n = (lane >> 3) + 8 * p; const LAS float* s = scr + (8 * c) * 65 + n;
        u32x2 o; o.x = pg8::pk4_fp8(s[0] * F8_SW, s[65] * F8_SW, s[130] * F8_SW, s[195] * F8_SW); o.y = pg8::pk4_fp8(s[260] * F8_SW, s[325] * F8_SW, s[390] * F8_SW, s[455] * F8_SW);
        const int nn = n0 + n; const int row = mode == 0 ? nn : (((nn >> 7) << 8) + (nn & 127) + (mode == 2 ? 128 : 0));
        *(u32x2*)(WT + (size_t)row * ldk + k0 + 8 * c) = o; }
    LDS_WAIT();
}

struct ConvDesc { const float* W; unsigned char* WT; int K, N, mode, f8, item; };
__device__ __forceinline__ void tr_load(const ConvDesc& d, f32x4 (&v)[16], int lane) {
    const int nblk = d.N >> 6, kb = d.item / nblk, nb = d.item - kb * nblk, k0 = kb << 6, n0 = nb << 6;
    const unsigned voff = (unsigned)(((lane >> 4) * d.N + 4 * (lane & 15)) * 4);
    const char* ub = (const char*)(d.W + (size_t)k0 * d.N + n0);
#pragma unroll
    for (int i = 0; i < 16; ++i) v[i] = __builtin_nontemporal_load((const f32x4*)(ub + (size_t)(4 * i) * d.N * 4 + voff));
}
__device__ __forceinline__ void tr_finish(const ConvDesc& d, const f32x4 (&v)[16], LAS float* scr, int lane) {
    const int nblk = d.N >> 6, kb = d.item / nblk, nb = d.item - kb * nblk, k0 = kb << 6, n0 = nb << 6;
#pragma unroll
    for (int i = 0; i < 16; ++i) { LAS float* q = scr + (4 * i + (lane >> 4)) * 65 + 4 * (lane & 15); q[0] = v[i][0]; q[1] = v[i][1]; q[2] = v[i][2]; q[3] = v[i][3]; }
    LDS_WAIT();
    const int c = lane & 7;
#pragma unroll
    for (int p = 0; p < 8; ++p) { const int n = (lane >> 3) + 8 * p; const LAS float* s = scr + (8 * c) * 65 + n;
        const int nn = n0 + n; const int row = d.mode == 0 ? nn : (((nn >> 7) << 8) + (nn & 127) + (d.mode == 2 ? 128 : 0));
        if (d.f8) { u32x2 o; o.x = pg8::pk4_fp8(s[0] * F8_SW, s[65] * F8_SW, s[130] * F8_SW, s[195] * F8_SW); o.y = pg8::pk4_fp8(s[260] * F8_SW, s[325] * F8_SW, s[390] * F8_SW, s[455] * F8_SW);
            *(u32x2*)(d.WT + (size_t)row * d.K + k0 + 8 * c) = o; }
        else { u32x4 o; o.x = pk2(s[0], s[65]); o.y = pk2(s[130], s[195]); o.z = pk2(s[260], s[325]); o.w = pk2(s[390], s[455]);
            *(u32x4*)(d.WT + ((size_t)row * d.K + k0 + 8 * c) * 2) = o; } }
    LDS_WAIT();
}
__device__ __forceinline__ void rms_row_bf16(const float* xrow, const float* g, bf16_t* orow, int lane) {
    const f32x4* xr = (const f32x4*)xrow + lane; const f32x4* gr = (const f32x4*)g + lane;
    f32x4 v[8]; float ss = 0.f;
#pragma unroll
    for (int j = 0; j < 8; ++j) { v[j] = xr[64 * j]; ss += dot4(v[j]); }
    const float rstd = 1.0f / sqrtf(wave_sum(ss) * (1.0f / D) + EPS);
    u32x2* o8 = (u32x2*)orow + lane;
#pragma unroll
    for (int j = 0; j < 8; ++j) { const f32x4 gg = gr[64 * j]; u32x2 w; w.x = pk2(v[j].x * rstd * gg.x, v[j].y * rstd * gg.y); w.y = pk2(v[j].z * rstd * gg.z, v[j].w * rstd * gg.w); o8[64 * j] = w; }
}
__device__ __forceinline__ int t5_bucket(int n) {
    if (n < 16) return n;
    int b = 16 + (int)(log((double)n / 16.0) / log(128.0) * 16.0);
    return b < 31 ? b : 31;
}

__device__ __forceinline__ void dma_tile_k(const bf16_t* base, size_t row_stride_bytes, LAS unsigned char* dst, const unsigned (&voff)[4]) {
#pragma unroll
    for (int i = 0; i < 8; ++i) {
        const char* ub = (const char*)base + (size_t)(4 * i) * row_stride_bytes;
        __builtin_amdgcn_global_load_lds((const unsigned*)(ub + voff[i & 3]), (LAS unsigned*)(dst + i * 1024), 16, 0, 0);
    }
}
__device__ __forceinline__ void dma_tile_v(const bf16_t* base, size_t row_stride_bytes, LAS unsigned char* dst, unsigned voff) {
#pragma unroll
    for (int i = 0; i < 8; ++i) {
        const char* ub = (const char*)base + (size_t)(4 * i) * row_stride_bytes;
        __builtin_amdgcn_global_load_lds((const unsigned*)(ub + voff), (LAS unsigned*)(dst + i * 1024), 16, 0, 0);
    }
}
#define TRRD(dst, addr, off) asm volatile("ds_read_b64_tr_b16 %0, %1 offset:%2" : "=&v"(dst) : "v"(addr), "i"(off) : "memory")

template <int MODE>
__device__ __forceinline__ void attn_item(LAS unsigned char* wl, const bf16_t* Qh, int qstride, const bf16_t* Kh, const bf16_t* Vh, bf16_t* Op, int ostride, float* lsep, int lstride,
                                          const LAS float* tb, int qg, int lane) {
    const int c = lane & 31, hi = lane >> 5;
    const int i0 = 32 * qg;
    const size_t rstride = (size_t)qstride;
    bf16x8 qf[8];
    { const bf16_t* qrow = Qh + (size_t)(i0 + c) * qstride + 8 * hi;
#pragma unroll
      for (int s = 0; s < 8; ++s) qf[s] = *(const bf16x8*)(qrow + 16 * s); }
    f32x16 o[4];
#pragma unroll
    for (int b = 0; b < 4; ++b)
#pragma unroll
        for (int r = 0; r < 16; ++r) o[b][r] = 0.f;
    float mx = -1e30f, lsum = 0.f, carry = 0.f;
    const int kt_first = MODE == 0 ? (qg > 4 ? qg - 4 : 0) : qg, kt_last = MODE == 0 ? qg : 0, kstep = MODE == 0 ? 1 : -1;
    LAS unsigned char* Kl = wl; LAS unsigned char* Vl = wl + 8192;
    const LAS unsigned char* kbase = Kl + c * 256;
    unsigned vb[4];
    { const int g = lane >> 4, q = (lane & 15) >> 2, p = lane & 3, h = g >> 1;
#pragma unroll
      for (int b = 0; b < 4; ++b) vb[b] = (unsigned)(uintptr_t)Vl + (4 * h + q) * 256 + (((4 * b + 2 * (g & 1) + (p >> 1)) ^ (q << 2)) << 4) + 8 * (p & 1); }
    unsigned voffk[4], voffv;
    { const int rr = lane >> 4, p = lane & 15;
#pragma unroll
      for (int i = 0; i < 4; ++i) voffk[i] = (unsigned)(rr * (int)rstride * 2 + ((p ^ ((4 * i + rr) & 15)) << 4));
      voffv = (unsigned)(rr * (int)rstride * 2 + ((p ^ (rr << 2)) << 4)); }
    dma_tile_k(Kh + (size_t)(32 * kt_first) * rstride, rstride * 2, Kl, voffk);
    dma_tile_v(Vh + (size_t)(32 * kt_first) * rstride, rstride * 2, Vl, voffv);
    bool early = false;
    for (int kt = kt_first;; kt += kstep) {
        const bool has_next = (kt != kt_last);
        const int j0 = 32 * kt;
        asm volatile("s_waitcnt vmcnt(8)" ::: "memory");
        f32x16 S;
#pragma unroll
        for (int r = 0; r < 16; ++r) S[r] = 0.f;
#pragma unroll
        for (int s = 0; s < 8; ++s) {
            const bf16x8 kf = *(const LAS bf16x8*)(kbase + ((((2 * s + hi) ^ (c & 15))) << 4));
            S = __builtin_amdgcn_mfma_f32_32x32x16_bf16(kf, qf[s], S, 0, 0, 0);
        }
        asm volatile("" ::: "memory");
        if (has_next) dma_tile_k(Kh + (size_t)(j0 + 32 * kstep) * rstride, rstride * 2, Kl, voffk);
        bf16x8 pb[2];
        if constexpr (MODE == 0) {
            const int a = 160 - (i0 - j0) - c + 4 * hi;
            const LAS float* tp = tb + a;
            float x[16]; float pm = -3e38f;
#pragma unroll
            for (int r = 0; r < 16; ++r) { x[r] = fmaf(S[r], QSCALE * LOG2E, tp[8 * (r >> 2) + (r & 3)]); pm = fmaxf(pm, x[r]); }
            { auto rr = __builtin_amdgcn_permlane32_swap(__float_as_uint(pm), __float_as_uint(pm), false, false); pm = fmaxf(__uint_as_float(rr[0]), __uint_as_float(rr[1])); }
            const float mn = fmaxf(mx, pm); const float alpha = __builtin_amdgcn_exp2f(mx - mn); mx = mn;
            float ps = 0.f;
#pragma unroll
            for (int r = 0; r < 16; ++r) { x[r] = __builtin_amdgcn_exp2f(x[r] - mn); ps += x[r]; }
            { auto rr = __builtin_amdgcn_permlane32_swap(__float_as_uint(ps), __float_as_uint(ps), false, false); ps = __uint_as_float(rr[0]) + __uint_as_float(rr[1]); }
            lsum = lsum * alpha + ps;
            if (__any(alpha < 1.f)) {
#pragma unroll
                for (int b = 0; b < 4; ++b)
#pragma unroll
                    for (int r = 0; r < 16; ++r) o[b][r] *= alpha;
            }
#pragma unroll
            for (int s = 0; s < 2; ++s) { u32x4 w; w.x = pk2(x[8 * s], x[8 * s + 1]); w.y = pk2(x[8 * s + 2], x[8 * s + 3]); w.z = pk2(x[8 * s + 4], x[8 * s + 5]); w.w = pk2(x[8 * s + 6], x[8 * s + 7]); pb[s] = __builtin_bit_cast(bf16x8, w); }
        } else {
            const bool diag = (j0 == i0);
            float lk[16], ls[16];
#pragma unroll
            for (int r = 0; r < 16; ++r) {
                const float z = S[r] * QSCALE; const float az = fabsf(z);
                const float sp = fmaxf(z, 0.f) + LN2 * __builtin_amdgcn_logf(1.0f + __builtin_amdgcn_exp2f(-az * LOG2E));
                const int key = 8 * (r >> 2) + 4 * hi + (r & 3);
                const bool valid = !diag || key < c;
                lk[r] = valid ? -sp : 0.f; ls[r] = valid ? (z - sp) : -1e30f;
            }
            float gs[4];
#pragma unroll
            for (int g = 0; g < 4; ++g) gs[g] = (lk[4 * g] + lk[4 * g + 1]) + (lk[4 * g + 2] + lk[4 * g + 3]);
            float pg[4];
#pragma unroll
            for (int g = 0; g < 4; ++g) { auto rr = __builtin_amdgcn_permlane32_swap(__float_as_uint(gs[g]), __float_as_uint(gs[g]), false, false); pg[g] = hi ? __uint_as_float(rr[0]) : __uint_as_float(rr[1]); }
            float suf[4]; float run = carry;
#pragma unroll
            for (int g = 3; g >= 0; --g) { if (hi == 0) { suf[g] = run + pg[g]; run = suf[g] + gs[g]; } else { suf[g] = run; run = run + gs[g] + pg[g]; } }
            float av[16];
#pragma unroll
            for (int g = 0; g < 4; ++g) { float lt = suf[g];
#pragma unroll
                for (int e = 3; e >= 0; --e) { av[4 * g + e] = __builtin_amdgcn_exp2f((ls[4 * g + e] + lt) * LOG2E); lt += lk[4 * g + e]; } }
            carry = run;
            early = __all(carry < -105.f);
#pragma unroll
            for (int s = 0; s < 2; ++s) { u32x4 w; w.x = pk2(av[8 * s], av[8 * s + 1]); w.y = pk2(av[8 * s + 2], av[8 * s + 3]); w.z = pk2(av[8 * s + 4], av[8 * s + 5]); w.w = pk2(av[8 * s + 6], av[8 * s + 7]); pb[s] = __builtin_bit_cast(bf16x8, w); }
        }
        if (has_next) asm volatile("s_waitcnt vmcnt(8)" ::: "memory"); else asm volatile("s_waitcnt vmcnt(0)" ::: "memory");
#pragma unroll
        for (int b = 0; b < 4; ++b) {
            s16x4 l0, h0, l1, h1;
            TRRD(l0, vb[b], 0); TRRD(h0, vb[b], 2048); TRRD(l1, vb[b], 4096); TRRD(h1, vb[b], 6144);
            asm volatile("s_waitcnt lgkmcnt(0)" ::: "memory"); SBAR();
            o[b] = __builtin_amdgcn_mfma_f32_32x32x16_bf16((bf16x8){l0[0], l0[1], l0[2], l0[3], h0[0], h0[1], h0[2], h0[3]}, pb[0], o[b], 0, 0, 0);
            o[b] = __builtin_amdgcn_mfma_f32_32x32x16_bf16((bf16x8){l1[0], l1[1], l1[2], l1[3], h1[0], h1[1], h1[2], h1[3]}, pb[1], o[b], 0, 0, 0);
        }
        asm volatile("" ::: "memory");
        if (!has_next || (MODE == 1 && early)) break;
        dma_tile_v(Vh + (size_t)(j0 + 32 * kstep) * rstride, rstride * 2, Vl, voffv);
    }
    if (MODE == 1) VM_WAIT();
    const float inv = MODE == 0 ? __builtin_amdgcn_rcpf(lsum) : 1.0f;
    bf16_t* orow = Op + (size_t)(i0 + c) * ostride + 4 * hi;
#pragma unroll
    for (int b = 0; b < 4; ++b)
#pragma unroll
        for (int g = 0; g < 4; ++g) { u32x2 w; w.x = pk2(o[b][4 * g] * inv, o[b][4 * g + 1] * inv); w.y = pk2(o[b][4 * g + 2] * inv, o[b][4 * g + 3] * inv); *(u32x2*)(orow + 32 * b + 8 * g) = w; }
    if (MODE == 0 && hi == 0) lsep[(size_t)(i0 + c) * lstride] = (mx + __builtin_amdgcn_logf(lsum)) * LN2;
}

struct Params { const float* in[16]; float* out; unsigned char* ws; int ph_lo, ph_hi; };
enum { IN_X = 0, IN_RELB, IN_ANG, IN_WIN, IN_GDIL, IN_GSB, IN_WO, IN_FNG, IN_DWG, IN_DWU, IN_DWD, IN_RW, IN_MWG, IN_MWU, IN_MWD, IN_FING };
constexpr int N_PHASES = 18;

typedef const __attribute__((address_space(4))) Params* KPtr;
__device__ __forceinline__ KPtr kparams() { KPtr p = (KPtr)__builtin_amdgcn_kernarg_segment_ptr(); asm volatile("" : "+s"(p)); return p; }
#define WSP(T, off) ((T)(ws + (off)))
__device__ __forceinline__ Frame make_frame() {
    Frame F; int t = threadIdx.x; asm volatile("" : "+v"(t));
    extern __shared__ __attribute__((aligned(16))) unsigned char lds_raw[];
    F.lds = (LAS unsigned char*)lds_raw; F.MISC = (volatile LAS unsigned*)(F.lds + MISC_OFF);
    F.tid = t; F.lane = t & 63; F.wave = __builtin_amdgcn_readfirstlane(t >> 6); F.G = gridDim.x; F.gw = blockIdx.x * NWAVES + F.wave;
    return F;
}
#define PHASE_ARGS() KPtr kp = kparams(); unsigned char* const ws = kp->ws; (void)ws; const Frame F = make_frame(); const int NGW = F.G * NWAVES; (void)NGW


constexpr int I_WI = (D / 64) * (DQKV / 64), I_WO = (D / 64) * (D / 64), I_DG = (D / 64) * (DFF / 64), I_DD = (DFF / 64) * (D / 64), I_MG = (D / 64) * (DFE / 64), I_MD = (DFE / 64) * (D / 64);
constexpr int CONV_A = I_WI + I_WO + 2 * I_DG + I_DD;
constexpr int CONV_B = I_WI + I_WO + NE * (2 * I_MG + I_MD);
static_assert(CONV_B % 2 == 0, "deferred conversion split");
__device__ __forceinline__ void conv_item(KPtr kp, unsigned char* ws, int it, LAS float* scr, int lane) {
    int r = it;
    if (r < CONV_A) {
        if (r < I_WI) { tr_item(kp->in[IN_WIN], D, DQKV, WSP(bf16_t*, WS_WI), 0, scr, r, lane); return; } r -= I_WI;
        if (r < I_WO) { tr_item(kp->in[IN_WO], D, D, WSP(bf16_t*, WS_WO), 0, scr, r, lane); return; } r -= I_WO;
#if DENSE_F8
        if (r < I_DG) { tr_item8(kp->in[IN_DWG], D, DFF, WSP(unsigned char*, WS_WGU_D), D, 1, scr, r, lane); return; } r -= I_DG;
        if (r < I_DG) { tr_item8(kp->in[IN_DWU], D, DFF, WSP(unsigned char*, WS_WGU_D), D, 2, scr, r, lane); return; } r -= I_DG;
        tr_item8(kp->in[IN_DWD], DFF, D, WSP(unsigned char*, WS_WD_D), DFFP, 0, scr, r, lane); return;
#else
        if (r < I_DG) { tr_item(kp->in[IN_DWG], D, DFF, WSP(bf16_t*, WS_WGU_D), 1, scr, r, lane); return; } r -= I_DG;
        if (r < I_DG) { tr_item(kp->in[IN_DWU], D, DFF, WSP(bf16_t*, WS_WGU_D), 2, scr, r, lane); return; } r -= I_DG;
        tr_item(kp->in[IN_DWD], DFF, D, WSP(bf16_t*, WS_WD_D), 0, scr, r, lane); return;
#endif
    }
    r -= CONV_A;
    if (r < I_WI) { tr_item(kp->in[IN_WIN] + (size_t)D * DQKV, D, DQKV, WSP(bf16_t*, WS_WI) + (size_t)DQKV * D, 0, scr, r, lane); return; } r -= I_WI;
    if (r < I_WO) { tr_item(kp->in[IN_WO] + (size_t)D * D, D, D, WSP(bf16_t*, WS_WO) + (size_t)D * D, 0, scr, r, lane); return; } r -= I_WO;
    if (r < NE * I_MG) { const int e = r / I_MG; tr_item8(kp->in[IN_MWG] + (size_t)e * D * DFE, D, DFE, WSP(unsigned char*, WS_WGU_M) + (size_t)e * 2 * DFE * D, D, 1, scr, r - e * I_MG, lane); return; } r -= NE * I_MG;
    if (r < NE * I_MG) { const int e = r / I_MG; tr_item8(kp->in[IN_MWU] + (size_t)e * D * DFE, D, DFE, WSP(unsigned char*, WS_WGU_M) + (size_t)e * 2 * DFE * D, D, 2, scr, r - e * I_MG, lane); return; } r -= NE * I_MG;
    { const int e = r / I_MD; tr_item8(kp->in[IN_MWD] + (size_t)e * DFE * D, DFE, D, WSP(unsigned char*, WS_WD_M) + (size_t)e * D * DFE, DFE, 0, scr, r - e * I_MD, lane); }
}

__device__ __forceinline__ ConvDesc conv_desc_b(KPtr kp, unsigned char* ws, int r) {
    ConvDesc d;
    if (r < I_WI) { d.W = kp->in[IN_WIN] + (size_t)D * DQKV; d.WT = WSP(unsigned char*, WS_WI) + (size_t)DQKV * D * 2; d.K = D; d.N = DQKV; d.mode = 0; d.f8 = 0; d.item = r; return d; } r -= I_WI;
    if (r < I_WO) { d.W = kp->in[IN_WO] + (size_t)D * D; d.WT = WSP(unsigned char*, WS_WO) + (size_t)D * D * 2; d.K = D; d.N = D; d.mode = 0; d.f8 = 0; d.item = r; return d; } r -= I_WO;
    if (r < NE * I_MG) { const int e = r / I_MG; d.W = kp->in[IN_MWG] + (size_t)e * D * DFE; d.WT = WSP(unsigned char*, WS_WGU_M) + (size_t)e * 2 * DFE * D; d.K = D; d.N = DFE; d.mode = 1; d.f8 = 1; d.item = r - e * I_MG; return d; } r -= NE * I_MG;
    if (r < NE * I_MG) { const int e = r / I_MG; d.W = kp->in[IN_MWU] + (size_t)e * D * DFE; d.WT = WSP(unsigned char*, WS_WGU_M) + (size_t)e * 2 * DFE * D; d.K = D; d.N = DFE; d.mode = 2; d.f8 = 1; d.item = r - e * I_MG; return d; } r -= NE * I_MG;
    { const int e = r / I_MD; d.W = kp->in[IN_MWD] + (size_t)e * DFE * D; d.WT = WSP(unsigned char*, WS_WD_M) + (size_t)e * D * DFE; d.K = DFE; d.N = D; d.mode = 0; d.f8 = 1; d.item = r - e * I_MD; return d; }
}

__global__ void __launch_bounds__(NTHREADS, 2) mega_fwd(Params P) {
    const Frame F0 = make_frame();
    unsigned* ctl = (unsigned*)(P.ws + WS_CTL);
    for (int u = F0.tid; u < (LDS_BYTES - MISC_OFF) / 4; u += NTHREADS) ((LAS unsigned*)(F0.lds + MISC_OFF))[u] = 0u;
    __syncthreads();
    const int lo = P.ph_lo, hi = P.ph_hi;
    const bool one_phase = (hi - lo) == 1;
    XcdBarrier bar; bar.bar = ctl + CW_BAR; bar.x = 0; bar.st = nullptr;
    if (!one_phase) bar = xcd_barrier_post(ctl + CW_BAR, F0.MISC + 8);
#ifndef PH_MASK
#define PH_MASK 0x3ffffu
#endif
#ifndef PH_MASK2
#define PH_MASK2 0x3ffffu
#endif
#define IN(k) (((PH_MASK >> ((k) > 8 ? (k) - 8 : (k))) & 1u) != 0u && ((PH_MASK2 >> (k)) & 1u) != 0u && lo <= (k) && (k) < hi)
#define SEAM(k) do { if (IN(k) && IN((k) + 1)) xcd_barrier(bar); } while (0)
#ifndef REP_TYPES
#define REP_TYPES 0
#endif
#ifndef REP_PHASE
#define REP_PHASE -1
#endif
#ifndef REP_COUNT
#define REP_COUNT 2
#endif
#define PH_BEGIN(k) for (int _rep = 0; _rep < (((k) == REP_PHASE) ? REP_COUNT : 1); ++_rep) { if (_rep) xcd_barrier(bar); if (IN(k))
#define PH_END }

    PH_BEGIN(0) {
        PHASE_ARGS(); bf16_t* const WI = WSP(bf16_t*, WS_WI); bf16_t* const WOt = WSP(bf16_t*, WS_WO); bf16_t* const WGUD = WSP(bf16_t*, WS_WGU_D); bf16_t* const WDD = WSP(bf16_t*, WS_WD_D);
        bf16_t* const WGUM = WSP(bf16_t*, WS_WGU_M); bf16_t* const WDM = WSP(bf16_t*, WS_WD_M); bf16_t* const H = WSP(bf16_t*, WS_H);
        if (blockIdx.x < 3 * NH) { float* tbg = WSP(float*, WS_BKT) + blockIdx.x * TBL_N; const int br = blockIdx.x / NH, h = blockIdx.x % NH, dd = br == 0 ? 1 : (br == 1 ? 4 : 16);
            if (F.tid < TBL_N) { const int m_ = 160 - F.tid; tbg[F.tid] = (m_ >= 0 && m_ <= 128) ? kp->in[IN_RELB][t5_bucket(dd * m_) * NH + h] * LOG2E : -1e30f; } }
        LAS float* scr = (LAS float*)(F.lds + F.wave * 16640);
        for (int it = F.gw; it < CONV_A; it += NGW) conv_item(kp, ws, it, scr, F.lane);
#if DENSE_F8
        { unsigned char* wdd = WSP(unsigned char*, WS_WD_D); for (int i = blockIdx.x * NTHREADS + F.tid; i < D * ((DFFP - DFF) / 16); i += F.G * NTHREADS) { const int row = i >> 3, c = i & 7; *(u32x4*)(wdd + (size_t)row * DFFP + DFF + 16 * c) = (u32x4){0u, 0u, 0u, 0u}; } }
#endif
        for (int m = F.gw; m < T; m += NGW) rms_row_bf16(kp->in[IN_X] + (size_t)m * D, kp->in[IN_ANG], H + (size_t)m * D, F.lane);
    }
    PH_END SEAM(0);

    for (int layer = 0; layer < 2; ++layer) {
        const int pb = layer == 0 ? 1 : 9;
        PH_BEGIN(pb) {
            PHASE_ARGS(); bf16_t* const H = WSP(bf16_t*, WS_H); bf16_t* const WI = WSP(bf16_t*, WS_WI); bf16_t* const QKV = WSP(bf16_t*, WS_QKV);
            pg8::Gemm g{H, WI + (size_t)layer * DQKV * D, T, DQKV, D}; pg8::StaticOrder S; S.init(T, DQKV, F.G, (int)blockIdx.x);
            pg8::EpiQKV E{QKV};
            pg8::gemm_phase<pg8::EpiQKV, pg8::StaticOrder, true, true>(F.lds, g, S, E, F.tid);
        }
        PH_END SEAM(pb);
        PH_BEGIN(pb + 1) {
            PHASE_ARGS(); bf16_t* const QKV = WSP(bf16_t*, WS_QKV); bf16_t* const OD = WSP(bf16_t*, WS_OD); bf16_t* const OS = WSP(bf16_t*, WS_OS); float* const LSE = WSP(float*, WS_LSE);
            LAS float* tbl = (LAS float*)(F.lds + TBL_OFF);
            { const float* tbg = WSP(const float*, WS_BKT); for (int i = F.tid; i < 3 * NH * TBL_N; i += NTHREADS) tbl[i] = tbg[i]; }
            __syncthreads();
            LAS unsigned char* wl = F.lds + F.wave * 16640;
            const size_t TS = (size_t)T * DH;
            const int cbase = CONV_A + layer * (CONV_B / 2); const int ncv = CONV_B / 2; const int natt = 4 * 4096;
            const int NHW = F.G * 4;
            constexpr int CONV_PER_CWAVE = 44;
            if (F.wave >= 4) {
                const Frame FC = make_frame();
                const int c0 = blockIdx.x * 4 + (F.wave - 4); const int roff = cbase - CONV_A;
                static_assert((CONV_B / 2) == 44 * 1024, "conversion split: 44 items per converting wave");
                const int npair = CONV_PER_CWAVE / 2;
                f32x4 va[16], vb[16];
                ConvDesc da = conv_desc_b(kp, ws, roff + c0), db;
                tr_load(da, va, FC.lane);
                for (int p = 0; p < npair - 1; ++p) {
                    db = conv_desc_b(kp, ws, roff + c0 + (2 * p + 1) * NHW); tr_load(db, vb, FC.lane);
                    tr_finish(da, va, (LAS float*)wl, FC.lane);
                    da = conv_desc_b(kp, ws, roff + c0 + (2 * p + 2) * NHW); tr_load(da, va, FC.lane);
                    tr_finish(db, vb, (LAS float*)wl, FC.lane);
                }
                db = conv_desc_b(kp, ws, roff + c0 + (2 * npair - 1) * NHW); tr_load(db, vb, FC.lane);
                tr_finish(da, va, (LAS float*)wl, FC.lane);
                tr_finish(db, vb, (LAS float*)wl, FC.lane);
            } else {
                const Frame FA = make_frame();
                for (int pass_ = 0; pass_ < (REP_TYPES ? 2 : 1); ++pass_)
                for (int it = blockIdx.x * 4 + F.wave, ai_ = 0; it < natt; it += NHW, ++ai_) {
                    if (pass_ == 1 && !((REP_TYPES >> (it >> 12)) & 1)) continue;
                    const int type = it >> 12, idx = it & 4095, bh = idx >> 7, rem = idx & 127, b = bh >> 3, h = bh & 7;
                    const size_t hb = (size_t)(bh * SEQ) * HD;
                    if (type < 3) {
                        const int sh = 2 * type, dil = 1 << sh;
                        const int gps = 128 >> sh, r = rem / gps, qg = rem - r * gps; const int tok0 = b * SEQ + r;
                        const size_t sub = hb + (size_t)r * HD;
                        attn_item<0>(wl, QKV + sub, dil * HD, QKV + TS + sub, QKV + 2 * TS + sub,
                                     OD + (size_t)type * TS + (size_t)tok0 * DH + h * HD, dil * DH, LSE + (size_t)type * T * NH + (size_t)tok0 * NH + h, dil * NH, tbl + (type * NH + h) * TBL_N, qg, FA.lane);
                    } else {
                        attn_item<1>(wl, QKV + 3 * TS + hb, HD, QKV + 4 * TS + hb, QKV + 5 * TS + hb, OS + (size_t)(b * SEQ) * DH + h * HD, DH, nullptr, 0, nullptr, rem, FA.lane);
                    }
                }
            }
        }
        PH_END SEAM(pb + 1);
        PH_BEGIN(pb + 2) {
            PHASE_ARGS(); bf16_t* const OD = WSP(bf16_t*, WS_OD); bf16_t* const OS = WSP(bf16_t*, WS_OS); float* const LSE = WSP(float*, WS_LSE); bf16_t* const O = WSP(bf16_t*, WS_O);
            const float* gd = kp->in[IN_GDIL] + (size_t)layer * DH; const float* gs = kp->in[IN_GSB] + (size_t)layer * DH;
            for (int t = F.gw; t < T; t += NGW) {
                const int h = F.lane >> 3;
                const float l0 = LSE[(size_t)t * NH + h], l1 = LSE[(size_t)(T + t) * NH + h], l2 = LSE[(size_t)(2 * T + t) * NH + h];
                const float lm = fmaxf(l0, fmaxf(l1, l2)); float w0 = __expf(l0 - lm), w1 = __expf(l1 - lm), w2 = __expf(l2 - lm); const float wi = 1.0f / (w0 + w1 + w2); w0 *= wi; w1 *= wi; w2 *= wi;
                const u32x4* p0 = (const u32x4*)(OD + (size_t)t * DH + 16 * F.lane); const u32x4* p1 = (const u32x4*)(OD + (size_t)(T + t) * DH + 16 * F.lane); const u32x4* p2 = (const u32x4*)(OD + (size_t)(2 * T + t) * DH + 16 * F.lane);
                const u32x4* ps = (const u32x4*)(OS + (size_t)t * DH + 16 * F.lane);
                u32x4 a[2], bq[2], cq[2], sq[2];
#pragma unroll
                for (int k = 0; k < 2; ++k) { a[k] = p0[k]; bq[k] = p1[k]; cq[k] = p2[k]; sq[k] = ps[k]; }
                float vd[16], vs[16]; float ssd = 0.f, sss = 0.f;
#pragma unroll
                for (int k = 0; k < 2; ++k)
#pragma unroll
                    for (int j = 0; j < 4; ++j) {
                        const float d0 = w0 * bf_lo(a[k][j]) + w1 * bf_lo(bq[k][j]) + w2 * bf_lo(cq[k][j]), d1 = w0 * bf_hi(a[k][j]) + w1 * bf_hi(bq[k][j]) + w2 * bf_hi(cq[k][j]);
                        vd[8 * k + 2 * j] = d0; vd[8 * k + 2 * j + 1] = d1; ssd += d0 * d0 + d1 * d1;
                        const float s0 = bf_lo(sq[k][j]), s1 = bf_hi(sq[k][j]); vs[8 * k + 2 * j] = s0; vs[8 * k + 2 * j + 1] = s1; sss += s0 * s0 + s1 * s1; }
                const float rd = 1.0f / sqrtf(wave_sum(ssd) * (1.0f / DH) + EPS), rs = 1.0f / sqrtf(wave_sum(sss) * (1.0f / DH) + EPS);
                const f32x4* gdp = (const f32x4*)(gd + 16 * F.lane); const f32x4* gsp = (const f32x4*)(gs + 16 * F.lane);
                u32x4 od[2], os[2];
#pragma unroll
                for (int k = 0; k < 2; ++k) { const f32x4 ga = gdp[2 * k], gb = gdp[2 * k + 1], ha = gsp[2 * k], hb = gsp[2 * k + 1];
                    od[k].x = pk2(vd[8 * k] * rd * ga.x, vd[8 * k + 1] * rd * ga.y); od[k].y = pk2(vd[8 * k + 2] * rd * ga.z, vd[8 * k + 3] * rd * ga.w);
                    od[k].z = pk2(vd[8 * k + 4] * rd * gb.x, vd[8 * k + 5] * rd * gb.y); od[k].w = pk2(vd[8 * k + 6] * rd * gb.z, vd[8 * k + 7] * rd * gb.w);
                    os[k].x = pk2(vs[8 * k] * rs * ha.x, vs[8 * k + 1] * rs * ha.y); os[k].y = pk2(vs[8 * k + 2] * rs * ha.z, vs[8 * k + 3] * rs * ha.w);
                    os[k].z = pk2(vs[8 * k + 4] * rs * hb.x, vs[8 * k + 5] * rs * hb.y); os[k].w = pk2(vs[8 * k + 6] * rs * hb.z, vs[8 * k + 7] * rs * hb.w); }
                u32x4* o0 = (u32x4*)(O + (size_t)t * D + 16 * F.lane); u32x4* o1 = (u32x4*)(O + (size_t)t * D + DH + 16 * F.lane);
                o0[0] = od[0]; o0[1] = od[1]; o1[0] = os[0]; o1[1] = os[1];
            }
        }
        PH_END SEAM(pb + 2);
        PH_BEGIN(pb + 3) {
            PHASE_ARGS(); bf16_t* const O = WSP(bf16_t*, WS_O); bf16_t* const WOt = WSP(bf16_t*, WS_WO); float* const X = WSP(float*, WS_X);
            pg8::Gemm g{O, WOt + (size_t)layer * D * D, T, D, D}; pg8::StaticOrder S; S.init(T, D, F.G, (int)blockIdx.x);
            pg8::EpiResF32 E{layer == 0 ? kp->in[IN_X] : (const float*)X, X, D, 1.0f};
            pg8::gemm_phase<pg8::EpiResF32, pg8::StaticOrder, true, true>(F.lds, g, S, E, F.tid);
        }
        PH_END SEAM(pb + 3);
        PH_BEGIN(pb + 4) {
            PHASE_ARGS(); float* const X = WSP(float*, WS_X); bf16_t* const H = WSP(bf16_t*, WS_H); int* const SEL = WSP(int*, WS_SEL); float* const GWT = WSP(float*, WS_GW); int* const HIST = WSP(int*, WS_HIST);
            const float* gF = kp->in[IN_FNG] + (size_t)layer * D;
#if DENSE_F8
            if (layer == 0) {
                unsigned char* ACT = WSP(unsigned char*, WS_ACT);
                for (int m = F.gw; m < T; m += NGW) {
                    const f32x4* xr = (const f32x4*)(X + (size_t)m * D) + F.lane; const f32x4* gr = (const f32x4*)gF + F.lane;
                    f32x4 v[8]; float ss = 0.f;
#pragma unroll
                    for (int q = 0; q < 8; ++q) { v[q] = xr[64 * q]; ss += dot4(v[q]); }
                    const float rstd = F8_SH / sqrtf(wave_sum(ss) * (1.0f / D) + EPS);
                    unsigned* o8 = (unsigned*)((unsigned char*)H + (size_t)m * D) + F.lane;
#pragma unroll
                    for (int q = 0; q < 8; ++q) { const f32x4 gg = gr[64 * q]; o8[64 * q] = pg8::pk4_fp8(v[q].x * rstd * gg.x, v[q].y * rstd * gg.y, v[q].z * rstd * gg.z, v[q].w * rstd * gg.w); }
                    if (F.lane < (DFFP - DFF) / 16) *(u32x4*)(ACT + (size_t)m * DFFP + DFF + 16 * F.lane) = (u32x4){0u, 0u, 0u, 0u};
                }
            }
#else
            if (layer == 0) { for (int m = F.gw; m < T; m += NGW) rms_row_bf16(X + (size_t)m * D, gF, H + (size_t)m * D, F.lane); }
#endif
            else {
                volatile LAS unsigned* hist = F.MISC + 16;
                const int rows_per_wg = T / F.G, rows_per_wave = rows_per_wg / NWAVES;
                { const f32x4* RW4 = (const f32x4*)kp->in[IN_RW]; LAS f32x4* RL = (LAS f32x4*)F.lds;
                  for (int u = F.tid; u < 4096; u += NTHREADS) { const int ln = u & 63, k = u >> 6, half = k & 1, qi = k >> 1, i = qi & 3, q = qi >> 2; RL[u] = RW4[(4 * (ln + 64 * q) + i) * 2 + half]; } }
                __syncthreads();
                const LAS f32x4* rl = (const LAS f32x4*)F.lds + F.lane;
                for (int j = 0; j < rows_per_wave; ++j) {
                    const int t = blockIdx.x * rows_per_wg + F.wave * rows_per_wave + j;
                    const f32x4* xr = (const f32x4*)(X + (size_t)t * D) + F.lane; const f32x4* gr = (const f32x4*)gF + F.lane;
                    f32x4 v[8]; float ss = 0.f;
#pragma unroll
                    for (int q = 0; q < 8; ++q) { v[q] = xr[64 * q]; ss += dot4(v[q]); }
                    const float rstd = 1.0f / sqrtf(wave_sum(ss) * (1.0f / D) + EPS);
                    float lg[8];
#pragma unroll
                    for (int e = 0; e < 8; ++e) lg[e] = 0.f;
                    unsigned* o8 = (unsigned*)((unsigned char*)H + (size_t)t * D) + F.lane;
#pragma unroll
                    for (int q = 0; q < 8; ++q) { const f32x4 gg = gr[64 * q]; const f32x4 y = {v[q].x * rstd * gg.x, v[q].y * rstd * gg.y, v[q].z * rstd * gg.z, v[q].w * rstd * gg.w};
                        o8[64 * q] = pg8::pk4_fp8(y.x * F8_SH, y.y * F8_SH, y.z * F8_SH, y.w * F8_SH);
#pragma unroll
                        for (int i = 0; i < 4; ++i) { const f32x4 ra = rl[((q * 4 + i) * 2) * 64], rb = rl[((q * 4 + i) * 2 + 1) * 64]; const float yi = y[i];
                            lg[0] += yi * ra.x; lg[1] += yi * ra.y; lg[2] += yi * ra.z; lg[3] += yi * ra.w; lg[4] += yi * rb.x; lg[5] += yi * rb.y; lg[6] += yi * rb.z; lg[7] += yi * rb.w; } }
#pragma unroll
                    for (int e = 0; e < 8; ++e) lg[e] = wave_sum(lg[e]);
                    if (F.lane == 0) {
                        int e1 = 0; float v1 = lg[0];
#pragma unroll
                        for (int e = 1; e < 8; ++e) if (lg[e] > v1) { v1 = lg[e]; e1 = e; }
                        int e2 = -1; float v2 = -3e38f;
#pragma unroll
                        for (int e = 0; e < 8; ++e) if (e != e1 && lg[e] > v2) { v2 = lg[e]; e2 = e; }
                        const float ex = __expf(v2 - v1); const float w1 = 1.0f / (1.0f + ex), w2 = ex * w1;
                        SEL[2 * t] = e1; SEL[2 * t + 1] = e2; GWT[2 * t] = w1; GWT[2 * t + 1] = w2;
                        __hip_atomic_fetch_add((LAS unsigned*)&hist[e1], 1u, __ATOMIC_RELAXED, __HIP_MEMORY_SCOPE_WORKGROUP); __hip_atomic_fetch_add((LAS unsigned*)&hist[e2], 1u, __ATOMIC_RELAXED, __HIP_MEMORY_SCOPE_WORKGROUP);
                    }
                }
                __syncthreads();
                if (F.tid < 8) { HIST[blockIdx.x * 8 + F.tid] = (int)hist[F.tid]; }
            }
        }
        PH_END SEAM(pb + 4);
        if (layer == 0) {
#if DENSE_F8
            PH_BEGIN(6) {
                PHASE_ARGS(); const bf16_t* const H = WSP(const bf16_t*, WS_H); const bf16_t* const WGUD = WSP(const bf16_t*, WS_WGU_D); unsigned char* const ACT = WSP(unsigned char*, WS_ACT);
                pg8::Gemm g{H, WGUD, T, 2 * DFF, D / 2}; pg8::StaticOrder S; S.init(T, 2 * DFF, F.G, (int)blockIdx.x);
                pg8::EpiSwiGLU8 E{ACT, DFFP, DFF / 128, 1.0f / (F8_SH * F8_SW), F8_SACT};
                pg8::gemm_phase<pg8::EpiSwiGLU8, pg8::StaticOrder, true, true, true>(F.lds, g, S, E, F.tid);
            }
            PH_END SEAM(6);
            PH_BEGIN(7) {
                PHASE_ARGS(); const bf16_t* const ACT = WSP(const bf16_t*, WS_ACT); const bf16_t* const WDD = WSP(const bf16_t*, WS_WD_D); float* const X = WSP(float*, WS_X);
                pg8::Gemm g{ACT, WDD, T, D, DFFP / 2}; pg8::StaticOrder S; S.init(T, D, F.G, (int)blockIdx.x);
                pg8::EpiResF32 E{X, X, D, 1.0f / (F8_SACT * F8_SW)};
                pg8::gemm_phase<pg8::EpiResF32, pg8::StaticOrder, true, true, true>(F.lds, g, S, E, F.tid);
            }
#else
            PH_BEGIN(6) {
                PHASE_ARGS(); bf16_t* const H = WSP(bf16_t*, WS_H); bf16_t* const WGUD = WSP(bf16_t*, WS_WGU_D); bf16_t* const ACT = WSP(bf16_t*, WS_ACT);
                pg8::Gemm g{H, WGUD, T, 2 * DFF, D}; pg8::StaticOrder S; S.init(T, 2 * DFF, F.G, (int)blockIdx.x);
                pg8::EpiSwiGLU E{ACT, DFF, DFF / 128};
                pg8::gemm_phase<pg8::EpiSwiGLU, pg8::StaticOrder, true, true>(F.lds, g, S, E, F.tid);
            }
            PH_END SEAM(6);
            PH_BEGIN(7) {
                PHASE_ARGS(); bf16_t* const ACT = WSP(bf16_t*, WS_ACT); bf16_t* const WDD = WSP(bf16_t*, WS_WD_D); float* const X = WSP(float*, WS_X);
                pg8::Gemm g{ACT, WDD, T, D, DFF}; pg8::StaticOrder S; S.init(T, D, F.G, (int)blockIdx.x);
                pg8::EpiResF32 E{X, X, D, 1.0f};
                pg8::gemm_phase<pg8::EpiResF32, pg8::StaticOrder, true, true>(F.lds, g, S, E, F.tid);
            }
#endif
            PH_END SEAM(7);
            PH_BEGIN(8) { PHASE_ARGS(); float* const X = WSP(float*, WS_X); bf16_t* const H = WSP(bf16_t*, WS_H); for (int m = F.gw; m < T; m += NGW) rms_row_bf16(X + (size_t)m * D, kp->in[IN_ANG] + D, H + (size_t)m * D, F.lane); }
            PH_END SEAM(8);
        }
    }
    PH_BEGIN(14) {
        PHASE_ARGS(); bf16_t* const H = WSP(bf16_t*, WS_H); unsigned char* const AS = WSP(unsigned char*, WS_AS); int* const SEL = WSP(int*, WS_SEL); int* const POS = WSP(int*, WS_POS); int* const HIST = WSP(int*, WS_HIST); int* const MOEINFO = WSP(int*, WS_MOEINFO);
        volatile LAS unsigned* tot = F.MISC + 32; volatile LAS unsigned* pre = F.MISC + 40; volatile LAS unsigned* rbase = F.MISC + 48; volatile LAS unsigned* ent = F.MISC + 64;
        if (F.tid < 16) F.MISC[32 + F.tid] = 0u;
        __syncthreads();
        { const int e = F.tid & 7, ch = F.tid >> 3; unsigned st = 0, sp = 0;
#pragma unroll
          for (int k = 0; k < 4; ++k) { const int w = 4 * ch + k; const unsigned hv = (unsigned)HIST[w * 8 + e]; st += hv; if (w < (int)blockIdx.x) sp += hv; }
          __hip_atomic_fetch_add((LAS unsigned*)&tot[e], st, __ATOMIC_RELAXED, __HIP_MEMORY_SCOPE_WORKGROUP); __hip_atomic_fetch_add((LAS unsigned*)&pre[e], sp, __ATOMIC_RELAXED, __HIP_MEMORY_SCOPE_WORKGROUP); }
        __syncthreads();
        if (F.tid == 0) { unsigned tbv = 0;
            for (int e = 0; e < 8; ++e) { rbase[e] = tbv * 256u + pre[e]; if (blockIdx.x == 0) MOEINFO[e] = (int)tbv; tbv += (tot[e] + 255u) >> 8; }
            if (blockIdx.x == 0) MOEINFO[8] = (int)tbv; }
        const int t0 = blockIdx.x * 64;
        if (F.tid < 128) ent[F.tid] = (unsigned)SEL[2 * t0 + F.tid];
        __syncthreads();
        if (F.tid < 128) { const unsigned e = ent[F.tid]; unsigned rank = 0; for (int j = 0; j < F.tid; ++j) rank += (ent[j] == e) ? 1u : 0u;
            const unsigned pos = rbase[e] + rank; POS[2 * t0 + F.tid] = (int)pos; F.MISC[192 + F.tid] = pos; }
        __syncthreads();
        for (int q = 0; q < 16; q += 8) {
            u32x4 v[8][2];
#pragma unroll
            for (int k = 0; k < 8; ++k) { const int en = 16 * F.wave + q + k; const u32x4* src = (const u32x4*)((const unsigned char*)H + (size_t)(t0 + (en >> 1)) * D) + F.lane;
                v[k][0] = src[0]; v[k][1] = src[64]; }
#pragma unroll
            for (int k = 0; k < 8; ++k) { const int en = 16 * F.wave + q + k; u32x4* dst = (u32x4*)(AS + (size_t)F.MISC[192 + en] * D) + F.lane;
                dst[0] = v[k][0]; dst[64] = v[k][1]; }
        }
    }
    PH_END SEAM(14);
    if (IN(15) || IN(16)) {
        PHASE_ARGS(); int* const MOEINFO = WSP(int*, WS_MOEINFO); const bf16_t* const AS = WSP(const bf16_t*, WS_AS); const bf16_t* const WGUM = WSP(const bf16_t*, WS_WGU_M); unsigned char* const ACTM = WSP(unsigned char*, WS_ACTM); const bf16_t* const WDM = WSP(const bf16_t*, WS_WD_M); bf16_t* const Y = WSP(bf16_t*, WS_Y);
        int tbv[9];
#pragma unroll
        for (int k = 0; k < 9; ++k) tbv[k] = __builtin_amdgcn_readfirstlane((int)__hip_atomic_load((unsigned*)MOEINFO + k, __ATOMIC_RELAXED, __HIP_MEMORY_SCOPE_AGENT));
        PH_BEGIN(15) {
            pg8::Gemm g{AS, WGUM, MOE_ROWS, NE * 2 * DFE, D / 2}; pg8::GroupedOrder S; S.init(tbv[8], 2 * DFE / 256, F.G, (int)blockIdx.x);
#pragma unroll
            for (int k = 0; k < 9; ++k) S.tb[k] = tbv[k];
            pg8::EpiSwiGLU8 E{ACTM, DFE, 2 * DFE / 256, 1.0f / (F8_SH * F8_SW), F8_SACT};
            pg8::gemm_phase<pg8::EpiSwiGLU8, pg8::GroupedOrder, true, true, true>(F.lds, g, S, E, F.tid);
        }
        PH_END SEAM(15);
        PH_BEGIN(16) {
            pg8::Gemm g{(const bf16_t*)ACTM, WDM, MOE_ROWS, NE * D, DFE / 2}; pg8::GroupedOrder S; S.init(tbv[8], D / 256, F.G, (int)blockIdx.x);
#pragma unroll
            for (int k = 0; k < 9; ++k) S.tb[k] = tbv[k];
            pg8::EpiBf16G E{Y, D, D / 256};
            pg8::gemm_phase<pg8::EpiBf16G, pg8::GroupedOrder, true, true, true>(F.lds, g, S, E, F.tid);
        } PH_END
    }
    SEAM(16);
    PH_BEGIN(17) {
        PHASE_ARGS(); float* const X = WSP(float*, WS_X); bf16_t* const Y = WSP(bf16_t*, WS_Y); int* const POS = WSP(int*, WS_POS); float* const GWT = WSP(float*, WS_GW);
        const float* gfin = kp->in[IN_FING];
        for (int t = F.gw; t < T; t += NGW) {
            const int p0 = POS[2 * t], p1 = POS[2 * t + 1]; const float w0 = GWT[2 * t] * (1.0f / (F8_SACT * F8_SW)), w1 = GWT[2 * t + 1] * (1.0f / (F8_SACT * F8_SW));
            const f32x4* xr = (const f32x4*)(X + (size_t)t * D) + F.lane; const u32x2* y0 = (const u32x2*)(Y + (size_t)p0 * D) + F.lane; const u32x2* y1 = (const u32x2*)(Y + (size_t)p1 * D) + F.lane;
            f32x4 v[8]; float ss = 0.f;
#pragma unroll
            for (int j = 0; j < 8; ++j) { const f32x4 xv = xr[64 * j]; const u32x2 a = y0[64 * j], b = y1[64 * j];
                v[j].x = xv.x + w0 * bf_lo(a.x) + w1 * bf_lo(b.x); v[j].y = xv.y + w0 * bf_hi(a.x) + w1 * bf_hi(b.x); v[j].z = xv.z + w0 * bf_lo(a.y) + w1 * bf_lo(b.y); v[j].w = xv.w + w0 * bf_hi(a.y) + w1 * bf_hi(b.y);
                ss += dot4(v[j]); }
            const float rstd = 1.0f / sqrtf(wave_sum(ss) * (1.0f / D) + EPS);
            f32x4* orow = (f32x4*)(kp->out + (size_t)t * D) + F.lane; const f32x4* gr = (const f32x4*)gfin + F.lane;
#pragma unroll
            for (int j = 0; j < 8; ++j) { const f32x4 gg = gr[64 * j]; orow[64 * j] = (f32x4){v[j].x * rstd * gg.x, v[j].y * rstd * gg.y, v[j].z * rstd * gg.z, v[j].w * rstd * gg.w}; }
        }
    } PH_END
#undef IN
#undef SEAM
}

#ifndef MK_ONE_LAUNCH
#define MK_ONE_LAUNCH 1
#endif
extern "C" void kernel_launch(void* const* d_in, const int* in_sizes, int n_in, void* d_out, int out_size, void* d_ws, size_t ws_size, hipStream_t stream) {
    static int grid = 0;
    if (grid == 0) {
        if (n_in != 16 || in_sizes[0] != T * D || out_size != T * D || ws_size < WS_END) { fprintf(stderr, "kernel_launch: shape/workspace mismatch (n_in %d, in0 %d, out %d, ws %zu, need %zu)\n", n_in, n_in > 0 ? in_sizes[0] : -1, out_size, ws_size, (size_t)WS_END); grid = -1; return; }
        int dev = 0, cus = 0, per_cu = 0;
        if (hipGetDevice(&dev) != hipSuccess || hipDeviceGetAttribute(&cus, hipDeviceAttributeMultiprocessorCount, dev) != hipSuccess) { grid = -1; return; }
        if (hipFuncSetAttribute((const void*)mega_fwd, hipFuncAttributeMaxDynamicSharedMemorySize, LDS_BYTES) != hipSuccess) { fprintf(stderr, "kernel_launch: hipFuncSetAttribute failed\n"); grid = -1; return; }
        if (hipOccupancyMaxActiveBlocksPerMultiprocessor(&per_cu, (const void*)mega_fwd, NTHREADS, LDS_BYTES) != hipSuccess || per_cu < 1) fprintf(stderr, "kernel_launch: occupancy query says %d\n", per_cu);
        (void)hipGetLastError();
        grid = cus;
        if (grid != 256) { fprintf(stderr, "kernel_launch: built for 256 CUs, found %d\n", cus); grid = -1; return; }
    }
    if (grid < 0) return;
    (void)hipMemsetAsync((char*)d_ws + WS_CTL, 0, CTL_ZERO_BYTES, stream);
    Params p{};
    for (int i = 0; i < 16; ++i) p.in[i] = (const float*)d_in[i];
    p.out = (float*)d_out; p.ws = (unsigned char*)d_ws;
#if MK_ONE_LAUNCH
    p.ph_lo = 0; p.ph_hi = N_PHASES;
    hipLaunchKernelGGL(mega_fwd, dim3(grid), dim3(NTHREADS), LDS_BYTES, stream, p);
#else
    for (int ph = 0; ph < N_PHASES; ++ph) { p.ph_lo = ph; p.ph_hi = ph + 1; hipLaunchKernelGGL(mega_fwd, dim3(grid), dim3(NTHREADS), LDS_BYTES, stream, p); }
#endif
}
```

```cpp
#define DENSE_F8 0
#include <hip/hip_runtime.h>
#include <cstdio>
#include <cstdint>
namespace pg8 {
#define PG8_LAS __attribute__((address_space(3)))
typedef unsigned short bf16_t;
typedef short bf16x8 __attribute__((ext_vector_type(8)));
typedef float f32x4 __attribute__((ext_vector_type(4)));
typedef unsigned u32x4 __attribute__((ext_vector_type(4)));
typedef int i32x4 __attribute__((ext_vector_type(4)));
typedef int v8i32 __attribute__((ext_vector_type(8)));
typedef unsigned u32x2 __attribute__((ext_vector_type(2)));
constexpr int BM = 256, BK = 64, HALF = 128, HTB = HALF * BK * 2  , STAGE_BYTES = 8 * HTB, NXCD = 8, WGM = 8;

__host__ __device__ __forceinline__ int lds_byte(int r, int c) { const int st = (r >> 4) * 2 + (c >> 5), rr = r & 15, cc = c & 31, ob = rr * 64 + cc * 2; return st * 1024 + (ob ^ (((ob >> 9) & 1) << 5)); }
__host__ __device__ __forceinline__ void stage_rc(int b, int& R, int& C) { const int st = b / 1024, sb = b % 1024, swz = sb ^ (((sb >> 9) & 1) << 5); R = (st >> 1) * 16 + swz / 64; C = (st & 1) * 32 + (swz % 64) / 2; }
__host__ __device__ __forceinline__ int perm32(int rho) { const int n = rho >> 4, i = rho & 15; return 8 * (i >> 2) + 4 * n + (i & 3); }

struct Unit { int pm, pn, ko; };
struct Gemm { const bf16_t* A; const bf16_t* Bt; int M, N, K; };

struct StaticOrder {
    static constexpr bool SPLITK = false;
    int nM, nN, nwg, G, c;
    __host__ __device__ void init(int M, int N, int G_, int c_) { nM = M / BM; nN = N / BM; nwg = nM * nN; G = G_; c = c_; }
    __host__ __device__ bool next(int i, Unit& u) const {
        const long L = (long)i * G + c; if (L >= nwg) return false;
        int wgid = (int)L; { const int q = nwg / NXCD, r = nwg % NXCD, xcd = wgid % NXCD, off = wgid / NXCD; wgid = (xcd < r ? xcd * (q + 1) : r * (q + 1) + (xcd - r) * q) + off; }
        const int nig = WGM * nN, gid = wgid / nig, fm = gid * WGM, gsz = (nM - fm) < WGM ? (nM - fm) : WGM;
        u.pm = fm + ((wgid % nig) % gsz); u.pn = (wgid % nig) / gsz; return true;
    }
    __device__ __forceinline__ void a_ready(const Unit&) const {}
    __device__ __forceinline__ void done(const Unit&) const {}
};

__device__ __forceinline__ unsigned cvt_pk_bf16(float lo, float hi) { unsigned r; asm volatile("v_cvt_pk_bf16_f32 %0, %1, %2" : "=v"(r) : "v"(lo), "v"(hi)); return r; }

struct EpiBf16 {
    static constexpr bool PERM = true, AFTER_DRAIN = false;
    bf16_t* O; int ldc; int split_cols; size_t split_stride; int tpe;
    __device__ __forceinline__ void operator()(const f32x4 (&acc)[2][2][4][2], const Unit& u, int wr, int wc, int fr, int fq) const {
        const int row0 = u.pm * BM + wr * 64 + fr; int colt = (tpe ? (u.pn % tpe) : u.pn) * BM; bf16_t* base = O;
        if (split_cols) { const int t = colt / split_cols; base += (size_t)t * split_stride; colt -= t * split_cols; }
        const int col0 = colt + wc * 32 + 8 * fq;
#pragma unroll
        for (int ai = 0; ai < 2; ++ai)
#pragma unroll
            for (int m = 0; m < 4; ++m) { bf16_t* rowp = base + (size_t)(row0 + ai * HALF + m * 16) * ldc + col0;
#pragma unroll
                for (int bj = 0; bj < 2; ++bj) { const f32x4 v0 = acc[ai][bj][m][0], v1 = acc[ai][bj][m][1];
                    u32x4 w; w.x = cvt_pk_bf16(v0[0], v0[1]); w.y = cvt_pk_bf16(v0[2], v0[3]); w.z = cvt_pk_bf16(v1[0], v1[1]); w.w = cvt_pk_bf16(v1[2], v1[3]);
                    *(u32x4*)(rowp + bj * HALF) = w; } }
    }
};


struct EpiBf16G {
    static constexpr bool PERM = true, AFTER_DRAIN = false;
    bf16_t* O; int ldc; int tpe;
    __device__ __forceinline__ void operator()(const f32x4 (&acc)[2][2][4][2], const Unit& u, int wr, int wc, int fr, int fq) const {
        const unsigned off0 = (unsigned)(u.pm * BM + wr * 64 + fr) * (unsigned)ldc + (unsigned)((u.pn % tpe) * BM + wc * 32 + 8 * fq);
#pragma unroll
        for (int ai = 0; ai < 2; ++ai)
#pragma unroll
            for (int m = 0; m < 4; ++m)
#pragma unroll
                for (int bj = 0; bj < 2; ++bj) { const f32x4 v0 = acc[ai][bj][m][0], v1 = acc[ai][bj][m][1];
                    u32x4 w; w.x = cvt_pk_bf16(v0[0], v0[1]); w.y = cvt_pk_bf16(v0[2], v0[3]); w.z = cvt_pk_bf16(v1[0], v1[1]); w.w = cvt_pk_bf16(v1[2], v1[3]);
                    *(u32x4*)(O + (off0 + (unsigned)((ai * HALF + m * 16) * ldc + bj * HALF))) = w; }
    }
};
struct EpiQKV {
    static constexpr bool PERM = true, AFTER_DRAIN = false;
    bf16_t* O; const PG8_LAS float* rsl;
    __device__ __forceinline__ void operator()(const f32x4 (&acc)[2][2][4][2], const Unit& u, int wr, int wc, int fr, int fq) const {
        const int t = u.pn >> 2, hp = u.pn & 3; const int m0 = u.pm * BM, b = m0 >> 12, s0 = (m0 & 4095) + wr * 64 + fr;
        const size_t TS = (size_t)16384 * 1024;
        bf16_t* base = O + (size_t)t * TS + wc * 32 + 8 * fq;
#pragma unroll
        for (int ai = 0; ai < 2; ++ai)
#pragma unroll
            for (int m = 0; m < 4; ++m) { const int s = s0 + ai * HALF + m * 16;
                float rs = 1.0f; if (rsl) rs = rsl[wr * 64 + fr + ai * HALF + m * 16];
#pragma unroll
                for (int bj = 0; bj < 2; ++bj) { const f32x4 v0 = acc[ai][bj][m][0] * rs, v1 = acc[ai][bj][m][1] * rs;
                    u32x4 w; w.x = cvt_pk_bf16(v0[0], v0[1]); w.y = cvt_pk_bf16(v0[2], v0[3]); w.z = cvt_pk_bf16(v1[0], v1[1]); w.w = cvt_pk_bf16(v1[2], v1[3]);
                    const size_t hb = (size_t)((b * 8 + 2 * hp + bj) * 4096);
                    *(u32x4*)(base + (hb + s) * 128) = w; } }
    }
};
struct EpiResB {
    static constexpr bool PERM = true, AFTER_DRAIN = false;
    const float* basef; const bf16_t* baseb; bf16_t* out; int ldc; float scale;
    __device__ __forceinline__ void operator()(const f32x4 (&acc)[2][2][4][2], const Unit& u, int wr, int wc, int fr, int fq) const {
        const unsigned off0 = (unsigned)(u.pm * BM + wr * 64 + fr) * (unsigned)ldc + (unsigned)(u.pn * BM + wc * 32 + 8 * fq);
#pragma unroll
        for (int ai = 0; ai < 2; ++ai) {
            f32x4 b0[4][2], b1[4][2];
            if (basef) {
#pragma unroll
                for (int m = 0; m < 4; ++m)
#pragma unroll
                    for (int bj = 0; bj < 2; ++bj) { const unsigned o = off0 + (unsigned)((ai * HALF + m * 16) * ldc + bj * HALF); b0[m][bj] = *(const f32x4*)(basef + o); b1[m][bj] = *(const f32x4*)(basef + o + 4); }
            } else {
                u32x4 w[4][2];
#pragma unroll
                for (int m = 0; m < 4; ++m)
#pragma unroll
                    for (int bj = 0; bj < 2; ++bj) w[m][bj] = *(const u32x4*)(baseb + (off0 + (unsigned)((ai * HALF + m * 16) * ldc + bj * HALF)));
#pragma unroll
                for (int m = 0; m < 4; ++m)
#pragma unroll
                    for (int bj = 0; bj < 2; ++bj) { const u32x4 q = w[m][bj];
                        b0[m][bj] = (f32x4){__builtin_bit_cast(float, q.x << 16), __builtin_bit_cast(float, q.x & 0xffff0000u), __builtin_bit_cast(float, q.y << 16), __builtin_bit_cast(float, q.y & 0xffff0000u)};
                        b1[m][bj] = (f32x4){__builtin_bit_cast(float, q.z << 16), __builtin_bit_cast(float, q.z & 0xffff0000u), __builtin_bit_cast(float, q.w << 16), __builtin_bit_cast(float, q.w & 0xffff0000u)}; }
            }
#pragma unroll
            for (int m = 0; m < 4; ++m)
#pragma unroll
                for (int bj = 0; bj < 2; ++bj) { const f32x4 v0 = b0[m][bj] + acc[ai][bj][m][0] * scale, v1 = b1[m][bj] + acc[ai][bj][m][1] * scale;
                    u32x4 wv; wv.x = cvt_pk_bf16(v0[0], v0[1]); wv.y = cvt_pk_bf16(v0[2], v0[3]); wv.z = cvt_pk_bf16(v1[0], v1[1]); wv.w = cvt_pk_bf16(v1[2], v1[3]);
                    *(u32x4*)(out + (off0 + (unsigned)((ai * HALF + m * 16) * ldc + bj * HALF))) = wv; }
            asm volatile("" ::: "memory");
        }
    }
};
struct EpiResF32 {
    static constexpr bool PERM = false, AFTER_DRAIN = false;
    const float* base; float* out; int ldc; float scale;
    __device__ __forceinline__ void operator()(const f32x4 (&acc)[2][2][4][2], const Unit& u, int wr, int wc, int fr, int fq) const {
        const int row0 = u.pm * BM + wr * 64 + fr, col0 = u.pn * BM + wc * 32 + 4 * fq;
#pragma unroll
        for (int ai = 0; ai < 2; ++ai)
#pragma unroll
            for (int m = 0; m < 4; ++m) { const size_t off = (size_t)(row0 + ai * HALF + m * 16) * ldc + col0;
                f32x4 bs[2][2];
#pragma unroll
                for (int bj = 0; bj < 2; ++bj)
#pragma unroll
                    for (int n = 0; n < 2; ++n) bs[bj][n] = *(const f32x4*)(base + off + bj * HALF + n * 16);
#pragma unroll
                for (int bj = 0; bj < 2; ++bj)
#pragma unroll
                    for (int n = 0; n < 2; ++n) *(f32x4*)(out + off + bj * HALF + n * 16) = bs[bj][n] + acc[ai][bj][m][n] * scale;
                asm volatile("" ::: "memory"); }
    }
};
struct EpiResF32N {
    static constexpr bool PERM = false, AFTER_DRAIN = false;
    const float* base; float* out; int ldc; float scale; const float* gain; bf16_t* Hn; float* part;
    __device__ __forceinline__ void operator()(const f32x4 (&acc)[2][2][4][2], const Unit& u, int wr, int wc, int fr, int fq) const {
        const int row0 = u.pm * BM + wr * 64 + fr, col0 = u.pn * BM + wc * 32 + 4 * fq;
        f32x4 gn[2][2];
#pragma unroll
        for (int bj = 0; bj < 2; ++bj)
#pragma unroll
            for (int n = 0; n < 2; ++n) gn[bj][n] = *(const f32x4*)(gain + col0 + bj * HALF + n * 16);
#pragma unroll
        for (int ai = 0; ai < 2; ++ai)
#pragma unroll
            for (int m = 0; m < 4; ++m) { const int row = row0 + ai * HALF + m * 16; const size_t off = (size_t)row * ldc + col0;
                f32x4 bs[2][2]; float ss = 0.f;
#pragma unroll
                for (int bj = 0; bj < 2; ++bj)
#pragma unroll
                    for (int n = 0; n < 2; ++n) bs[bj][n] = *(const f32x4*)(base + off + bj * HALF + n * 16);
#pragma unroll
                for (int bj = 0; bj < 2; ++bj)
#pragma unroll
                    for (int n = 0; n < 2; ++n) { const f32x4 xn = bs[bj][n] + acc[ai][bj][m][n] * scale; *(f32x4*)(out + off + bj * HALF + n * 16) = xn;
                        ss += xn[0] * xn[0] + xn[1] * xn[1] + xn[2] * xn[2] + xn[3] * xn[3];
                        const f32x4 hg = xn * gn[bj][n]; u32x2 w; w.x = cvt_pk_bf16(hg[0], hg[1]); w.y = cvt_pk_bf16(hg[2], hg[3]);
                        *(u32x2*)(Hn + off + bj * HALF + n * 16) = w; }
                ss += __shfl_xor(ss, 16); ss += __shfl_xor(ss, 32);
                if (fq == 0) part[(size_t)row * 32 + (u.pn * 4 + wc)] = ss;
                asm volatile("" ::: "memory"); }
    }
};
__device__ __forceinline__ float silu_mul(float g, float u) { return g * u * __builtin_amdgcn_rcpf(1.0f + __builtin_amdgcn_exp2f(g * -1.4426950408889634f)); }
struct EpiSwiGLU {
    static constexpr bool PERM = true, AFTER_DRAIN = false;
    bf16_t* O; int ldc; int tpe;
    __device__ __forceinline__ void operator()(const f32x4 (&acc)[2][2][4][2], const Unit& u, int wr, int wc, int fr, int fq) const {
        const int row0 = u.pm * BM + wr * 64 + fr, col0 = (u.pn % tpe) * HALF + wc * 32 + 8 * fq;
#pragma unroll
        for (int ai = 0; ai < 2; ++ai)
#pragma unroll
            for (int m = 0; m < 4; ++m) { bf16_t* rowp = O + (size_t)(row0 + ai * HALF + m * 16) * ldc + col0;
                const f32x4 g0 = acc[ai][0][m][0], g1 = acc[ai][0][m][1], u0 = acc[ai][1][m][0], u1 = acc[ai][1][m][1];
                u32x4 w; w.x = cvt_pk_bf16(silu_mul(g0[0], u0[0]), silu_mul(g0[1], u0[1])); w.y = cvt_pk_bf16(silu_mul(g0[2], u0[2]), silu_mul(g0[3], u0[3]));
                w.z = cvt_pk_bf16(silu_mul(g1[0], u1[0]), silu_mul(g1[1], u1[1])); w.w = cvt_pk_bf16(silu_mul(g1[2], u1[2]), silu_mul(g1[3], u1[3]));
                *(u32x4*)rowp = w; }
    }
};

__device__ __forceinline__ unsigned pk4_fp8(float a, float b, float c, float d) {
    a = __builtin_amdgcn_fmed3f(a, -448.f, 448.f); b = __builtin_amdgcn_fmed3f(b, -448.f, 448.f); c = __builtin_amdgcn_fmed3f(c, -448.f, 448.f); d = __builtin_amdgcn_fmed3f(d, -448.f, 448.f);
    int p = __builtin_amdgcn_cvt_pk_fp8_f32(a, b, 0, false); p = __builtin_amdgcn_cvt_pk_fp8_f32(c, d, p, true); return (unsigned)p;
}
struct EpiSwiGLU8 {
    static constexpr bool PERM = true, AFTER_DRAIN = false;
    unsigned char* O; int ldc; int tpe; float in_scale, out_scale;
    __device__ __forceinline__ void operator()(const f32x4 (&acc)[2][2][4][2], const Unit& u, int wr, int wc, int fr, int fq) const {
        const int row0 = u.pm * BM + wr * 64 + fr, col0 = (u.pn % tpe) * HALF + wc * 32 + 8 * fq;
#pragma unroll
        for (int ai = 0; ai < 2; ++ai)
#pragma unroll
            for (int m = 0; m < 4; ++m) { unsigned char* rowp = O + (size_t)(row0 + ai * HALF + m * 16) * ldc + col0;
                const f32x4 g0 = acc[ai][0][m][0] * in_scale, g1 = acc[ai][0][m][1] * in_scale, u0 = acc[ai][1][m][0] * (in_scale * out_scale), u1 = acc[ai][1][m][1] * (in_scale * out_scale);
                u32x2 w; w.x = pk4_fp8(silu_mul(g0[0], u0[0]), silu_mul(g0[1], u0[1]), silu_mul(g0[2], u0[2]), silu_mul(g0[3], u0[3]));
                w.y = pk4_fp8(silu_mul(g1[0], u1[0]), silu_mul(g1[1], u1[1]), silu_mul(g1[2], u1[2]), silu_mul(g1[3], u1[3]));
                *(u32x2*)rowp = w; }
    }
};
struct GroupedOrder {
    static constexpr bool SPLITK = false;
    int nM, nN, nwg, G, c; int tb[9];
    __device__ __forceinline__ void init(int RT, int nN_, int G_, int c_) { nM = RT; nN = nN_; nwg = nM * nN; G = G_; c = c_; }
    __device__ __forceinline__ bool next(int i, Unit& u) const {
        const long L = (long)i * G + c; if (L >= nwg) return false;
        int wgid = (int)L; { const int q = nwg / NXCD, r = nwg % NXCD, xcd = wgid % NXCD, off = wgid / NXCD; wgid = (xcd < r ? xcd * (q + 1) : r * (q + 1) + (xcd - r) * q) + off; }
        const int nig = WGM * nN, gid = wgid / nig, fm = gid * WGM, gsz = (nM - fm) < WGM ? (nM - fm) : WGM;
        const int pm = fm + ((wgid % nig) % gsz), pn = (wgid % nig) / gsz; int e = 0;
#pragma unroll
        for (int k = 1; k < 8; ++k) e += (pm >= tb[k]) ? 1 : 0;
        u.pm = pm; u.pn = e * nN + pn; return true;
    }
    __device__ __forceinline__ void a_ready(const Unit&) const {}
    __device__ __forceinline__ void done(const Unit&) const {}
};
struct TailOrder {
    static constexpr bool SPLITK = true;
    int nunits, nN, nsl, nt, G, c; int tb[9];
    __device__ __forceinline__ void init(int ntail, int nN_, int nsl_, int nt_, int G_, int c_) { nN = nN_; nsl = nsl_; nt = nt_; nunits = ntail * nN_ * nsl_; G = G_; c = c_; }
    __device__ __forceinline__ bool next(int i, Unit& u) const {
        const int L = i * G + c; if (L >= nunits) return false;
        const int ks = L % nsl, r = L / nsl, pn = r % nN, pm = 128 + r / nN; int e = 0;
#pragma unroll
        for (int k = 1; k < 8; ++k) e += (pm >= tb[k]) ? 1 : 0;
        u.pm = pm; u.pn = e * nN + pn; u.ko = ks * nt * 128; return true;
    }
    __device__ __forceinline__ void a_ready(const Unit&) const {}
    __device__ __forceinline__ void done(const Unit&) const {}
};
struct EpiPartF32 {
    static constexpr bool PERM = true, AFTER_DRAIN = false;
    float* P; int tpe; int slice_bytes; unsigned slice_elems;
    __device__ __forceinline__ void operator()(const f32x4 (&acc)[2][2][4][2], const Unit& u, int wr, int wc, int fr, int fq) const {
        float* const base = P + (size_t)(u.ko / slice_bytes) * slice_elems;
        const unsigned off0 = (unsigned)((u.pm - 128) * BM + wr * 64 + fr) * 2048u + (unsigned)((u.pn % tpe) * BM + wc * 32 + 8 * fq);
#pragma unroll
        for (int ai = 0; ai < 2; ++ai)
#pragma unroll
            for (int m = 0; m < 4; ++m)
#pragma unroll
                for (int bj = 0; bj < 2; ++bj) { f32x4* dst = (f32x4*)(base + (off0 + (unsigned)((ai * HALF + m * 16) * 2048 + bj * HALF)));
                    dst[0] = acc[ai][bj][m][0]; dst[1] = acc[ai][bj][m][1]; }
    }
};
template <class Epi, class Sched, bool ALIGN_EPI = false, bool SP2 = false, bool F8 = false>
__device__ __forceinline__ void gemm_phase(PG8_LAS unsigned char* lds, const Gemm g, const Sched& S, const Epi& E, const int tid) {
    const int wid = __builtin_amdgcn_readfirstlane(tid >> 6), lane = tid & 63, wr = wid >> 2, wc = wid & 3, fr = lane & 15, fq = lane >> 4;
    const int K = g.K; int nt = K / BK; if constexpr (Sched::SPLITK) nt = S.nt;
    unsigned voffA[2], voffB[2];
#pragma unroll
    for (int i = 0; i < 2; ++i) { int R, C; stage_rc(tid * 16 + i * 8192, R, C); const int Rb = Epi::PERM ? ((R & ~31) + perm32(R & 31)) : R;
        voffA[i] = (unsigned)(R * K + C) * 2u; voffB[i] = (unsigned)(Rb * K + C) * 2u; }
    const size_t kstep = (size_t)(BK * 2);
    const size_t hstep = (size_t)HALF * K * 2;
    const size_t tstep = 2 * hstep;
    const unsigned ldsw = (unsigned)wid * 1024u;
    const unsigned ldsb = (unsigned)__builtin_amdgcn_readfirstlane((int)((unsigned)(size_t)lds + ldsw));
    const int aoff = lds_byte(wr * 64 + fr, fq * 8), boff = lds_byte(wc * 32 + fr, fq * 8);
#define PG8_SA(b, h) (((b) * 2 + (h)) * HTB)
#define PG8_SB(b, h) ((4 + (b) * 2 + (h)) * HTB)
#define PG8_STAGE(bufoff, gbase, voff) do { _Pragma("unroll") for (int _i = 0; _i < 2; ++_i) { unsigned _keep; \
        asm volatile("s_mov_b32 %0, m0\n\ts_mov_b32 m0, %3\n\ts_nop 0\n\tglobal_load_lds_dwordx4 %1, %2\n\ts_mov_b32 m0, %0" : "=&s"(_keep) : "v"((voff)[_i]), "s"((const char*)(gbase)), "s"(ldsb + (unsigned)((bufoff) + _i * 8192)) : "memory"); } } while (0)
#define PG8_LDA(dst, b, h) do { _Pragma("unroll") for (int m = 0; m < 4; ++m) _Pragma("unroll") for (int k = 0; k < 2; ++k) dst[m][k] = *(const PG8_LAS bf16x8*)(lds + PG8_SA(b, h) + aoff + m * 2048 + k * 1024); } while (0)
#define PG8_LDB(dst, b, h) do { _Pragma("unroll") for (int n = 0; n < 2; ++n) _Pragma("unroll") for (int k = 0; k < 2; ++k) dst[n][k] = *(const PG8_LAS bf16x8*)(lds + PG8_SB(b, h) + boff + n * 2048 + k * 1024); } while (0)
#define PG8_CAT(x) __builtin_bit_cast(v8i32, __builtin_shufflevector(__builtin_bit_cast(i32x4, (x)[0]), __builtin_bit_cast(i32x4, (x)[1]), 0, 1, 2, 3, 4, 5, 6, 7))
#define PG8_MMA(ai, bj, At, Bt) do { __builtin_amdgcn_s_setprio(1); if constexpr (F8) asm volatile("s_nop 4" ::: "memory"); _Pragma("unroll") for (int m = 0; m < 4; ++m) _Pragma("unroll") for (int n = 0; n < 2; ++n) { \
        if constexpr (F8) { asm volatile("v_mfma_scale_f32_16x16x128_f8f6f4 %0, %1, %2, %0, %3, %3 op_sel_hi:[0,0,0]" : "+v"(acc[ai][bj][m][n]) : "v"(PG8_CAT(Bt[n])), "v"(PG8_CAT(At[m])), "v"(f8sc)); } \
        else { _Pragma("unroll") for (int k = 0; k < 2; ++k) acc[ai][bj][m][n] = __builtin_amdgcn_mfma_f32_16x16x32_bf16(Bt[n][k], At[m][k], acc[ai][bj][m][n], 0, 0, 0); } } __builtin_amdgcn_s_setprio(0); } while (0)
#define PG8_WAIT_V(n) asm volatile("s_waitcnt vmcnt(" #n ")" ::: "memory")
#define PG8_WAIT_L(n) asm volatile("s_waitcnt lgkmcnt(" #n ")" ::: "memory")
#define PG8_BAR __builtin_amdgcn_s_barrier()
#define PG8_SCHED __builtin_amdgcn_sched_barrier(0)
    const int f8sc = 0x7f7f7f7f;
    Unit cur, nxt; int ui = 0;
    if (!S.next(0, cur)) return;
    f32x4 acc[2][2][4][2];
#pragma unroll
    for (int a = 0; a < 2; ++a)
#pragma unroll
        for (int b = 0; b < 2; ++b)
#pragma unroll
            for (int m = 0; m < 4; ++m)
#pragma unroll
                for (int n = 0; n < 2; ++n) acc[a][b][m][n] = (f32x4){0.f, 0.f, 0.f, 0.f};
    bf16x8 At[4][2], B0[2][2], B1[2][2];
    const char* cA = (const char*)g.A + (size_t)cur.pm * tstep; const char* cB = (const char*)g.Bt + (size_t)cur.pn * tstep;
    if constexpr (Sched::SPLITK) { cA += cur.ko; cB += cur.ko; }
    S.a_ready(cur);
    if constexpr (SP2) {
        PG8_STAGE(PG8_SB(0, 0), cB, voffB); PG8_STAGE(PG8_SB(0, 1), cB + hstep, voffB); PG8_STAGE(PG8_SA(0, 0), cA, voffA); PG8_STAGE(PG8_SA(0, 1), cA + hstep, voffA);
        if (wr == 1) PG8_BAR;
        PG8_WAIT_V(2); PG8_BAR;
        PG8_STAGE(PG8_SB(1, 0), cB + kstep, voffB); PG8_STAGE(PG8_SA(1, 0), cA + kstep, voffA); PG8_STAGE(PG8_SB(1, 1), cB + hstep + kstep, voffB);
        PG8_WAIT_V(6); PG8_BAR;
    } else {
        PG8_STAGE(PG8_SB(0, 0), cB, voffB); PG8_STAGE(PG8_SA(0, 0), cA, voffA); PG8_STAGE(PG8_SB(0, 1), cB + hstep, voffB); PG8_STAGE(PG8_SA(0, 1), cA + hstep, voffA);
        if (wr == 1) PG8_BAR;
        PG8_WAIT_V(4); PG8_BAR;
        PG8_STAGE(PG8_SB(1, 0), cB + kstep, voffB); PG8_STAGE(PG8_SA(1, 0), cA + kstep, voffA); PG8_STAGE(PG8_SB(1, 1), cB + hstep + kstep, voffB);
        PG8_WAIT_V(6); PG8_BAR;
    }
    for (;;) {
        const bool has_next = S.next(ui + 1, nxt);
        const char* nA = has_next ? (const char*)g.A + (size_t)nxt.pm * tstep + (Sched::SPLITK ? nxt.ko : 0) : cA; const char* nB = has_next ? (const char*)g.Bt + (size_t)nxt.pn * tstep + (Sched::SPLITK ? nxt.ko : 0) : cB;
        for (int t = 0; t < nt; t += 2) {
            const bool last = (t == nt - 2);
            const char* a1 = cA + (size_t)(t + 1) * kstep;
            const char* a2 = last ? nA : cA + (size_t)(t + 2) * kstep; const char* b2 = last ? nB : cB + (size_t)(t + 2) * kstep;
            const char* a3 = a2 + kstep; const char* b3 = b2 + kstep;
            if (last && has_next) S.a_ready(nxt);
            if constexpr (SP2) {
            PG8_LDB(B0, 0, 0); PG8_LDB(B1, 0, 1); PG8_SCHED; PG8_LDA(At, 0, 0); PG8_STAGE(PG8_SA(1, 1), a1 + hstep, voffA);
            PG8_WAIT_V(8); PG8_WAIT_L(0); PG8_BAR; PG8_MMA(0, 0, At, B0); PG8_MMA(0, 1, At, B1); PG8_BAR; PG8_SCHED;
            PG8_LDA(At, 0, 1); PG8_STAGE(PG8_SB(0, 0), b2, voffB); PG8_STAGE(PG8_SB(0, 1), b2 + hstep, voffB); PG8_STAGE(PG8_SA(0, 0), a2, voffA);
            PG8_WAIT_V(8); PG8_WAIT_L(0); PG8_BAR; PG8_MMA(1, 0, At, B0); PG8_MMA(1, 1, At, B1); PG8_BAR; PG8_SCHED;
            PG8_LDB(B0, 1, 0); PG8_LDB(B1, 1, 1); PG8_SCHED; PG8_LDA(At, 1, 0); PG8_STAGE(PG8_SA(0, 1), a2 + hstep, voffA);
            PG8_WAIT_V(8); PG8_WAIT_L(0); PG8_BAR; PG8_MMA(0, 0, At, B0); PG8_MMA(0, 1, At, B1); PG8_BAR; PG8_SCHED;
            PG8_LDA(At, 1, 1); PG8_STAGE(PG8_SB(1, 0), b3, voffB); PG8_STAGE(PG8_SB(1, 1), b3 + hstep, voffB); PG8_STAGE(PG8_SA(1, 0), a3, voffA);
            PG8_WAIT_V(8); PG8_WAIT_L(0); PG8_BAR; PG8_MMA(1, 0, At, B0); PG8_MMA(1, 1, At, B1); PG8_BAR; PG8_SCHED;
            } else {
            PG8_LDB(B0, 0, 0); PG8_SCHED; PG8_LDA(At, 0, 0); PG8_STAGE(PG8_SA(1, 1), a1 + hstep, voffA);
            PG8_WAIT_L(8); PG8_BAR; PG8_WAIT_L(0); PG8_MMA(0, 0, At, B0); PG8_BAR; PG8_SCHED;
            PG8_LDB(B1, 0, 1); PG8_STAGE(PG8_SB(0, 0), b2, voffB);
            PG8_BAR; PG8_WAIT_L(0); PG8_MMA(0, 1, At, B1); PG8_BAR;
            PG8_LDA(At, 0, 1); PG8_STAGE(PG8_SA(0, 0), a2, voffA);
            PG8_BAR; PG8_WAIT_L(0); PG8_MMA(1, 0, At, B0); PG8_BAR; PG8_SCHED;
            PG8_STAGE(PG8_SB(0, 1), b2 + hstep, voffB);
            PG8_WAIT_V(6); PG8_BAR; PG8_MMA(1, 1, At, B1); PG8_BAR;
            PG8_LDB(B0, 1, 0); PG8_SCHED; PG8_LDA(At, 1, 0); PG8_STAGE(PG8_SA(0, 1), a2 + hstep, voffA);
            PG8_WAIT_L(8); PG8_BAR; PG8_WAIT_L(0); PG8_MMA(0, 0, At, B0); PG8_BAR; PG8_SCHED;
            PG8_LDB(B1, 1, 1); PG8_STAGE(PG8_SB(1, 0), b3, voffB);
            PG8_BAR; PG8_WAIT_L(0); PG8_MMA(0, 1, At, B1); PG8_BAR;
            PG8_LDA(At, 1, 1); PG8_STAGE(PG8_SA(1, 0), a3, voffA);
            PG8_BAR; PG8_WAIT_L(0); PG8_MMA(1, 0, At, B0); PG8_BAR; PG8_SCHED;
            PG8_STAGE(PG8_SB(1, 1), b3 + hstep, voffB);
            PG8_WAIT_V(6); PG8_BAR; PG8_MMA(1, 1, At, B1); PG8_BAR;
            }
        }
        if constexpr (ALIGN_EPI) { if (wr == 0) PG8_BAR; }
        if constexpr (F8) asm volatile("s_nop 15\n\ts_nop 15" ::: "memory");
        if constexpr (!Epi::AFTER_DRAIN) { E(acc, cur, wr, wc, fr, fq); S.done(cur); }
        if (!has_next) break;
#pragma unroll
        for (int a = 0; a < 2; ++a)
#pragma unroll
            for (int b = 0; b < 2; ++b)
#pragma unroll
                for (int m = 0; m < 4; ++m)
#pragma unroll
                    for (int n = 0; n < 2; ++n) acc[a][b][m][n] = (f32x4){0.f, 0.f, 0.f, 0.f};
        cur = nxt; cA = nA; cB = nB; ++ui;
        if constexpr (ALIGN_EPI) { if (wr == 1) PG8_BAR; }
    }
    PG8_WAIT_V(0);
    if constexpr (!ALIGN_EPI) { if (wr == 0) PG8_BAR; }
    PG8_BAR;
    if constexpr (Epi::AFTER_DRAIN) { E.fused(acc, cur, wr, wc, fr, fq, lds, wid, lane); S.done(cur); }
#undef PG8_SA
#undef PG8_SB
#undef PG8_STAGE
#undef PG8_LDA
#undef PG8_LDB
#undef PG8_MMA
#undef PG8_CAT
#undef PG8_WAIT_V
#undef PG8_WAIT_L
#undef PG8_BAR
#undef PG8_SCHED
}
}

#define GAS __attribute__((address_space(1)))
#define LAS __attribute__((address_space(3)))
typedef unsigned short bf16_t;
typedef short bf16x8 __attribute__((ext_vector_type(8)));
typedef short s16x4 __attribute__((ext_vector_type(4)));
typedef float f32x4 __attribute__((ext_vector_type(4)));
typedef float f32x16 __attribute__((ext_vector_type(16)));
typedef unsigned u32x4 __attribute__((ext_vector_type(4)));
typedef unsigned u32x2 __attribute__((ext_vector_type(2)));
#define LDS_WAIT() asm volatile("s_waitcnt lgkmcnt(0)" ::: "memory")
#define VM_WAIT() asm volatile("s_waitcnt vmcnt(0)" ::: "memory")
#define SBAR() __builtin_amdgcn_sched_barrier(0)

constexpr int BATCH = 4, SEQ = 4096, T = BATCH * SEQ, D = 2048, NH = 8, HD = 128, DH = NH * HD  , DQKV = 6144;
constexpr int DFF = 5504, DFFP = 5632  , DFE = 7168, NE = 8, MOE_ROWS = 2 * T + NE * 256;
#ifndef DENSE_F8
#define DENSE_F8 1
#endif
constexpr float EPS = 1e-6f;
constexpr int NWAVES = 8, NTHREADS = 512;
constexpr float LOG2E = 1.4426950408889634f, LN2 = 0.6931471805599453f;
constexpr float QSCALE = 0.08838834764831845f;
constexpr float F8_SH = 16.f, F8_SW = 512.f, F8_SACT = 8.f;

constexpr size_t MiB = 1u << 20;
constexpr size_t WS_CTL = 0, CTL_ZERO_BYTES = 1 * MiB;
constexpr size_t WS_BKT = 1 * MiB;
constexpr size_t WS_SEL = 2 * MiB;
constexpr size_t WS_GW = WS_SEL + 256 * 1024;
constexpr size_t WS_POS = WS_GW + 256 * 1024;
constexpr size_t WS_HIST = WS_POS + 256 * 1024;
constexpr size_t WS_MOEINFO = WS_HIST + 64 * 1024;
constexpr size_t WS_LSE = 3 * MiB;
constexpr size_t WS_WI = 8 * MiB;
constexpr size_t WS_WO = WS_WI + 2 * (size_t)DQKV * D * 2;
constexpr size_t WS_WGU_D = WS_WO + 2 * (size_t)D * D * 2;
constexpr size_t WS_WD_D = WS_WGU_D + (size_t)2 * DFF * D * 2;
constexpr size_t WS_WGU_M = WS_WD_D + (size_t)D * DFF * 2 + 512 * 1024;
constexpr size_t WS_WD_M = WS_WGU_M + (size_t)NE * 2 * DFE * D;
constexpr size_t WS_X = WS_WD_M + (size_t)NE * D * DFE;
constexpr size_t WS_H = WS_X + (size_t)T * D * 4;
constexpr size_t WS_R = WS_H + (size_t)T * D * 2;
constexpr size_t WS_QKV = WS_R;
constexpr size_t WS_OD = WS_QKV + (size_t)6 * T * DH * 2;
constexpr size_t WS_OS = WS_OD + (size_t)3 * T * DH * 2;
constexpr size_t WS_O = WS_OS + (size_t)T * DH * 2;
constexpr size_t WS_ACT = WS_R;
constexpr size_t WS_AS = WS_R + (size_t)MOE_ROWS * D * 2;
constexpr size_t WS_ACTM = WS_AS + (size_t)MOE_ROWS * D;
constexpr size_t WS_Y = WS_R;
constexpr int TAIL_T0 = 128, TAIL_MAXT = 7, TAIL_SL = 7, TAIL_NT = 8;
constexpr size_t WS_YP = WS_ACTM + (size_t)MOE_ROWS * DFE;
constexpr size_t WS_PART = WS_YP + (size_t)TAIL_SL * TAIL_MAXT * 256 * D * 4;
constexpr size_t WS_END_MOE = WS_PART + (size_t)T * 32 * 4, WS_END_ATT = WS_O + (size_t)T * D * 2, WS_END = WS_END_MOE > WS_END_ATT ? WS_END_MOE : WS_END_ATT;
static_assert(WS_ACT + (size_t)T * DFF * 2 <= WS_END, "region R");
static_assert(WS_END <= 1879048192ull, "workspace");
static_assert(TAIL_SL * TAIL_NT * 128 == DFE && WS_YP % 256 == 0, "split-K tail");
static_assert(WS_WI % 256 == 0 && WS_WO % 256 == 0 && WS_WGU_D % 256 == 0 && WS_WD_D % 256 == 0 && WS_WGU_M % 256 == 0 && WS_WD_M % 256 == 0 && WS_X % 256 == 0 && WS_H % 256 == 0 && WS_R % 256 == 0 && WS_ACTM % 256 == 0, "alignment");
constexpr int CW_AQ = 20480;
constexpr int CW_TAIL = 16384;
constexpr int CW_BAR = 4096;

constexpr int WSCR = 16896;
constexpr int SCR_BYTES = 8 * WSCR;
constexpr int TBL_OFF = SCR_BYTES, TBL_N = 200, TBL_BYTES = 3 * NH * TBL_N * 4;
constexpr int MISC_OFF = 154624;
constexpr int LDS_BYTES = 157696;
static_assert(TBL_OFF + TBL_BYTES <= MISC_OFF && MISC_OFF + 3072 <= LDS_BYTES, "LDS map");

#define XB_TMO      128
#define XB_XCNT(j)  (256  + 64 * (j))
#define XB_XSUB(j)  (1280 + 64 * (j))
#define XB_XGEN(j)  (2304 + 64 * (j))
#define XB_TOP      3328
#define XB_TOPGEN   3392
#define XCD_BAR_WORDS 3456
#define XB_SPIN_CAP (1u << 20)
__device__ __forceinline__ unsigned xb_ld(unsigned* p)              { return __hip_atomic_load(p, __ATOMIC_RELAXED, __HIP_MEMORY_SCOPE_AGENT); }
__device__ __forceinline__ unsigned xb_add(unsigned* p, unsigned v) { return __hip_atomic_fetch_add(p, v, __ATOMIC_RELAXED, __HIP_MEMORY_SCOPE_AGENT); }
__device__ __forceinline__ unsigned xb_xcc_id() { return (unsigned)__builtin_amdgcn_s_getreg((3 << 11) | 20) & 0xFu; }
#define XB_SPIN(cond, bar) do { unsigned _sp = 0; while (cond) { __builtin_amdgcn_s_sleep(1); \
    if ((++_sp & 255u) == 0u) { if (xb_ld(&(bar)[XB_TMO])) break; if (_sp > XB_SPIN_CAP) { atomicAdd(&(bar)[XB_TMO], 1u); break; } } } } while (0)
struct XcdBarrier { unsigned* bar; unsigned x; volatile LAS unsigned* st; };
__device__ __forceinline__ XcdBarrier xcd_barrier_post(unsigned* bar, volatile LAS unsigned* st) {
    XcdBarrier b; b.bar = bar; b.x = xb_xcc_id(); b.st = st;
    if (threadIdx.x == 0) (void)xb_add(&bar[XB_XCNT(b.x)], 1u);
    return b;
}
__device__ __forceinline__ void xcd_barrier_complete(unsigned* bar, unsigned x, unsigned& nloc, unsigned& nx) {
    const unsigned G = gridDim.x * gridDim.y * gridDim.z;
    unsigned sum, cnt, mine, sp = 0u;
    for (;;) {
        sum = 0u; cnt = 0u; mine = 0u;
#pragma unroll
        for (unsigned j = 0; j < 16; ++j) { const unsigned c = xb_ld(&bar[XB_XCNT(j)]); sum += c; cnt += (c > 0u) ? 1u : 0u; mine = (j == x) ? c : mine; }
        if (sum == G) break;
        __builtin_amdgcn_s_sleep(1);
        if ((++sp & 255u) == 0u) { if (xb_ld(&bar[XB_TMO])) break; if (sp > XB_SPIN_CAP) { atomicAdd(&bar[XB_TMO], 1u); break; } }
    }
    nloc = mine > 0u ? mine : 1u; nx = cnt > 0u ? cnt : 1u;
}
__device__ __forceinline__ void xcd_barrier(const XcdBarrier& b) {
    asm volatile("s_waitcnt vmcnt(0)" ::: "memory");
    __syncthreads();
    if (threadIdx.x == 0) {
        unsigned* bar = b.bar;
        __builtin_amdgcn_s_waitcnt(0);
        unsigned nloc = b.st[0], nx = b.st[1];
        if (nloc == 0u) { xcd_barrier_complete(bar, b.x, nloc, nx); b.st[0] = nloc; b.st[1] = nx; }
        const unsigned old = xb_add(&bar[XB_XSUB(b.x)], 1u);
        const unsigned gen = old / nloc;
        if (old + 1u == (gen + 1u) * nloc) {
            __builtin_amdgcn_fence(__ATOMIC_RELEASE, "agent");
            asm volatile("s_waitcnt vmcnt(0)" ::: "memory");
            const unsigned og = xb_add(&bar[XB_TOP], 1u);
            const unsigned tg = og / nx;
            if (og + 1u == (tg + 1u) * nx) xb_add(&bar[XB_TOPGEN], 1u);
            else XB_SPIN(xb_ld(&bar[XB_TOPGEN]) == tg, bar);
            __builtin_amdgcn_fence(__ATOMIC_ACQUIRE, "agent");
            xb_add(&bar[XB_XGEN(b.x)], 1u);
            asm volatile("s_waitcnt vmcnt(0)" ::: "memory");
        } else {
            XB_SPIN(xb_ld(&bar[XB_XGEN(b.x)]) == gen, bar);
            __builtin_amdgcn_fence(__ATOMIC_ACQUIRE, "agent");
            asm volatile("s_waitcnt vmcnt(0)" ::: "memory");
        }
#if defined(PHTIME)
        if (blockIdx.x == 0) { const unsigned s_ = b.st[2]; b.st[2] = s_ + 1u; bar[(12290 - CW_BAR) + s_] = (unsigned)__builtin_amdgcn_s_memrealtime(); }
#endif
    }
    __syncthreads();
}

__device__ __forceinline__ unsigned pk2(float lo, float hi) { unsigned r; asm volatile("v_cvt_pk_bf16_f32 %0, %1, %2" : "=v"(r) : "v"(lo), "v"(hi)); return r; }
__device__ __forceinline__ float bf_lo(unsigned w) { return __builtin_bit_cast(float, w << 16); }
__device__ __forceinline__ float bf_hi(unsigned w) { return __builtin_bit_cast(float, w & 0xffff0000u); }
__device__ __forceinline__ float wave_sum(float v) {
#pragma unroll
    for (int o = 1; o < 64; o <<= 1) v += __shfl_xor(v, o);
    return v;
}
__device__ __forceinline__ float dot4(f32x4 a) { return (a.x * a.x + a.y * a.y) + (a.z * a.z + a.w * a.w); }

struct Frame {
    LAS unsigned char* lds; volatile LAS unsigned* MISC;
    int tid, lane, wave, gw, G;
};

__device__ __forceinline__ void tr_item(const float* __restrict__ W, int K, int N, bf16_t* __restrict__ WT, int mode, LAS float* scr, int item, int lane) {
    const int nblk = N >> 6, kb = item / nblk, nb = item - kb * nblk, k0 = kb << 6, n0 = nb << 6;
    f32x4 v[16];
    const float* src = W + (size_t)(k0 + (lane >> 4)) * N + n0 + 4 * (lane & 15);
#pragma unroll
    for (int i = 0; i < 16; ++i) v[i] = __builtin_nontemporal_load((const f32x4*)(src + (size_t)(4 * i) * N));
#pragma unroll
    for (int i = 0; i < 16; ++i) { LAS float* d = scr + (4 * i + (lane >> 4)) * 65 + 4 * (lane & 15); d[0] = v[i][0]; d[1] = v[i][1]; d[2] = v[i][2]; d[3] = v[i][3]; }
    LDS_WAIT();
    const int c = lane & 7;
#pragma unroll
    for (int p = 0; p < 8; ++p) { const int n = (lane >> 3) + 8 * p; const LAS float* s = scr + (8 * c) * 65 + n;
        u32x4 o; o.x = pk2(s[0], s[65]); o.y = pk2(s[130], s[195]); o.z = pk2(s[260], s[325]); o.w = pk2(s[390], s[455]);
        const int nn = n0 + n; const int row = mode == 0 ? nn : (((nn >> 7) << 8) + (nn & 127) + (mode == 2 ? 128 : 0));
        *(u32x4*)(WT + (size_t)row * K + k0 + 8 * c) = o; }
    LDS_WAIT();
}
__device__ __forceinline__ void tr_item8(const float* __restrict__ W, int K, int N, unsigned char* __restrict__ WT, int ldk, int mode, LAS float* scr, int item, int lane) {
    const int nblk = N >> 6, kb = item / nblk, nb = item - kb * nblk, k0 = kb << 6, n0 = nb << 6;
    f32x4 v[16];
    const float* src = W + (size_t)(k0 + (lane >> 4)) * N + n0 + 4 * (lane & 15);
#pragma unroll
    for (int i = 0; i < 16; ++i) v[i] = __builtin_nontemporal_load((const f32x4*)(src + (size_t)(4 * i) * N));
#pragma unroll
    for (int i = 0; i < 16; ++i) { LAS float* d = scr + (4 * i + (lane >> 4)) * 65 + 4 * (lane & 15); d[0] = v[i][0]; d[1] = v[i][1]; d[2] = v[i][2]; d[3] = v[i][3]; }
    LDS_WAIT();
    const int c = lane & 7;
#pragma unroll
    for (int p = 0; p < 8; ++p) { const int n = (lane >> 3) + 8 * p; const LAS float* s = scr + (8 * c) * 65 + n;
        u32x2 o; o.x = pg8::pk4_fp8(s[0] * F8_SW, s[65] * F8_SW, s[130] * F8_SW, s[195] * F8_SW); o.y = pg8::pk4_fp8(s[260] * F8_SW, s[325] * F8_SW, s[390] * F8_SW, s[455] * F8_SW);
        const int nn = n0 + n; const int row = mode == 0 ? nn : (((nn >> 7) << 8) + (nn & 127) + (mode == 2 ? 128 : 0));
        *(u32x2*)(WT + (size_t)row * ldk + k0 + 8 * c) = o; }
    LDS_WAIT();
}

struct ConvDesc { const float* W; unsigned char* WT; int K, N, mode, f8, item, ldk; };
__device__ __forceinline__ void tr_load(const ConvDesc& d, f32x4 (&v)[16], int lane) {
    if (d.f8) {
        const int nblk = d.N >> 5, kb = d.item / nblk, nb = d.item - kb * nblk, k0 = kb << 7, n0 = nb << 5;
        const unsigned voff = (unsigned)(((lane >> 3) * d.N + 4 * (lane & 7)) * 4);
        const char* ub = (const char*)(d.W + (size_t)k0 * d.N + n0);
#pragma unroll
        for (int i = 0; i < 16; ++i) v[i] = __builtin_nontemporal_load((const f32x4*)(ub + (size_t)(8 * i) * d.N * 4 + voff));
    } else {
        const int nblk = d.N >> 6, kb = d.item / nblk, nb = d.item - kb * nblk, k0 = kb << 6, n0 = nb << 6;
        const unsigned voff = (unsigned)(((lane >> 4) * d.N + 4 * (lane & 15)) * 4);
        const char* ub = (const char*)(d.W + (size_t)k0 * d.N + n0);
#pragma unroll
        for (int i = 0; i < 16; ++i) v[i] = __builtin_nontemporal_load((const f32x4*)(ub + (size_t)(4 * i) * d.N * 4 + voff));
    }
}
__device__ __forceinline__ void tr_finish(const ConvDesc& d, const f32x4 (&v)[16], LAS float* scr, int lane) {
    if (d.f8) {
        const int nblk = d.N >> 5, kb = d.item / nblk, nb = d.item - kb * nblk, k0 = kb << 7, n0 = nb << 5;
#pragma unroll
        for (int i = 0; i < 16; ++i) { LAS float* q = scr + (8 * i + (lane >> 3)) * 33 + 4 * (lane & 7); q[0] = v[i][0]; q[1] = v[i][1]; q[2] = v[i][2]; q[3] = v[i][3]; }
        LDS_WAIT();
        const int c = lane & 7;
#pragma unroll
        for (int p = 0; p < 4; ++p) { const int n = (lane >> 3) + 8 * p; const LAS float* s = scr + (16 * c) * 33 + n;
            const int nn = n0 + n; const int row = d.mode == 0 ? nn : (((nn >> 7) << 8) + (nn & 127) + (d.mode == 2 ? 128 : 0));
            u32x4 o; o.x = pg8::pk4_fp8(s[0] * F8_SW, s[33] * F8_SW, s[66] * F8_SW, s[99] * F8_SW); o.y = pg8::pk4_fp8(s[132] * F8_SW, s[165] * F8_SW, s[198] * F8_SW, s[231] * F8_SW);
            o.z = pg8::pk4_fp8(s[264] * F8_SW, s[297] * F8_SW, s[330] * F8_SW, s[363] * F8_SW); o.w = pg8::pk4_fp8(s[396] * F8_SW, s[429] * F8_SW, s[462] * F8_SW, s[495] * F8_SW);
            __builtin_nontemporal_store(o, (u32x4*)(d.WT + (size_t)row * d.ldk + k0 + 16 * c)); }
        LDS_WAIT();
    } else {
        const int nblk = d.N >> 6, kb = d.item / nblk, nb = d.item - kb * nblk, k0 = kb << 6, n0 = nb << 6;
#pragma unroll
        for (int i = 0; i < 16; ++i) { LAS float* q = scr + (4 * i + (lane >> 4)) * 65 + 4 * (lane & 15); q[0] = v[i][0]; q[1] = v[i][1]; q[2] = v[i][2]; q[3] = v[i][3]; }
        LDS_WAIT();
        const int c = lane & 7;
#pragma unroll
        for (int p = 0; p < 8; ++p) { const int n = (lane >> 3) + 8 * p; const LAS float* s = scr + (8 * c) * 65 + n;
            const int nn = n0 + n; const int row = d.mode == 0 ? nn : (((nn >> 7) << 8) + (nn & 127) + (d.mode == 2 ? 128 : 0));
            u32x4 o; o.x = pk2(s[0], s[65]); o.y = pk2(s[130], s[195]); o.z = pk2(s[260], s[325]); o.w = pk2(s[390], s[455]);
            __builtin_nontemporal_store(o, (u32x4*)(d.WT + ((size_t)row * d.ldk + k0 + 8 * c) * 2)); }
        LDS_WAIT();
    }
}
__device__ __forceinline__ void rms_row_bf16(const float* xrow, const float* g, bf16_t* orow, int lane) {
    const f32x4* xr = (const f32x4*)xrow + lane; const f32x4* gr = (const f32x4*)g + lane;
    f32x4 v[8]; float ss = 0.f;
#pragma unroll
    for (int j = 0; j < 8; ++j) { v[j] = xr[64 * j]; ss += dot4(v[j]); }
    const float rstd = 1.0f / sqrtf(wave_sum(ss) * (1.0f / D) + EPS);
    u32x2* o8 = (u32x2*)orow + lane;
#pragma unroll
    for (int j = 0; j < 8; ++j) { const f32x4 gg = gr[64 * j]; u32x2 w; w.x = pk2(v[j].x * rstd * gg.x, v[j].y * rstd * gg.y); w.y = pk2(v[j].z * rstd * gg.z, v[j].w * rstd * gg.w); o8[64 * j] = w; }
}
__device__ __forceinline__ f32x4 ldxb(const bf16_t* xrow, int lane, int j) { const u32x2 w = ((const u32x2*)xrow)[lane + 64 * j]; return (f32x4){bf_lo(w.x), bf_hi(w.x), bf_lo(w.y), bf_hi(w.y)}; }
__device__ __forceinline__ void rms_row_b2b(const bf16_t* xrow, const float* g, bf16_t* orow, int lane) {
    const f32x4* gr = (const f32x4*)g + lane;
    f32x4 v[8]; float ss = 0.f;
#pragma unroll
    for (int j = 0; j < 8; ++j) { v[j] = ldxb(xrow, lane, j); ss += dot4(v[j]); }
    const float rstd = 1.0f / sqrtf(wave_sum(ss) * (1.0f / D) + EPS);
    u32x2* o8 = (u32x2*)orow + lane;
#pragma unroll
    for (int j = 0; j < 8; ++j) { const f32x4 gg = gr[64 * j]; u32x2 w; w.x = pk2(v[j].x * rstd * gg.x, v[j].y * rstd * gg.y); w.y = pk2(v[j].z * rstd * gg.z, v[j].w * rstd * gg.w); o8[64 * j] = w; }
}
__device__ __forceinline__ void rms_rows_b2b(const bf16_t* X, const float* g, bf16_t* H, int gw, int ngw, int lane) {
    f32x4 gq[8];
#pragma unroll
    for (int q = 0; q < 8; ++q) gq[q] = ((const f32x4*)g)[lane + 64 * q];
    for (int m0 = gw; m0 < T; m0 += 4 * ngw) {
        u32x2 raw[4][8];
#pragma unroll
        for (int r = 0; r < 4; ++r)
#pragma unroll
            for (int q = 0; q < 8; ++q) raw[r][q] = ((const u32x2*)(X + (size_t)(m0 + r * ngw) * D))[lane + 64 * q];
#pragma unroll
        for (int r = 0; r < 4; ++r) {
            f32x4 v[8]; float ss = 0.f;
#pragma unroll
            for (int q = 0; q < 8; ++q) { v[q] = (f32x4){bf_lo(raw[r][q].x), bf_hi(raw[r][q].x), bf_lo(raw[r][q].y), bf_hi(raw[r][q].y)}; ss += dot4(v[q]); }
            const float rstd = 1.0f / sqrtf(wave_sum(ss) * (1.0f / D) + EPS);
            u32x2* o8 = (u32x2*)(H + (size_t)(m0 + r * ngw) * D) + lane;
#pragma unroll
            for (int q = 0; q < 8; ++q) { u32x2 w; w.x = pk2(v[q].x * rstd * gq[q].x, v[q].y * rstd * gq[q].y); w.y = pk2(v[q].z * rstd * gq[q].z, v[q].w * rstd * gq[q].w); o8[64 * q] = w; }
        }
    }
}
__device__ __forceinline__ void rms_rows_f2b(const float* X, const float* g, bf16_t* H, int gw, int ngw, int lane) {
    f32x4 gq[8];
#pragma unroll
    for (int q = 0; q < 8; ++q) gq[q] = ((const f32x4*)g)[lane + 64 * q];
    for (int m0 = gw; m0 < T; m0 += 4 * ngw) {
        f32x4 v[4][8];
#pragma unroll
        for (int r = 0; r < 4; ++r)
#pragma unroll
            for (int q = 0; q < 8; ++q) v[r][q] = ((const f32x4*)(X + (size_t)(m0 + r * ngw) * D))[lane + 64 * q];
#pragma unroll
        for (int r = 0; r < 4; ++r) {
            float ss = 0.f;
#pragma unroll
            for (int q = 0; q < 8; ++q) ss += dot4(v[r][q]);
            const float rstd = 1.0f / sqrtf(wave_sum(ss) * (1.0f / D) + EPS);
            u32x2* o8 = (u32x2*)(H + (size_t)(m0 + r * ngw) * D) + lane;
#pragma unroll
            for (int q = 0; q < 8; ++q) { u32x2 w; w.x = pk2(v[r][q].x * rstd * gq[q].x, v[r][q].y * rstd * gq[q].y); w.y = pk2(v[r][q].z * rstd * gq[q].z, v[r][q].w * rstd * gq[q].w); o8[64 * q] = w; }
        }
    }
}
__device__ __forceinline__ int t5_bucket(int n) {
    if (n < 16) return n;
    int b = 16 + (int)(log((double)n / 16.0) / log(128.0) * 16.0);
    return b < 31 ? b : 31;
}

__device__ __forceinline__ void dma_tile_k(const bf16_t* base, size_t row_stride_bytes, LAS unsigned char* dst, const unsigned (&voff)[4]) {
#pragma unroll
    for (int i = 0; i < 8; ++i) {
        const char* ub = (const char*)base + (size_t)(4 * i) * row_stride_bytes;
        __builtin_amdgcn_global_load_lds((const unsigned*)(ub + voff[i & 3]), (LAS unsigned*)(dst + i * 1024), 16, 0, 0);
    }
}
__device__ __forceinline__ void dma_tile_v(const bf16_t* base, size_t row_stride_bytes, LAS unsigned char* dst, unsigned voff) {
#pragma unroll
    for (int i = 0; i < 8; ++i) {
        const char* ub = (const char*)base + (size_t)(4 * i) * row_stride_bytes;
        __builtin_amdgcn_global_load_lds((const unsigned*)(ub + voff), (LAS unsigned*)(dst + i * 1024), 16, 0, 0);
    }
}
#define TRRD(dst, addr, off) asm volatile("ds_read_b64_tr_b16 %0, %1 offset:%2" : "=&v"(dst) : "v"(addr), "i"(off) : "memory")

template <int MODE>
__device__ __forceinline__ void attn_item(LAS unsigned char* wl, const bf16_t* Qh, int qstride, const bf16_t* Kh, const bf16_t* Vh, bf16_t* Op, int ostride, float* lsep, int lstride,
                                          const LAS float* tb, int qg, int lane) {
    const int c = lane & 31, hi = lane >> 5;
    const int i0 = 32 * qg;
    const size_t rstride = (size_t)qstride;
    bf16x8 qf[8];
    { const bf16_t* qrow = Qh + (size_t)(i0 + c) * qstride + 8 * hi;
#pragma unroll
      for (int s = 0; s < 8; ++s) qf[s] = *(const bf16x8*)(qrow + 16 * s); }
    f32x16 o[4];
#pragma unroll
    for (int b = 0; b < 4; ++b)
#pragma unroll
        for (int r = 0; r < 16; ++r) o[b][r] = 0.f;
    float mx = -1e30f, lsum = 0.f, carry = 0.f;
    const int kt_first = MODE == 0 ? (qg > 4 ? qg - 4 : 0) : qg, kt_last = MODE == 0 ? qg : 0, kstep = MODE == 0 ? 1 : -1;
    LAS unsigned char* Kl = wl; LAS unsigned char* Vl = wl + 8192;
    const LAS unsigned char* kbase = Kl + c * 256;
    unsigned vb[4];
    { const int g = lane >> 4, q = (lane & 15) >> 2, p = lane & 3, h = g >> 1;
#pragma unroll
      for (int b = 0; b < 4; ++b) vb[b] = (unsigned)(uintptr_t)Vl + (4 * h + q) * 256 + (((4 * b + 2 * (g & 1) + (p >> 1)) ^ (q << 2)) << 4) + 8 * (p & 1); }
    unsigned voffk[4], voffv;
    { const int rr = lane >> 4, p = lane & 15;
#pragma unroll
      for (int i = 0; i < 4; ++i) voffk[i] = (unsigned)(rr * (int)rstride * 2 + ((p ^ ((4 * i + rr) & 15)) << 4));
      voffv = (unsigned)(rr * (int)rstride * 2 + ((p ^ (rr << 2)) << 4)); }
    dma_tile_k(Kh + (size_t)(32 * kt_first) * rstride, rstride * 2, Kl, voffk);
    dma_tile_v(Vh + (size_t)(32 * kt_first) * rstride, rstride * 2, Vl, voffv);
    bool early = false;
    for (int kt = kt_first;; kt += kstep) {
        const bool has_next = (kt != kt_last);
        const int j0 = 32 * kt;
        asm volatile("s_waitcnt vmcnt(8)" ::: "memory");
        f32x16 S;
#pragma unroll
        for (int r = 0; r < 16; ++r) S[r] = 0.f;
#pragma unroll
        for (int s = 0; s < 8; ++s) {
            const bf16x8 kf = *(const LAS bf16x8*)(kbase + ((((2 * s + hi) ^ (c & 15))) << 4));
            S = __builtin_amdgcn_mfma_f32_32x32x16_bf16(kf, qf[s], S, 0, 0, 0);
        }
        asm volatile("" ::: "memory");
        if (has_next) dma_tile_k(Kh + (size_t)(j0 + 32 * kstep) * rstride, rstride * 2, Kl, voffk);
        bf16x8 pb[2];
        if constexpr (MODE == 0) {
            const int a = 160 - (i0 - j0) - c + 4 * hi;
            const LAS float* tp = tb + a;
            float x[16]; float pm = -3e38f;
#pragma unroll
            for (int r = 0; r < 16; ++r) { x[r] = fmaf(S[r], QSCALE * LOG2E, tp[8 * (r >> 2) + (r & 3)]); pm = fmaxf(pm, x[r]); }
            { auto rr = __builtin_amdgcn_permlane32_swap(__float_as_uint(pm), __float_as_uint(pm), false, false); pm = fmaxf(__uint_as_float(rr[0]), __uint_as_float(rr[1])); }
            const float mn = fmaxf(mx, pm); const float alpha = __builtin_amdgcn_exp2f(mx - mn); mx = mn;
            float ps = 0.f;
#pragma unroll
            for (int r = 0; r < 16; ++r) { x[r] = __builtin_amdgcn_exp2f(x[r] - mn); ps += x[r]; }
            { auto rr = __builtin_amdgcn_permlane32_swap(__float_as_uint(ps), __float_as_uint(ps), false, false); ps = __uint_as_float(rr[0]) + __uint_as_float(rr[1]); }
            lsum = lsum * alpha + ps;
            if (__any(alpha < 1.f)) {
#pragma unroll
                for (int b = 0; b < 4; ++b)
#pragma unroll
                    for (int r = 0; r < 16; ++r) o[b][r] *= alpha;
            }
#pragma unroll
            for (int s = 0; s < 2; ++s) { u32x4 w; w.x = pk2(x[8 * s], x[8 * s + 1]); w.y = pk2(x[8 * s + 2], x[8 * s + 3]); w.z = pk2(x[8 * s + 4], x[8 * s + 5]); w.w = pk2(x[8 * s + 6], x[8 * s + 7]); pb[s] = __builtin_bit_cast(bf16x8, w); }
        } else {
            const bool diag = (j0 == i0);
            float lk[16], ls[16];
#pragma unroll
            for (int r = 0; r < 16; ++r) {
                const float z = S[r] * QSCALE; const float az = fabsf(z);
                const float sp = fmaxf(z, 0.f) + LN2 * __builtin_amdgcn_logf(1.0f + __builtin_amdgcn_exp2f(-az * LOG2E));
                const int key = 8 * (r >> 2) + 4 * hi + (r & 3);
                const bool valid = !diag || key < c;
                lk[r] = valid ? -sp : 0.f; ls[r] = valid ? (z - sp) : -1e30f;
            }
            float gs[4];
#pragma unroll
            for (int g = 0; g < 4; ++g) gs[g] = (lk[4 * g] + lk[4 * g + 1]) + (lk[4 * g + 2] + lk[4 * g + 3]);
            float pg[4];
#pragma unroll
            for (int g = 0; g < 4; ++g) { auto rr = __builtin_amdgcn_permlane32_swap(__float_as_uint(gs[g]), __float_as_uint(gs[g]), false, false); pg[g] = hi ? __uint_as_float(rr[0]) : __uint_as_float(rr[1]); }
            float suf[4]; float run = carry;
#pragma unroll
            for (int g = 3; g >= 0; --g) { if (hi == 0) { suf[g] = run + pg[g]; run = suf[g] + gs[g]; } else { suf[g] = run; run = run + gs[g] + pg[g]; } }
            float av[16];
#pragma unroll
            for (int g = 0; g < 4; ++g) { float lt = suf[g];
#pragma unroll
                for (int e = 3; e >= 0; --e) { av[4 * g + e] = __builtin_amdgcn_exp2f((ls[4 * g + e] + lt) * LOG2E); lt += lk[4 * g + e]; } }
            carry = run;
            early = __all(carry < -105.f);
#pragma unroll
            for (int s = 0; s < 2; ++s) { u32x4 w; w.x = pk2(av[8 * s], av[8 * s + 1]); w.y = pk2(av[8 * s + 2], av[8 * s + 3]); w.z = pk2(av[8 * s + 4], av[8 * s + 5]); w.w = pk2(av[8 * s + 6], av[8 * s + 7]); pb[s] = __builtin_bit_cast(bf16x8, w); }
        }
        if (has_next) asm volatile("s_waitcnt vmcnt(8)" ::: "memory"); else asm volatile("s_waitcnt vmcnt(0)" ::: "memory");
#pragma unroll
        for (int b = 0; b < 4; ++b) {
            s16x4 l0, h0, l1, h1;
            TRRD(l0, vb[b], 0); TRRD(h0, vb[b], 2048); TRRD(l1, vb[b], 4096); TRRD(h1, vb[b], 6144);
            asm volatile("s_waitcnt lgkmcnt(0)" ::: "memory"); SBAR();
            o[b] = __builtin_amdgcn_mfma_f32_32x32x16_bf16((bf16x8){l0[0], l0[1], l0[2], l0[3], h0[0], h0[1], h0[2], h0[3]}, pb[0], o[b], 0, 0, 0);
            o[b] = __builtin_amdgcn_mfma_f32_32x32x16_bf16((bf16x8){l1[0], l1[1], l1[2], l1[3], h1[0], h1[1], h1[2], h1[3]}, pb[1], o[b], 0, 0, 0);
        }
        asm volatile("" ::: "memory");
        if (!has_next || (MODE == 1 && early)) break;
        dma_tile_v(Vh + (size_t)(j0 + 32 * kstep) * rstride, rstride * 2, Vl, voffv);
    }
    if (MODE == 1) VM_WAIT();
    const float inv = MODE == 0 ? __builtin_amdgcn_rcpf(lsum) : 1.0f;
    bf16_t* orow = Op + (size_t)(i0 + c) * ostride + 4 * hi;
#pragma unroll
    for (int b = 0; b < 4; ++b)
#pragma unroll
        for (int g = 0; g < 4; ++g) { u32x2 w; w.x = pk2(o[b][4 * g] * inv, o[b][4 * g + 1] * inv); w.y = pk2(o[b][4 * g + 2] * inv, o[b][4 * g + 3] * inv); *(u32x2*)(orow + 32 * b + 8 * g) = w; }
    if (MODE == 0 && hi == 0) lsep[(size_t)(i0 + c) * lstride] = (mx + __builtin_amdgcn_logf(lsum)) * LN2;
}

struct Params { const float* in[16]; float* out; unsigned char* ws; int ph_lo, ph_hi; };
enum { IN_X = 0, IN_RELB, IN_ANG, IN_WIN, IN_GDIL, IN_GSB, IN_WO, IN_FNG, IN_DWG, IN_DWU, IN_DWD, IN_RW, IN_MWG, IN_MWU, IN_MWD, IN_FING };
constexpr int N_PHASES = 18;

typedef const __attribute__((address_space(4))) Params* KPtr;
__device__ __forceinline__ KPtr kparams() { KPtr p = (KPtr)__builtin_amdgcn_kernarg_segment_ptr(); asm volatile("" : "+s"(p)); return p; }
#define WSP(T, off) ((T)(ws + (off)))
__device__ __forceinline__ Frame make_frame() {
    Frame F; int t = threadIdx.x; asm volatile("" : "+v"(t));
    extern __shared__ __attribute__((aligned(16))) unsigned char lds_raw[];
    F.lds = (LAS unsigned char*)lds_raw; F.MISC = (volatile LAS unsigned*)(F.lds + MISC_OFF);
    F.tid = t; F.lane = t & 63; F.wave = __builtin_amdgcn_readfirstlane(t >> 6); F.G = gridDim.x; F.gw = blockIdx.x * NWAVES + F.wave;
    return F;
}
#define PHASE_ARGS() KPtr kp = kparams(); unsigned char* const ws = kp->ws; (void)ws; const Frame F = make_frame(); const int NGW = F.G * NWAVES; (void)NGW


constexpr int I_WI = (D / 64) * (DQKV / 64), I_WO = (D / 64) * (D / 64), I_DG = (D / 64) * (DFF / 64), I_DD = (DFF / 64) * (D / 64), I_MG = (D / 64) * (DFE / 64), I_MD = (DFE / 64) * (D / 64);
constexpr int CONV_A = I_WI + I_WO + 2 * I_DG + I_DD;
constexpr int CONV_B = I_WI + I_WO + NE * (2 * I_MG + I_MD);
static_assert(CONV_B % 2 == 0, "deferred conversion split");
__device__ __forceinline__ void conv_item(KPtr kp, unsigned char* ws, int it, LAS float* scr, int lane) {
    int r = it;
    if (r < CONV_A) {
        if (r < I_WI) { tr_item(kp->in[IN_WIN], D, DQKV, WSP(bf16_t*, WS_WI), 0, scr, r, lane); return; } r -= I_WI;
        if (r < I_WO) { tr_item(kp->in[IN_WO], D, D, WSP(bf16_t*, WS_WO), 0, scr, r, lane); return; } r -= I_WO;
#if DENSE_F8
        if (r < I_DG) { tr_item8(kp->in[IN_DWG], D, DFF, WSP(unsigned char*, WS_WGU_D), D, 1, scr, r, lane); return; } r -= I_DG;
        if (r < I_DG) { tr_item8(kp->in[IN_DWU], D, DFF, WSP(unsigned char*, WS_WGU_D), D, 2, scr, r, lane); return; } r -= I_DG;
        tr_item8(kp->in[IN_DWD], DFF, D, WSP(unsigned char*, WS_WD_D), DFFP, 0, scr, r, lane); return;
#else
        if (r < I_DG) { tr_item(kp->in[IN_DWG], D, DFF, WSP(bf16_t*, WS_WGU_D), 1, scr, r, lane); return; } r -= I_DG;
        if (r < I_DG) { tr_item(kp->in[IN_DWU], D, DFF, WSP(bf16_t*, WS_WGU_D), 2, scr, r, lane); return; } r -= I_DG;
        tr_item(kp->in[IN_DWD], DFF, D, WSP(bf16_t*, WS_WD_D), 0, scr, r, lane); return;
#endif
    }
    r -= CONV_A;
    if (r < I_WI) { tr_item(kp->in[IN_WIN] + (size_t)D * DQKV, D, DQKV, WSP(bf16_t*, WS_WI) + (size_t)DQKV * D, 0, scr, r, lane); return; } r -= I_WI;
    if (r < I_WO) { tr_item(kp->in[IN_WO] + (size_t)D * D, D, D, WSP(bf16_t*, WS_WO) + (size_t)D * D, 0, scr, r, lane); return; } r -= I_WO;
    if (r < NE * I_MG) { const int e = r / I_MG; tr_item8(kp->in[IN_MWG] + (size_t)e * D * DFE, D, DFE, WSP(unsigned char*, WS_WGU_M) + (size_t)e * 2 * DFE * D, D, 1, scr, r - e * I_MG, lane); return; } r -= NE * I_MG;
    if (r < NE * I_MG) { const int e = r / I_MG; tr_item8(kp->in[IN_MWU] + (size_t)e * D * DFE, D, DFE, WSP(unsigned char*, WS_WGU_M) + (size_t)e * 2 * DFE * D, D, 2, scr, r - e * I_MG, lane); return; } r -= NE * I_MG;
    { const int e = r / I_MD; tr_item8(kp->in[IN_MWD] + (size_t)e * DFE * D, DFE, D, WSP(unsigned char*, WS_WD_M) + (size_t)e * D * DFE, DFE, 0, scr, r - e * I_MD, lane); }
}

__device__ __forceinline__ ConvDesc conv_desc_a(KPtr kp, unsigned char* ws, int r) {
    ConvDesc d;
    if (r < I_WI) { d.W = kp->in[IN_WIN]; d.WT = WSP(unsigned char*, WS_WI); d.K = D; d.N = DQKV; d.mode = 0; d.f8 = 0; d.item = r; d.ldk = D; return d; } r -= I_WI;
    if (r < I_WO) { d.W = kp->in[IN_WO]; d.WT = WSP(unsigned char*, WS_WO); d.K = D; d.N = D; d.mode = 0; d.f8 = 0; d.item = r; d.ldk = D; return d; } r -= I_WO;
    if (r < I_DG) { d.W = kp->in[IN_DWG]; d.WT = WSP(unsigned char*, WS_WGU_D); d.K = D; d.N = DFF; d.mode = 1; d.f8 = DENSE_F8; d.item = r; d.ldk = D; return d; } r -= I_DG;
    if (r < I_DG) { d.W = kp->in[IN_DWU]; d.WT = WSP(unsigned char*, WS_WGU_D); d.K = D; d.N = DFF; d.mode = 2; d.f8 = DENSE_F8; d.item = r; d.ldk = D; return d; } r -= I_DG;
    d.W = kp->in[IN_DWD]; d.WT = WSP(unsigned char*, WS_WD_D); d.K = DFF; d.N = D; d.mode = 0; d.f8 = DENSE_F8; d.item = r; d.ldk = DENSE_F8 ? DFFP : DFF; return d;
}

__device__ __forceinline__ ConvDesc conv_desc_b(KPtr kp, unsigned char* ws, int r) {
    ConvDesc d;
    if (r < I_WI) { d.W = kp->in[IN_WIN] + (size_t)D * DQKV; d.WT = WSP(unsigned char*, WS_WI) + (size_t)DQKV * D * 2; d.K = D; d.N = DQKV; d.mode = 0; d.f8 = 0; d.item = r; d.ldk = D; return d; } r -= I_WI;
    if (r < I_WO) { d.W = kp->in[IN_WO] + (size_t)D * D; d.WT = WSP(unsigned char*, WS_WO) + (size_t)D * D * 2; d.K = D; d.N = D; d.mode = 0; d.f8 = 0; d.item = r; d.ldk = D; return d; } r -= I_WO;
    if (r < NE * I_MG) { const int e = r / I_MG; d.W = kp->in[IN_MWG] + (size_t)e * D * DFE; d.WT = WSP(unsigned char*, WS_WGU_M) + (size_t)e * 2 * DFE * D; d.K = D; d.N = DFE; d.mode = 1; d.f8 = 1; d.item = r - e * I_MG; d.ldk = D; return d; } r -= NE * I_MG;
    if (r < NE * I_MG) { const int e = r / I_MG; d.W = kp->in[IN_MWU] + (size_t)e * D * DFE; d.WT = WSP(unsigned char*, WS_WGU_M) + (size_t)e * 2 * DFE * D; d.K = D; d.N = DFE; d.mode = 2; d.f8 = 1; d.item = r - e * I_MG; d.ldk = D; return d; } r -= NE * I_MG;
    { const int e = r / I_MD; d.W = kp->in[IN_MWD] + (size_t)e * DFE * D; d.WT = WSP(unsigned char*, WS_WD_M) + (size_t)e * D * DFE; d.K = DFE; d.N = D; d.mode = 0; d.f8 = 1; d.item = r - e * I_MD; d.ldk = DFE; return d; }
}

#ifndef MK_ONE_LAUNCH
#define MK_ONE_LAUNCH 1
#endif
#ifndef NORM_FOLD
#define NORM_FOLD 0
#endif
__global__ void __launch_bounds__(NTHREADS, 2) mega_fwd(Params P) {
    const Frame F0 = make_frame();
    unsigned* ctl = (unsigned*)(P.ws + WS_CTL);
    for (int u = F0.tid; u < (LDS_BYTES - MISC_OFF) / 4; u += NTHREADS) ((LAS unsigned*)(F0.lds + MISC_OFF))[u] = 0u;
    __syncthreads();
    const int lo = P.ph_lo, hi = P.ph_hi;
    const bool one_phase = (hi - lo) == 1;
    XcdBarrier bar; bar.bar = ctl + CW_BAR; bar.x = 0; bar.st = nullptr;
    if (!one_phase) bar = xcd_barrier_post(ctl + CW_BAR, F0.MISC + 8);
#ifndef PH_MASK
#define PH_MASK 0x3ffffu
#endif
#ifndef PH_MASK2
#define PH_MASK2 0x3ffffu
#endif
#define IN(k) (((PH_MASK >> ((k) > 8 ? (k) - 8 : (k))) & 1u) != 0u && ((PH_MASK2 >> (k)) & 1u) != 0u && lo <= (k) && (k) < hi)
#if defined(PHTIME)
#define PH_STAMP(k) do { KPtr kq_ = kparams(); unsigned* const dq_ = (unsigned*)(kq_->ws + WS_CTL) + 12290 + (k); if (blockIdx.x == 0 && threadIdx.x == 0) *dq_ = (unsigned)__builtin_amdgcn_s_memrealtime(); } while (0)
#else
#define PH_STAMP(k) do {} while (0)
#endif
#define SEAM(k) do { if (IN(k) && IN((k) + 1)) xcd_barrier(bar); } while (0)
#ifndef REP_TYPES
#define REP_TYPES 0
#endif
#ifndef REP_PHASE
#define REP_PHASE -1
#endif
#ifndef REP_COUNT
#define REP_COUNT 2
#endif
#define PH_BEGIN(k) for (int _rep = 0; _rep < (((k) == REP_PHASE) ? REP_COUNT : 1); ++_rep) { if (_rep) xcd_barrier(bar); if (IN(k))
#define PH_END }

    PH_STAMP(-1);
    PH_BEGIN(0) {
        PHASE_ARGS(); bf16_t* const WI = WSP(bf16_t*, WS_WI); bf16_t* const WOt = WSP(bf16_t*, WS_WO); bf16_t* const WGUD = WSP(bf16_t*, WS_WGU_D); bf16_t* const WDD = WSP(bf16_t*, WS_WD_D);
        bf16_t* const WGUM = WSP(bf16_t*, WS_WGU_M); bf16_t* const WDM = WSP(bf16_t*, WS_WD_M); bf16_t* const H = WSP(bf16_t*, WS_H);
        if (blockIdx.x < 3 * NH) { float* tbg = WSP(float*, WS_BKT) + blockIdx.x * TBL_N; const int br = blockIdx.x / NH, h = blockIdx.x % NH, dd = br == 0 ? 1 : (br == 1 ? 4 : 16);
            if (F.tid < TBL_N) { const int m_ = 160 - F.tid; tbg[F.tid] = (m_ >= 0 && m_ <= 128) ? kp->in[IN_RELB][t5_bucket(dd * m_) * NH + h] * LOG2E : -1e30f; } }
        LAS float* scr = (LAS float*)(F.lds + F.wave * WSCR);
        {
            const int per = (CONV_A + NGW - 1) / NGW, npair = (per + 1) / 2;
#define CA_IDX(i_) (F.gw + (i_) * NGW < CONV_A ? F.gw + (i_) * NGW : CONV_A - 1)
            f32x4 va[16], vb[16];
            ConvDesc da = conv_desc_a(kp, ws, CA_IDX(0)), db;
            tr_load(da, va, F.lane);
            for (int p_ = 0; p_ < npair - 1; ++p_) {
                db = conv_desc_a(kp, ws, CA_IDX(2 * p_ + 1)); tr_load(db, vb, F.lane);
                tr_finish(da, va, scr, F.lane);
                da = conv_desc_a(kp, ws, CA_IDX(2 * p_ + 2)); tr_load(da, va, F.lane);
                tr_finish(db, vb, scr, F.lane);
            }
            db = conv_desc_a(kp, ws, CA_IDX(2 * npair - 1)); tr_load(db, vb, F.lane);
            tr_finish(da, va, scr, F.lane);
            tr_finish(db, vb, scr, F.lane);
#undef CA_IDX
        }
#if DENSE_F8
        { unsigned char* wdd = WSP(unsigned char*, WS_WD_D); for (int i = blockIdx.x * NTHREADS + F.tid; i < D * ((DFFP - DFF) / 16); i += F.G * NTHREADS) { const int row = i >> 3, c = i & 7; *(u32x4*)(wdd + (size_t)row * DFFP + DFF + 16 * c) = (u32x4){0u, 0u, 0u, 0u}; } }
#endif
        rms_rows_f2b(kp->in[IN_X], kp->in[IN_ANG], H, F.gw, NGW, F.lane);
    }
    PH_END SEAM(0);

    for (int layer = 0; layer < 2; ++layer) {
        const int pb = layer == 0 ? 1 : 9;
        int lo_l = lo, hi_l = hi; asm volatile("" : "+s"(lo_l), "+s"(hi_l)); const int lo = lo_l, hi = hi_l;
        PH_BEGIN(pb) {
            PHASE_ARGS(); bf16_t* const H = WSP(bf16_t*, WS_H); bf16_t* const WI = WSP(bf16_t*, WS_WI); bf16_t* const QKV = WSP(bf16_t*, WS_QKV);
            pg8::Gemm g{H, WI + (size_t)layer * DQKV * D, T, DQKV, D}; pg8::StaticOrder S; S.init(T, DQKV, F.G, (int)blockIdx.x);
#if DENSE_F8 && NORM_FOLD
            LAS float* const rsl = (LAS float*)(F.lds + MISC_OFF) + 512;
            { const int c_ = (int)blockIdx.x, pm0 = 8 * (c_ & 7) + ((c_ >> 3) & 7); float rv = 1.0f;
              if (layer && F.tid < 256) { const f32x4* pr = (const f32x4*)(WSP(const float*, WS_PART) + (size_t)(pm0 * 256 + F.tid) * 32); f32x4 a4 = pr[0];
#pragma unroll
                  for (int k = 1; k < 8; ++k) a4 += pr[k];
                  rv = 1.0f / sqrtf((a4[0] + a4[1] + a4[2] + a4[3]) * (1.0f / D) + EPS); }
              if (F.tid < 256) rsl[F.tid] = rv;
              __syncthreads(); }
            pg8::EpiQKV E{QKV, rsl};
#else
            pg8::EpiQKV E{QKV, (const LAS float*)nullptr};
#endif
            pg8::gemm_phase<pg8::EpiQKV, pg8::StaticOrder, true, true>(F.lds, g, S, E, F.tid);
        }
        PH_END SEAM(pb);
        PH_BEGIN(pb + 1) {
            PHASE_ARGS(); bf16_t* const QKV = WSP(bf16_t*, WS_QKV); bf16_t* const OD = WSP(bf16_t*, WS_OD); bf16_t* const OS = WSP(bf16_t*, WS_OS); float* const LSE = WSP(float*, WS_LSE);
            LAS float* tbl = (LAS float*)(F.lds + TBL_OFF);
            { const float* tbg = WSP(const float*, WS_BKT); for (int i = F.tid; i < 3 * NH * TBL_N; i += NTHREADS) tbl[i] = tbg[i]; }
            __syncthreads();
            LAS unsigned char* wl = F.lds + F.wave * WSCR;
            const size_t TS = (size_t)T * DH;
            const int cbase = CONV_A + layer * (CONV_B / 2); const int ncv = CONV_B / 2; constexpr int natt_c = 4 * 4096; const int natt = natt_c; (void)natt;
#ifndef F8_ALIGN
#define F8_ALIGN true
#endif
#ifndef ATT_NA
#define ATT_NA 4
#endif
            constexpr int NA = ATT_NA, NCV = 8 - ATT_NA;
            const int NCW = F.G * NCV;
            if (F.wave >= NA) {
                const Frame FC = make_frame();
                const int c0 = blockIdx.x * NCV + (F.wave - NA); const int roff = cbase - CONV_A;
#if defined(CONV2X)
                const int per0 = (ncv + NCW - 1) / NCW, per = CONV2X * per0, npair = (per + 1) / 2;
#define CV_IDX(i_) (roff + (c0 + ((i_) % per0) * NCW < ncv ? c0 + ((i_) % per0) * NCW : ncv - 1))
#else
                const int per = (ncv + NCW - 1) / NCW, npair = (per + 1) / 2;
#define CV_IDX(i_) (roff + (c0 + (i_) * NCW < ncv ? c0 + (i_) * NCW : ncv - 1))
#endif
                f32x4 va[16], vb[16];
                ConvDesc da = conv_desc_b(kp, ws, CV_IDX(0)), db;
                tr_load(da, va, FC.lane);
                for (int p = 0; p < npair - 1; ++p) {
                    db = conv_desc_b(kp, ws, CV_IDX(2 * p + 1)); tr_load(db, vb, FC.lane);
                    tr_finish(da, va, (LAS float*)wl, FC.lane);
                    da = conv_desc_b(kp, ws, CV_IDX(2 * p + 2)); tr_load(da, va, FC.lane);
                    tr_finish(db, vb, (LAS float*)wl, FC.lane);
                }
                db = conv_desc_b(kp, ws, CV_IDX(2 * npair - 1)); tr_load(db, vb, FC.lane);
                tr_finish(da, va, (LAS float*)wl, FC.lane);
                tr_finish(db, vb, (LAS float*)wl, FC.lane);
#undef CV_IDX
            }
            {
                const Frame FA = make_frame();
                static_assert(natt_c == 8 * 2048, "2048 items per XCD queue");
                unsigned* const aqb = (unsigned*)(ws + WS_CTL) + CW_AQ + 128 * layer;
                const int x0 = (int)(xb_xcc_id() & 7u);
#define AQ_FETCH(dst_, q_) { dst_ = 0u; if (FA.lane == 0) dst_ = __hip_atomic_fetch_add(aqb + 16 * (q_), 1u, __ATOMIC_RELAXED, __HIP_MEMORY_SCOPE_AGENT); }
                if (F.wave < NA) __builtin_amdgcn_s_setprio(2);
                for (int qs = 0; qs < 8; ++qs) { const int xq = (x0 + qs) & 7;
                unsigned nv, nn; AQ_FETCH(nv, xq);
                int n = __builtin_amdgcn_readfirstlane((int)nv);
                while (n < 2048) {
                    AQ_FETCH(nn, xq);
                    const int it = ((((15 - (n >> 7)) << 3) + xq) << 7) + (n & 127);
                    const int type = it >> 12, idx = it & 4095, bh = idx >> 7, rem = idx & 127, b = bh >> 3, h = bh & 7;
                    const size_t hb = (size_t)(bh * SEQ) * HD;
                    if (type < 3) {
                        const int sh = 2 * type, dil = 1 << sh;
                        const int gps = 128 >> sh, r = rem / gps, qg = rem - r * gps; const int tok0 = b * SEQ + r;
                        const size_t sub = hb + (size_t)r * HD;
                        attn_item<0>(wl, QKV + sub, dil * HD, QKV + TS + sub, QKV + 2 * TS + sub,
                                     OD + (size_t)type * TS + (size_t)tok0 * DH + h * HD, dil * DH, LSE + (size_t)type * T * NH + (size_t)tok0 * NH + h, dil * NH, tbl + (type * NH + h) * TBL_N, qg, FA.lane);
                    } else {
                        attn_item<1>(wl, QKV + 3 * TS + hb, HD, QKV + 4 * TS + hb, QKV + 5 * TS + hb, OS + (size_t)(b * SEQ) * DH + h * HD, DH, nullptr, 0, nullptr, rem, FA.lane);
                    }
                    n = __builtin_amdgcn_readfirstlane((int)nn);
                }
                }
                __builtin_amdgcn_s_setprio(0);
#undef AQ_FETCH
            }
        }
        PH_END SEAM(pb + 1);
        PH_BEGIN(pb + 2) {
            PHASE_ARGS(); bf16_t* const OD = WSP(bf16_t*, WS_OD); bf16_t* const OS = WSP(bf16_t*, WS_OS); float* const LSE = WSP(float*, WS_LSE); bf16_t* const O = WSP(bf16_t*, WS_O);
            const float* gd = kp->in[IN_GDIL] + (size_t)layer * DH; const float* gs = kp->in[IN_GSB] + (size_t)layer * DH;
            const int h = F.lane >> 3;
            f32x4 gdq[4], gsq[4];
#pragma unroll
            for (int k = 0; k < 4; ++k) { gdq[k] = ((const f32x4*)(gd + 16 * F.lane))[k]; gsq[k] = ((const f32x4*)(gs + 16 * F.lane))[k]; }
            for (int tb0 = F.gw; tb0 < T; tb0 += 2 * NGW) {
                float ls[2][3]; u32x4 ra[2][2], rbq[2][2], rcq[2][2], rsq[2][2];
#pragma unroll
                for (int r = 0; r < 2; ++r) { const int t = tb0 + r * NGW;
                    ls[r][0] = LSE[(size_t)t * NH + h]; ls[r][1] = LSE[(size_t)(T + t) * NH + h]; ls[r][2] = LSE[(size_t)(2 * T + t) * NH + h];
                    const u32x4* p0 = (const u32x4*)(OD + (size_t)t * DH + 16 * F.lane); const u32x4* p1 = (const u32x4*)(OD + (size_t)(T + t) * DH + 16 * F.lane); const u32x4* p2 = (const u32x4*)(OD + (size_t)(2 * T + t) * DH + 16 * F.lane);
                    const u32x4* ps = (const u32x4*)(OS + (size_t)t * DH + 16 * F.lane);
#pragma unroll
                    for (int k = 0; k < 2; ++k) { ra[r][k] = p0[k]; rbq[r][k] = p1[k]; rcq[r][k] = p2[k]; rsq[r][k] = ps[k]; } }
#pragma unroll
                for (int r = 0; r < 2; ++r) { const int t = tb0 + r * NGW;
                    const float l0 = ls[r][0], l1 = ls[r][1], l2 = ls[r][2];
                    const float lm = fmaxf(l0, fmaxf(l1, l2)); float w0 = __expf(l0 - lm), w1 = __expf(l1 - lm), w2 = __expf(l2 - lm); const float wi = 1.0f / (w0 + w1 + w2); w0 *= wi; w1 *= wi; w2 *= wi;
                    float vd[16], vs[16]; float ssd = 0.f, sss = 0.f;
#pragma unroll
                    for (int k = 0; k < 2; ++k)
#pragma unroll
                        for (int j = 0; j < 4; ++j) {
                            const float d0 = w0 * bf_lo(ra[r][k][j]) + w1 * bf_lo(rbq[r][k][j]) + w2 * bf_lo(rcq[r][k][j]), d1 = w0 * bf_hi(ra[r][k][j]) + w1 * bf_hi(rbq[r][k][j]) + w2 * bf_hi(rcq[r][k][j]);
                            vd[8 * k + 2 * j] = d0; vd[8 * k + 2 * j + 1] = d1; ssd += d0 * d0 + d1 * d1;
                            const float s0 = bf_lo(rsq[r][k][j]), s1 = bf_hi(rsq[r][k][j]); vs[8 * k + 2 * j] = s0; vs[8 * k + 2 * j + 1] = s1; sss += s0 * s0 + s1 * s1; }
                    const float rd = 1.0f / sqrtf(wave_sum(ssd) * (1.0f / DH) + EPS), rs = 1.0f / sqrtf(wave_sum(sss) * (1.0f / DH) + EPS);
                    u32x4 od[2], os[2];
#pragma unroll
                    for (int k = 0; k < 2; ++k) { const f32x4 ga = gdq[2 * k], gb = gdq[2 * k + 1], ha = gsq[2 * k], hb = gsq[2 * k + 1];
                        od[k].x = pk2(vd[8 * k] * rd * ga.x, vd[8 * k + 1] * rd * ga.y); od[k].y = pk2(vd[8 * k + 2] * rd * ga.z, vd[8 * k + 3] * rd * ga.w);
                        od[k].z = pk2(vd[8 * k + 4] * rd * gb.x, vd[8 * k + 5] * rd * gb.y); od[k].w = pk2(vd[8 * k + 6] * rd * gb.z, vd[8 * k + 7] * rd * gb.w);
                        os[k].x = pk2(vs[8 * k] * rs * ha.x, vs[8 * k + 1] * rs * ha.y); os[k].y = pk2(vs[8 * k + 2] * rs * ha.z, vs[8 * k + 3] * rs * ha.w);
                        os[k].z = pk2(vs[8 * k + 4] * rs * hb.x, vs[8 * k + 5] * rs * hb.y); os[k].w = pk2(vs[8 * k + 6] * rs * hb.z, vs[8 * k + 7] * rs * hb.w); }
                    u32x4* o0 = (u32x4*)(O + (size_t)t * D + 16 * F.lane); u32x4* o1 = (u32x4*)(O + (size_t)t * D + DH + 16 * F.lane);
                    o0[0] = od[0]; o0[1] = od[1]; o1[0] = os[0]; o1[1] = os[1];
                }
            }
        }
        PH_END SEAM(pb + 2);
        PH_BEGIN(pb + 3) {
            PHASE_ARGS(); bf16_t* const O = WSP(bf16_t*, WS_O); bf16_t* const WOt = WSP(bf16_t*, WS_WO); bf16_t* const X = WSP(bf16_t*, WS_X);
            pg8::Gemm g{O, WOt + (size_t)layer * D * D, T, D, D}; pg8::StaticOrder S; S.init(T, D, F.G, (int)blockIdx.x);
            pg8::EpiResB E{layer == 0 ? kp->in[IN_X] : (const float*)nullptr, X, X, D, 1.0f};
            pg8::gemm_phase<pg8::EpiResB, pg8::StaticOrder, true, true>(F.lds, g, S, E, F.tid);
        }
        PH_END SEAM(pb + 3);
        PH_BEGIN(pb + 4) {
            PHASE_ARGS(); const bf16_t* const X = WSP(const bf16_t*, WS_X); bf16_t* const H = WSP(bf16_t*, WS_H); int* const SEL = WSP(int*, WS_SEL); float* const GWT = WSP(float*, WS_GW); int* const HIST = WSP(int*, WS_HIST);
            const float* gF = kp->in[IN_FNG] + (size_t)layer * D;
#if DENSE_F8
            if (layer == 0) {
                unsigned char* ACT = WSP(unsigned char*, WS_ACT);
                f32x4 gq[8];
#pragma unroll
                for (int q = 0; q < 8; ++q) gq[q] = ((const f32x4*)gF)[F.lane + 64 * q];
                for (int m0 = F.gw; m0 < T; m0 += 4 * NGW) {
                    u32x2 raw[4][8];
#pragma unroll
                    for (int r = 0; r < 4; ++r)
#pragma unroll
                        for (int q = 0; q < 8; ++q) raw[r][q] = ((const u32x2*)(X + (size_t)(m0 + r * NGW) * D))[F.lane + 64 * q];
#pragma unroll
                    for (int r = 0; r < 4; ++r) { const int m = m0 + r * NGW;
                        f32x4 v[8]; float ss = 0.f;
#pragma unroll
                        for (int q = 0; q < 8; ++q) { v[q] = (f32x4){bf_lo(raw[r][q].x), bf_hi(raw[r][q].x), bf_lo(raw[r][q].y), bf_hi(raw[r][q].y)}; ss += dot4(v[q]); }
                        const float rstd = F8_SH / sqrtf(wave_sum(ss) * (1.0f / D) + EPS);
                        unsigned* o8 = (unsigned*)((unsigned char*)H + (size_t)m * D) + F.lane;
#pragma unroll
                        for (int q = 0; q < 8; ++q) o8[64 * q] = pg8::pk4_fp8(v[q].x * rstd * gq[q].x, v[q].y * rstd * gq[q].y, v[q].z * rstd * gq[q].z, v[q].w * rstd * gq[q].w);
                        { u32x4 z4 = (u32x4){0u, 0u, 0u, 0u}; asm volatile("" : "+v"(z4));
                          if (F.lane < (DFFP - DFF) / 16) *(u32x4*)(ACT + (size_t)m * DFFP + DFF + 16 * F.lane) = z4; }
                    }
                }
            }
#else
            if (layer == 0) rms_rows_b2b(X, gF, H, F.gw, NGW, F.lane);
#endif
            else {
                volatile LAS unsigned* hist = F.MISC + 16;
                const int rows_per_wg = T / F.G, rows_per_wave = rows_per_wg / NWAVES;
                { const f32x4* RW4 = (const f32x4*)kp->in[IN_RW]; LAS f32x4* RL = (LAS f32x4*)F.lds;
                  for (int u = F.tid; u < 4096; u += NTHREADS) { const int ln = u & 63, k = u >> 6, half = k & 1, qi = k >> 1, i = qi & 3, q = qi >> 2; RL[u] = RW4[(4 * (ln + 64 * q) + i) * 2 + half]; } }
                __syncthreads();
                const LAS f32x4* rl = (const LAS f32x4*)F.lds + F.lane;
                f32x4 gq[8];
#pragma unroll
                for (int q = 0; q < 8; ++q) gq[q] = ((const f32x4*)gF)[F.lane + 64 * q];
                for (int jb = 0; jb < rows_per_wave; jb += 4) {
                    const int tb0 = blockIdx.x * rows_per_wg + F.wave * rows_per_wave + jb;
                    u32x2 raw[4][8];
#pragma unroll
                    for (int r = 0; r < 4; ++r)
#pragma unroll
                        for (int q = 0; q < 8; ++q) raw[r][q] = ((const u32x2*)(X + (size_t)(tb0 + r) * D))[F.lane + 64 * q];
#pragma unroll
                    for (int r = 0; r < 4; ++r) { const int t = tb0 + r;
                    f32x4 v[8]; float ss = 0.f;
#pragma unroll
                    for (int q = 0; q < 8; ++q) { v[q] = (f32x4){bf_lo(raw[r][q].x), bf_hi(raw[r][q].x), bf_lo(raw[r][q].y), bf_hi(raw[r][q].y)}; ss += dot4(v[q]); }
                    const float rstd = 1.0f / sqrtf(wave_sum(ss) * (1.0f / D) + EPS);
                    float lg[8];
#pragma unroll
                    for (int e = 0; e < 8; ++e) lg[e] = 0.f;
                    unsigned* o8 = (unsigned*)((unsigned char*)H + (size_t)t * D) + F.lane;
#pragma unroll
                    for (int q = 0; q < 8; ++q) { const f32x4 gg = gq[q]; const f32x4 y = {v[q].x * rstd * gg.x, v[q].y * rstd * gg.y, v[q].z * rstd * gg.z, v[q].w * rstd * gg.w};
                        o8[64 * q] = pg8::pk4_fp8(y.x * F8_SH, y.y * F8_SH, y.z * F8_SH, y.w * F8_SH);
#pragma unroll
                        for (int i = 0; i < 4; ++i) { const f32x4 ra = rl[((q * 4 + i) * 2) * 64], rb = rl[((q * 4 + i) * 2 + 1) * 64]; const float yi = y[i];
                            lg[0] += yi * ra.x; lg[1] += yi * ra.y; lg[2] += yi * ra.z; lg[3] += yi * ra.w; lg[4] += yi * rb.x; lg[5] += yi * rb.y; lg[6] += yi * rb.z; lg[7] += yi * rb.w; } }
#pragma unroll
                    for (int e = 0; e < 8; ++e) lg[e] = wave_sum(lg[e]);
                    if (F.lane == 0) {
                        int e1 = 0; float v1 = lg[0];
#pragma unroll
                        for (int e = 1; e < 8; ++e) if (lg[e] > v1) { v1 = lg[e]; e1 = e; }
                        int e2 = -1; float v2 = -3e38f;
#pragma unroll
                        for (int e = 0; e < 8; ++e) if (e != e1 && lg[e] > v2) { v2 = lg[e]; e2 = e; }
                        const float ex = __expf(v2 - v1); const float w1 = 1.0f / (1.0f + ex), w2 = ex * w1;
                        SEL[2 * t] = e1; SEL[2 * t + 1] = e2; GWT[2 * t] = w1; GWT[2 * t + 1] = w2;
                        __hip_atomic_fetch_add((LAS unsigned*)&hist[e1], 1u, __ATOMIC_RELAXED, __HIP_MEMORY_SCOPE_WORKGROUP); __hip_atomic_fetch_add((LAS unsigned*)&hist[e2], 1u, __ATOMIC_RELAXED, __HIP_MEMORY_SCOPE_WORKGROUP);
                    }
                    }
                }
                __syncthreads();
                if (F.tid < 8) { HIST[blockIdx.x * 8 + F.tid] = (int)hist[F.tid]; }
            }
        }
        PH_END SEAM(pb + 4);
        if (layer == 0) {
#if DENSE_F8
            PH_BEGIN(6) {
                PHASE_ARGS(); const bf16_t* const H = WSP(const bf16_t*, WS_H); const bf16_t* const WGUD = WSP(const bf16_t*, WS_WGU_D); unsigned char* const ACT = WSP(unsigned char*, WS_ACT);
                pg8::Gemm g{H, WGUD, T, 2 * DFF, D / 2}; pg8::StaticOrder S; S.init(T, 2 * DFF, F.G, (int)blockIdx.x);
                pg8::EpiSwiGLU8 E{ACT, DFFP, DFF / 128, 1.0f / (F8_SH * F8_SW), F8_SACT};
                pg8::gemm_phase<pg8::EpiSwiGLU8, pg8::StaticOrder, true, true, true>(F.lds, g, S, E, F.tid);
            }
            PH_END SEAM(6);
            PH_BEGIN(7) {
                PHASE_ARGS(); const bf16_t* const ACT = WSP(const bf16_t*, WS_ACT); const bf16_t* const WDD = WSP(const bf16_t*, WS_WD_D); bf16_t* const X = WSP(bf16_t*, WS_X);
                pg8::Gemm g{ACT, WDD, T, D, DFFP / 2}; pg8::StaticOrder S; S.init(T, D, F.G, (int)blockIdx.x);
#if NORM_FOLD
                pg8::EpiResF32N E{X, X, D, 1.0f / (F8_SACT * F8_SW), kp->in[IN_ANG] + D, WSP(bf16_t*, WS_H), WSP(float*, WS_PART)};
                pg8::gemm_phase<pg8::EpiResF32N, pg8::StaticOrder, true, true, true>(F.lds, g, S, E, F.tid);
#else
                pg8::EpiResB E{(const float*)nullptr, X, X, D, 1.0f / (F8_SACT * F8_SW)};
                pg8::gemm_phase<pg8::EpiResB, pg8::StaticOrder, true, true, true>(F.lds, g, S, E, F.tid);
#endif
            }
#else
            PH_BEGIN(6) {
                PHASE_ARGS(); bf16_t* const H = WSP(bf16_t*, WS_H); bf16_t* const WGUD = WSP(bf16_t*, WS_WGU_D); bf16_t* const ACT = WSP(bf16_t*, WS_ACT);
                pg8::Gemm g{H, WGUD, T, 2 * DFF, D}; pg8::StaticOrder S; S.init(T, 2 * DFF, F.G, (int)blockIdx.x);
                pg8::EpiSwiGLU E{ACT, DFF, DFF / 128};
#if defined(CLKPROBE)
                const unsigned long long ct0 = __builtin_amdgcn_s_memtime(), cr0 = __builtin_amdgcn_s_memrealtime();
#endif
                pg8::gemm_phase<pg8::EpiSwiGLU, pg8::StaticOrder, true, true>(F.lds, g, S, E, F.tid);
#if defined(CLKPROBE)
                { const unsigned long long ct1 = __builtin_amdgcn_s_memtime(), cr1 = __builtin_amdgcn_s_memrealtime();
                  if (blockIdx.x == 5 && F.tid == 0) { const float ghz = (float)(ct1 - ct0) / (float)(cr1 - cr0) * 0.1f; const float us = (float)(cr1 - cr0) * 0.01f;
                      unsigned* dbg = (unsigned*)(ws + WS_CTL) + 12288; dbg[0] = (unsigned)(CLKPROBE == 1 ? (int)(ghz * 4.f) : (int)(us * 0.1f + 0.5f)); } }
#endif
            }
            PH_END SEAM(6);
            PH_BEGIN(7) {
                PHASE_ARGS(); bf16_t* const ACT = WSP(bf16_t*, WS_ACT); bf16_t* const WDD = WSP(bf16_t*, WS_WD_D); bf16_t* const X = WSP(bf16_t*, WS_X);
                pg8::Gemm g{ACT, WDD, T, D, DFF}; pg8::StaticOrder S; S.init(T, D, F.G, (int)blockIdx.x);
                pg8::EpiResB E{(const float*)nullptr, X, X, D, 1.0f};
                pg8::gemm_phase<pg8::EpiResB, pg8::StaticOrder, true, true>(F.lds, g, S, E, F.tid);
            }
#endif
            PH_END SEAM(7);
#if !(DENSE_F8 && NORM_FOLD)
            PH_BEGIN(8) { PHASE_ARGS(); const bf16_t* const X = WSP(const bf16_t*, WS_X); bf16_t* const H = WSP(bf16_t*, WS_H); rms_rows_b2b(X, kp->in[IN_ANG] + D, H, F.gw, NGW, F.lane); }
            PH_END SEAM(8);
#endif
        }
    }
    PH_BEGIN(14) {
        PHASE_ARGS(); bf16_t* const H = WSP(bf16_t*, WS_H); unsigned char* const AS = WSP(unsigned char*, WS_AS); int* const SEL = WSP(int*, WS_SEL); int* const POS = WSP(int*, WS_POS); int* const HIST = WSP(int*, WS_HIST); int* const MOEINFO = WSP(int*, WS_MOEINFO);
        volatile LAS unsigned* tot = F.MISC + 32; volatile LAS unsigned* pre = F.MISC + 40; volatile LAS unsigned* rbase = F.MISC + 48; volatile LAS unsigned* ent = F.MISC + 64;
        if (F.tid < 16) F.MISC[32 + F.tid] = 0u;
        __syncthreads();
        { const int e = F.tid & 7, ch = F.tid >> 3; unsigned st = 0, sp = 0;
#pragma unroll
          for (int k = 0; k < 4; ++k) { const int w = 4 * ch + k; const unsigned hv = (unsigned)HIST[w * 8 + e]; st += hv; if (w < (int)blockIdx.x) sp += hv; }
          __hip_atomic_fetch_add((LAS unsigned*)&tot[e], st, __ATOMIC_RELAXED, __HIP_MEMORY_SCOPE_WORKGROUP); __hip_atomic_fetch_add((LAS unsigned*)&pre[e], sp, __ATOMIC_RELAXED, __HIP_MEMORY_SCOPE_WORKGROUP); }
        __syncthreads();
        if (F.tid == 0) { unsigned tbv = 0;
            for (int e = 0; e < 8; ++e) { rbase[e] = tbv * 256u + pre[e]; if (blockIdx.x == 0) MOEINFO[e] = (int)tbv; tbv += (tot[e] + 255u) >> 8; }
            if (blockIdx.x == 0) MOEINFO[8] = (int)tbv; }
        const int t0 = blockIdx.x * 64;
        if (F.tid < 128) ent[F.tid] = (unsigned)SEL[2 * t0 + F.tid];
        __syncthreads();
        if (F.tid < 128) { const unsigned e = ent[F.tid]; unsigned rank = 0; for (int j = 0; j < F.tid; ++j) rank += (ent[j] == e) ? 1u : 0u;
            const unsigned pos = rbase[e] + rank; POS[2 * t0 + F.tid] = (int)pos; F.MISC[192 + F.tid] = pos; }
        __syncthreads();
        for (int q = 0; q < 16; q += 8) {
            u32x4 v[8][2];
#pragma unroll
            for (int k = 0; k < 8; ++k) { const int en = 16 * F.wave + q + k; const u32x4* src = (const u32x4*)((const unsigned char*)H + (size_t)(t0 + (en >> 1)) * D) + F.lane;
                v[k][0] = src[0]; v[k][1] = src[64]; }
#pragma unroll
            for (int k = 0; k < 8; ++k) { const int en = 16 * F.wave + q + k; u32x4* dst = (u32x4*)(AS + (size_t)F.MISC[192 + en] * D) + F.lane;
                dst[0] = v[k][0]; dst[64] = v[k][1]; }
        }
    }
    PH_END SEAM(14);
    if (IN(15) || IN(16)) {
        PHASE_ARGS(); int* const MOEINFO = WSP(int*, WS_MOEINFO); const bf16_t* const AS = WSP(const bf16_t*, WS_AS); const bf16_t* const WGUM = WSP(const bf16_t*, WS_WGU_M); unsigned char* const ACTM = WSP(unsigned char*, WS_ACTM); const bf16_t* const WDM = WSP(const bf16_t*, WS_WD_M); bf16_t* const Y = WSP(bf16_t*, WS_Y);
        int tbv[9];
#pragma unroll
        for (int k = 0; k < 9; ++k) tbv[k] = __builtin_amdgcn_readfirstlane((int)__hip_atomic_load((unsigned*)MOEINFO + k, __ATOMIC_RELAXED, __HIP_MEMORY_SCOPE_AGENT));
        PH_BEGIN(15) {
            pg8::Gemm g{AS, WGUM, MOE_ROWS, NE * 2 * DFE, D / 2}; pg8::GroupedOrder S; S.init(tbv[8], 2 * DFE / 256, F.G, (int)blockIdx.x);
#pragma unroll
            for (int k = 0; k < 9; ++k) S.tb[k] = tbv[k];
            pg8::EpiSwiGLU8 E{ACTM, DFE, 2 * DFE / 256, 1.0f / (F8_SH * F8_SW), F8_SACT};
            pg8::gemm_phase<pg8::EpiSwiGLU8, pg8::GroupedOrder, F8_ALIGN, true, true>(F.lds, g, S, E, F.tid);
        }
        PH_END SEAM(15);
        PH_BEGIN(16) {
#if defined(NO_TAIL)
            const int rmain = tbv[8];
#else
            const int rmain = tbv[8] < TAIL_T0 ? tbv[8] : TAIL_T0;
#endif
            pg8::Gemm g{(const bf16_t*)ACTM, WDM, MOE_ROWS, NE * D, DFE / 2}; pg8::GroupedOrder S; S.init(rmain, D / 256, F.G, (int)blockIdx.x);
#pragma unroll
            for (int k = 0; k < 9; ++k) S.tb[k] = tbv[k];
            pg8::EpiBf16G E{Y, D, D / 256};
            pg8::gemm_phase<pg8::EpiBf16G, pg8::GroupedOrder, F8_ALIGN, true, true>(F.lds, g, S, E, F.tid);
            pg8::TailOrder S2; S2.init(tbv[8] - rmain, D / 256, TAIL_SL, TAIL_NT, F.G, (int)blockIdx.x);
#pragma unroll
            for (int k = 0; k < 9; ++k) S2.tb[k] = tbv[k];
            pg8::EpiPartF32 E2{WSP(float*, WS_YP), D / 256, TAIL_NT * 128, (unsigned)(TAIL_MAXT * 256 * D)};
            pg8::gemm_phase<pg8::EpiPartF32, pg8::TailOrder, F8_ALIGN, true, true>(F.lds, g, S2, E2, F.tid);
        } PH_END
    }
    SEAM(16);
    PH_BEGIN(17) {
        PHASE_ARGS(); const bf16_t* const X = WSP(const bf16_t*, WS_X); bf16_t* const Y = WSP(bf16_t*, WS_Y); int* const POS = WSP(int*, WS_POS); float* const GWT = WSP(float*, WS_GW);
        const float* gfin = kp->in[IN_FING];
#if defined(PHTIME)
        xcd_barrier(bar);
#endif
        {
            const int ntr = (WSP(const int*, WS_MOEINFO)[8] - TAIL_T0) * 256; const float* const YP = WSP(const float*, WS_YP);
            for (int r = F.gw; r < ntr; r += NGW) {
#pragma unroll
                for (int jh = 0; jh < 2; ++jh) { f32x4 s[4];
#pragma unroll
                    for (int j = 0; j < 4; ++j) s[j] = ((const f32x4*)(YP + (size_t)r * D))[F.lane + 64 * (4 * jh + j)];
#pragma unroll
                    for (int k = 1; k < TAIL_SL; ++k)
#pragma unroll
                        for (int j = 0; j < 4; ++j) s[j] += ((const f32x4*)(YP + ((size_t)k * TAIL_MAXT * 256 + r) * D))[F.lane + 64 * (4 * jh + j)];
#pragma unroll
                    for (int j = 0; j < 4; ++j) { u32x2 w; w.x = pk2(s[j].x, s[j].y); w.y = pk2(s[j].z, s[j].w); ((u32x2*)(Y + (size_t)(TAIL_T0 * 256 + r) * D))[F.lane + 64 * (4 * jh + j)] = w; }
                }
            }
            if (!one_phase) xcd_barrier(bar);
        }
#if defined(PHTIME)
        unsigned dbgv; { const unsigned s0_ = __hip_atomic_load((unsigned*)(ws + WS_CTL) + 12290 + PHTIME - 1, __ATOMIC_RELAXED, __HIP_MEMORY_SCOPE_AGENT), s1_ = __hip_atomic_load((unsigned*)(ws + WS_CTL) + 12290 + PHTIME, __ATOMIC_RELAXED, __HIP_MEMORY_SCOPE_AGENT);
            const float us_ = (float)(s1_ - s0_) * 0.01f; int v_ = (int)floorf(log2f(us_ / (float)(PHUNIT)) * 6.0f); v_ = v_ < 0 ? 0 : (v_ > 29 ? 29 : v_); dbgv = (unsigned)(1 + v_); }
#elif defined(CLKPROBE)
        const unsigned dbgv = __hip_atomic_load((unsigned*)(ws + WS_CTL) + 12288, __ATOMIC_RELAXED, __HIP_MEMORY_SCOPE_AGENT);
#endif
        f32x4 gq[8];
#pragma unroll
        for (int j = 0; j < 8; ++j) gq[j] = ((const f32x4*)gfin)[F.lane + 64 * j];
        for (int tb0 = F.gw; tb0 < T; tb0 += 2 * NGW) {
            int pp[2][2]; float ww[2][2];
#pragma unroll
            for (int r = 0; r < 2; ++r) { const int t = tb0 + r * NGW; pp[r][0] = POS[2 * t]; pp[r][1] = POS[2 * t + 1];
                ww[r][0] = GWT[2 * t] * (1.0f / (F8_SACT * F8_SW)); ww[r][1] = GWT[2 * t + 1] * (1.0f / (F8_SACT * F8_SW)); }
            u32x2 rx[2][8], ra[2][8], rb[2][8];
#pragma unroll
            for (int r = 0; r < 2; ++r) { const int t = tb0 + r * NGW;
                const u32x2* xr = (const u32x2*)(X + (size_t)t * D) + F.lane; const u32x2* y0 = (const u32x2*)(Y + (size_t)pp[r][0] * D) + F.lane; const u32x2* y1 = (const u32x2*)(Y + (size_t)pp[r][1] * D) + F.lane;
#pragma unroll
                for (int j = 0; j < 8; ++j) { rx[r][j] = xr[64 * j]; ra[r][j] = y0[64 * j]; rb[r][j] = y1[64 * j]; } }
#pragma unroll
            for (int r = 0; r < 2; ++r) { const int t = tb0 + r * NGW; const float w0 = ww[r][0], w1 = ww[r][1];
                f32x4 v[8]; float ss = 0.f;
#pragma unroll
                for (int j = 0; j < 8; ++j) { const u32x2 x2 = rx[r][j], a = ra[r][j], b = rb[r][j];
                    v[j].x = bf_lo(x2.x) + w0 * bf_lo(a.x) + w1 * bf_lo(b.x); v[j].y = bf_hi(x2.x) + w0 * bf_hi(a.x) + w1 * bf_hi(b.x); v[j].z = bf_lo(x2.y) + w0 * bf_lo(a.y) + w1 * bf_lo(b.y); v[j].w = bf_hi(x2.y) + w0 * bf_hi(a.y) + w1 * bf_hi(b.y);
                    ss += dot4(v[j]); }
                const float rstd = 1.0f / sqrtf(wave_sum(ss) * (1.0f / D) + EPS);
                f32x4* orow = (f32x4*)(kp->out + (size_t)t * D) + F.lane;
#pragma unroll
                for (int j = 0; j < 8; ++j) { const f32x4 gg = gq[j]; f32x4 ov = (f32x4){v[j].x * rstd * gg.x, v[j].y * rstd * gg.y, v[j].z * rstd * gg.z, v[j].w * rstd * gg.w};
#if defined(CLKPROBE) || defined(PHTIME)
                    ov = ov * (1.0f + (float)dbgv);
#endif
                    orow[64 * j] = ov; }
            }
        }
    } PH_END
#undef IN
#undef SEAM
}

#ifndef MK_ONE_LAUNCH
#define MK_ONE_LAUNCH 1
#endif
extern "C" void kernel_launch(void* const* d_in, const int* in_sizes, int n_in, void* d_out, int out_size, void* d_ws, size_t ws_size, hipStream_t stream) {
    static int grid = 0;
    if (grid == 0) {
        if (n_in != 16 || in_sizes[0] != T * D || out_size != T * D || ws_size < WS_END) { fprintf(stderr, "kernel_launch: shape/workspace mismatch (n_in %d, in0 %d, out %d, ws %zu, need %zu)\n", n_in, n_in > 0 ? in_sizes[0] : -1, out_size, ws_size, (size_t)WS_END); grid = -1; return; }
        int dev = 0, cus = 0, per_cu = 0;
        if (hipGetDevice(&dev) != hipSuccess || hipDeviceGetAttribute(&cus, hipDeviceAttributeMultiprocessorCount, dev) != hipSuccess) { grid = -1; return; }
        if (hipFuncSetAttribute((const void*)mega_fwd, hipFuncAttributeMaxDynamicSharedMemorySize, LDS_BYTES) != hipSuccess) { fprintf(stderr, "kernel_launch: hipFuncSetAttribute failed\n"); grid = -1; return; }
        if (hipOccupancyMaxActiveBlocksPerMultiprocessor(&per_cu, (const void*)mega_fwd, NTHREADS, LDS_BYTES) != hipSuccess || per_cu < 1) fprintf(stderr, "kernel_launch: occupancy query says %d\n", per_cu);
        (void)hipGetLastError();
        grid = cus;
        if (grid != 256) { fprintf(stderr, "kernel_launch: built for 256 CUs, found %d\n", cus); grid = -1; return; }
    }
    if (grid < 0) return;
    (void)hipMemsetAsync((char*)d_ws + WS_CTL, 0, CTL_ZERO_BYTES, stream);
    Params p{};
    for (int i = 0; i < 16; ++i) p.in[i] = (const float*)d_in[i];
    p.out = (float*)d_out; p.ws = (unsigned char*)d_ws;
#if MK_ONE_LAUNCH
    p.ph_lo = 0; p.ph_hi = N_PHASES;
    hipLaunchKernelGGL(mega_fwd, dim3(grid), dim3(NTHREADS), LDS_BYTES, stream, p);
#else
    for (int ph = 0; ph < N_PHASES; ++ph) { p.ph_lo = ph; p.ph_hi = ph + 1; hipLaunchKernelGGL(mega_fwd, dim3(grid), dim3(NTHREADS), LDS_BYTES, stream, p); }
#endif
}
```

```cpp
#include <hip/hip_runtime.h>
#include <cstdio>
#include <cstdint>
namespace pg8 {
#define PG8_LAS __attribute__((address_space(3)))
typedef unsigned short bf16_t;
typedef short bf16x8 __attribute__((ext_vector_type(8)));
typedef float f32x4 __attribute__((ext_vector_type(4)));
typedef unsigned u32x4 __attribute__((ext_vector_type(4)));
typedef int i32x4 __attribute__((ext_vector_type(4)));
typedef int v8i32 __attribute__((ext_vector_type(8)));
typedef unsigned u32x2 __attribute__((ext_vector_type(2)));
constexpr int BM = 256, BK = 64, HALF = 128, HTB = HALF * BK * 2  , STAGE_BYTES = 8 * HTB, NXCD = 8, WGM = 8;

__host__ __device__ __forceinline__ int lds_byte(int r, int c) { const int st = (r >> 4) * 2 + (c >> 5), rr = r & 15, cc = c & 31, ob = rr * 64 + cc * 2; return st * 1024 + (ob ^ (((ob >> 9) & 1) << 5)); }
__host__ __device__ __forceinline__ void stage_rc(int b, int& R, int& C) { const int st = b / 1024, sb = b % 1024, swz = sb ^ (((sb >> 9) & 1) << 5); R = (st >> 1) * 16 + swz / 64; C = (st & 1) * 32 + (swz % 64) / 2; }
__host__ __device__ __forceinline__ int perm32(int rho) { const int n = rho >> 4, i = rho & 15; return 8 * (i >> 2) + 4 * n + (i & 3); }

struct Unit { int pm, pn, ko; };
struct Gemm { const bf16_t* A; const bf16_t* Bt; int M, N, K; };

struct StaticOrder {
    static constexpr bool SPLITK = false;
    int nM, nN, nwg, G, c;
    __host__ __device__ void init(int M, int N, int G_, int c_) { nM = M / BM; nN = N / BM; nwg = nM * nN; G = G_; c = c_; }
    __host__ __device__ bool next(int i, Unit& u) const {
        const long L = (long)i * G + c; if (L >= nwg) return false;
        int wgid = (int)L; { const int q = nwg / NXCD, r = nwg % NXCD, xcd = wgid % NXCD, off = wgid / NXCD; wgid = (xcd < r ? xcd * (q + 1) : r * (q + 1) + (xcd - r) * q) + off; }
        const int nig = WGM * nN, gid = wgid / nig, fm = gid * WGM, gsz = (nM - fm) < WGM ? (nM - fm) : WGM;
        u.pm = fm + ((wgid % nig) % gsz); u.pn = (wgid % nig) / gsz; return true;
    }
    __device__ __forceinline__ void a_ready(const Unit&) const {}
    __device__ __forceinline__ void done(const Unit&) const {}
};

__device__ __forceinline__ unsigned cvt_pk_bf16(float lo, float hi) { unsigned r; asm volatile("v_cvt_pk_bf16_f32 %0, %1, %2" : "=v"(r) : "v"(lo), "v"(hi)); return r; }

struct EpiBf16 {
    static constexpr bool PERM = true, AFTER_DRAIN = false;
    bf16_t* O; int ldc; int split_cols; size_t split_stride; int tpe;
    __device__ __forceinline__ void operator()(const f32x4 (&acc)[2][2][4][2], const Unit& u, int wr, int wc, int fr, int fq) const {
        const int row0 = u.pm * BM + wr * 64 + fr; int colt = (tpe ? (u.pn % tpe) : u.pn) * BM; bf16_t* base = O;
        if (split_cols) { const int t = colt / split_cols; base += (size_t)t * split_stride; colt -= t * split_cols; }
        const int col0 = colt + wc * 32 + 8 * fq;
#pragma unroll
        for (int ai = 0; ai < 2; ++ai)
#pragma unroll
            for (int m = 0; m < 4; ++m) { bf16_t* rowp = base + (size_t)(row0 + ai * HALF + m * 16) * ldc + col0;
#pragma unroll
                for (int bj = 0; bj < 2; ++bj) { const f32x4 v0 = acc[ai][bj][m][0], v1 = acc[ai][bj][m][1];
                    u32x4 w; w.x = cvt_pk_bf16(v0[0], v0[1]); w.y = cvt_pk_bf16(v0[2], v0[3]); w.z = cvt_pk_bf16(v1[0], v1[1]); w.w = cvt_pk_bf16(v1[2], v1[3]);
                    *(u32x4*)(rowp + bj * HALF) = w; } }
    }
};


struct EpiBf16G {
    static constexpr bool PERM = true, AFTER_DRAIN = false;
    bf16_t* O; int ldc; int tpe;
    __device__ __forceinline__ void operator()(const f32x4 (&acc)[2][2][4][2], const Unit& u, int wr, int wc, int fr, int fq) const {
        const unsigned off0 = (unsigned)(u.pm * BM + wr * 64 + fr) * (unsigned)ldc + (unsigned)((u.pn % tpe) * BM + wc * 32 + 8 * fq);
#pragma unroll
        for (int ai = 0; ai < 2; ++ai)
#pragma unroll
            for (int m = 0; m < 4; ++m)
#pragma unroll
                for (int bj = 0; bj < 2; ++bj) { const f32x4 v0 = acc[ai][bj][m][0], v1 = acc[ai][bj][m][1];
                    u32x4 w; w.x = cvt_pk_bf16(v0[0], v0[1]); w.y = cvt_pk_bf16(v0[2], v0[3]); w.z = cvt_pk_bf16(v1[0], v1[1]); w.w = cvt_pk_bf16(v1[2], v1[3]);
                    *(u32x4*)(O + (off0 + (unsigned)((ai * HALF + m * 16) * ldc + bj * HALF))) = w; }
    }
};
struct EpiQKV {
    static constexpr bool PERM = true, AFTER_DRAIN = false;
    bf16_t* O; const PG8_LAS float* rsl;
    __device__ __forceinline__ void operator()(const f32x4 (&acc)[2][2][4][2], const Unit& u, int wr, int wc, int fr, int fq) const {
        const int t = u.pn >> 2, hp = u.pn & 3; const int m0 = u.pm * BM, b = m0 >> 12, s0 = (m0 & 4095) + wr * 64 + fr;
        const size_t TS = (size_t)16384 * 1024;
        bf16_t* base = O + (size_t)t * TS + wc * 32 + 8 * fq;
#pragma unroll
        for (int ai = 0; ai < 2; ++ai)
#pragma unroll
            for (int m = 0; m < 4; ++m) { const int s = s0 + ai * HALF + m * 16;
                float rs = 1.0f; if (rsl) rs = rsl[wr * 64 + fr + ai * HALF + m * 16];
#pragma unroll
                for (int bj = 0; bj < 2; ++bj) { const f32x4 v0 = acc[ai][bj][m][0] * rs, v1 = acc[ai][bj][m][1] * rs;
                    u32x4 w; w.x = cvt_pk_bf16(v0[0], v0[1]); w.y = cvt_pk_bf16(v0[2], v0[3]); w.z = cvt_pk_bf16(v1[0], v1[1]); w.w = cvt_pk_bf16(v1[2], v1[3]);
                    const size_t hb = (size_t)((b * 8 + 2 * hp + bj) * 4096);
                    *(u32x4*)(base + (hb + s) * 128) = w; } }
    }
};
struct EpiResB {
    static constexpr bool PERM = true, AFTER_DRAIN = false;
    const float* basef; const bf16_t* baseb; bf16_t* out; int ldc; float scale;
    __device__ __forceinline__ void operator()(const f32x4 (&acc)[2][2][4][2], const Unit& u, int wr, int wc, int fr, int fq) const {
        const unsigned off0 = (unsigned)(u.pm * BM + wr * 64 + fr) * (unsigned)ldc + (unsigned)(u.pn * BM + wc * 32 + 8 * fq);
#pragma unroll
        for (int ai = 0; ai < 2; ++ai) {
            f32x4 b0[4][2], b1[4][2];
            if (basef) {
#pragma unroll
                for (int m = 0; m < 4; ++m)
#pragma unroll
                    for (int bj = 0; bj < 2; ++bj) { const unsigned o = off0 + (unsigned)((ai * HALF + m * 16) * ldc + bj * HALF); b0[m][bj] = *(const f32x4*)(basef + o); b1[m][bj] = *(const f32x4*)(basef + o + 4); }
            } else {
                u32x4 w[4][2];
#pragma unroll
                for (int m = 0; m < 4; ++m)
#pragma unroll
                    for (int bj = 0; bj < 2; ++bj) w[m][bj] = *(const u32x4*)(baseb + (off0 + (unsigned)((ai * HALF + m * 16) * ldc + bj * HALF)));
#pragma unroll
                for (int m = 0; m < 4; ++m)
#pragma unroll
                    for (int bj = 0; bj < 2; ++bj) { const u32x4 q = w[m][bj];
                        b0[m][bj] = (f32x4){__builtin_bit_cast(float, q.x << 16), __builtin_bit_cast(float, q.x & 0xffff0000u), __builtin_bit_cast(float, q.y << 16), __builtin_bit_cast(float, q.y & 0xffff0000u)};
                        b1[m][bj] = (f32x4){__builtin_bit_cast(float, q.z << 16), __builtin_bit_cast(float, q.z & 0xffff0000u), __builtin_bit_cast(float, q.w << 16), __builtin_bit_cast(float, q.w & 0xffff0000u)}; }
            }
#pragma unroll
            for (int m = 0; m < 4; ++m)
#pragma unroll
                for (int bj = 0; bj < 2; ++bj) { const f32x4 v0 = b0[m][bj] + acc[ai][bj][m][0] * scale, v1 = b1[m][bj] + acc[ai][bj][m][1] * scale;
                    u32x4 wv; wv.x = cvt_pk_bf16(v0[0], v0[1]); wv.y = cvt_pk_bf16(v0[2], v0[3]); wv.z = cvt_pk_bf16(v1[0], v1[1]); wv.w = cvt_pk_bf16(v1[2], v1[3]);
                    *(u32x4*)(out + (off0 + (unsigned)((ai * HALF + m * 16) * ldc + bj * HALF))) = wv; }
            asm volatile("" ::: "memory");
        }
    }
};
struct EpiResF32 {
    static constexpr bool PERM = false, AFTER_DRAIN = false;
    const float* base; float* out; int ldc; float scale;
    __device__ __forceinline__ void operator()(const f32x4 (&acc)[2][2][4][2], const Unit& u, int wr, int wc, int fr, int fq) const {
        const int row0 = u.pm * BM + wr * 64 + fr, col0 = u.pn * BM + wc * 32 + 4 * fq;
#pragma unroll
        for (int ai = 0; ai < 2; ++ai)
#pragma unroll
            for (int m = 0; m < 4; ++m) { const size_t off = (size_t)(row0 + ai * HALF + m * 16) * ldc + col0;
                f32x4 bs[2][2];
#pragma unroll
                for (int bj = 0; bj < 2; ++bj)
#pragma unroll
                    for (int n = 0; n < 2; ++n) bs[bj][n] = *(const f32x4*)(base + off + bj * HALF + n * 16);
#pragma unroll
                for (int bj = 0; bj < 2; ++bj)
#pragma unroll
                    for (int n = 0; n < 2; ++n) *(f32x4*)(out + off + bj * HALF + n * 16) = bs[bj][n] + acc[ai][bj][m][n] * scale;
                asm volatile("" ::: "memory"); }
    }
};
struct EpiResF32N {
    static constexpr bool PERM = false, AFTER_DRAIN = false;
    const float* base; float* out; int ldc; float scale; const float* gain; bf16_t* Hn; float* part;
    __device__ __forceinline__ void operator()(const f32x4 (&acc)[2][2][4][2], const Unit& u, int wr, int wc, int fr, int fq) const {
        const int row0 = u.pm * BM + wr * 64 + fr, col0 = u.pn * BM + wc * 32 + 4 * fq;
        f32x4 gn[2][2];
#pragma unroll
        for (int bj = 0; bj < 2; ++bj)
#pragma unroll
            for (int n = 0; n < 2; ++n) gn[bj][n] = *(const f32x4*)(gain + col0 + bj * HALF + n * 16);
#pragma unroll
        for (int ai = 0; ai < 2; ++ai)
#pragma unroll
            for (int m = 0; m < 4; ++m) { const int row = row0 + ai * HALF + m * 16; const size_t off = (size_t)row * ldc + col0;
                f32x4 bs[2][2]; float ss = 0.f;
#pragma unroll
                for (int bj = 0; bj < 2; ++bj)
#pragma unroll
                    for (int n = 0; n < 2; ++n) bs[bj][n] = *(const f32x4*)(base + off + bj * HALF + n * 16);
#pragma unroll
                for (int bj = 0; bj < 2; ++bj)
#pragma unroll
                    for (int n = 0; n < 2; ++n) { const f32x4 xn = bs[bj][n] + acc[ai][bj][m][n] * scale; *(f32x4*)(out + off + bj * HALF + n * 16) = xn;
                        ss += xn[0] * xn[0] + xn[1] * xn[1] + xn[2] * xn[2] + xn[3] * xn[3];
                        const f32x4 hg = xn * gn[bj][n]; u32x2 w; w.x = cvt_pk_bf16(hg[0], hg[1]); w.y = cvt_pk_bf16(hg[2], hg[3]);
                        *(u32x2*)(Hn + off + bj * HALF + n * 16) = w; }
                ss += __shfl_xor(ss, 16); ss += __shfl_xor(ss, 32);
                if (fq == 0) part[(size_t)row * 32 + (u.pn * 4 + wc)] = ss;
                asm volatile("" ::: "memory"); }
    }
};
__device__ __forceinline__ float silu_mul(float g, float u) { return g * u * __builtin_amdgcn_rcpf(1.0f + __builtin_amdgcn_exp2f(g * -1.4426950408889634f)); }
struct EpiSwiGLU {
    static constexpr bool PERM = true, AFTER_DRAIN = false;
    bf16_t* O; int ldc; int tpe;
    __device__ __forceinline__ void operator()(const f32x4 (&acc)[2][2][4][2], const Unit& u, int wr, int wc, int fr, int fq) const {
        const int row0 = u.pm * BM + wr * 64 + fr, col0 = (u.pn % tpe) * HALF + wc * 32 + 8 * fq;
#pragma unroll
        for (int ai = 0; ai < 2; ++ai)
#pragma unroll
            for (int m = 0; m < 4; ++m) { bf16_t* rowp = O + (size_t)(row0 + ai * HALF + m * 16) * ldc + col0;
                const f32x4 g0 = acc[ai][0][m][0], g1 = acc[ai][0][m][1], u0 = acc[ai][1][m][0], u1 = acc[ai][1][m][1];
                u32x4 w; w.x = cvt_pk_bf16(silu_mul(g0[0], u0[0]), silu_mul(g0[1], u0[1])); w.y = cvt_pk_bf16(silu_mul(g0[2], u0[2]), silu_mul(g0[3], u0[3]));
                w.z = cvt_pk_bf16(silu_mul(g1[0], u1[0]), silu_mul(g1[1], u1[1])); w.w = cvt_pk_bf16(silu_mul(g1[2], u1[2]), silu_mul(g1[3], u1[3]));
                *(u32x4*)rowp = w; }
    }
};

__device__ __forceinline__ unsigned pk4_fp8(float a, float b, float c, float d) {
    a = __builtin_amdgcn_fmed3f(a, -448.f, 448.f); b = __builtin_amdgcn_fmed3f(b, -448.f, 448.f); c = __builtin_amdgcn_fmed3f(c, -448.f, 448.f); d = __builtin_amdgcn_fmed3f(d, -448.f, 448.f);
    int p = __builtin_amdgcn_cvt_pk_fp8_f32(a, b, 0, false); p = __builtin_amdgcn_cvt_pk_fp8_f32(c, d, p, true); return (unsigned)p;
}
struct EpiSwiGLU8 {
    static constexpr bool PERM = true, AFTER_DRAIN = false;
    unsigned char* O; int ldc; int tpe; float in_scale, out_scale;
    __device__ __forceinline__ void operator()(const f32x4 (&acc)[2][2][4][2], const Unit& u, int wr, int wc, int fr, int fq) const {
        const int row0 = u.pm * BM + wr * 64 + fr, col0 = (u.pn % tpe) * HALF + wc * 32 + 8 * fq;
#pragma unroll
        for (int ai = 0; ai < 2; ++ai)
#pragma unroll
            for (int m = 0; m < 4; ++m) { unsigned char* rowp = O + (size_t)(row0 + ai * HALF + m * 16) * ldc + col0;
                const f32x4 g0 = acc[ai][0][m][0] * in_scale, g1 = acc[ai][0][m][1] * in_scale, u0 = acc[ai][1][m][0] * (in_scale * out_scale), u1 = acc[ai][1][m][1] * (in_scale * out_scale);
                u32x2 w; w.x = pk4_fp8(silu_mul(g0[0], u0[0]), silu_mul(g0[1], u0[1]), silu_mul(g0[2], u0[2]), silu_mul(g0[3], u0[3]));
                w.y = pk4_fp8(silu_mul(g1[0], u1[0]), silu_mul(g1[1], u1[1]), silu_mul(g1[2], u1[2]), silu_mul(g1[3], u1[3]));
                *(u32x2*)rowp = w; }
    }
};
struct GroupedOrder {
    static constexpr bool SPLITK = false;
    int nM, nN, nwg, G, c; int tb[9];
    __device__ __forceinline__ void init(int RT, int nN_, int G_, int c_) { nM = RT; nN = nN_; nwg = nM * nN; G = G_; c = c_; }
    __device__ __forceinline__ bool next(int i, Unit& u) const {
        const long L = (long)i * G + c; if (L >= nwg) return false;
        int wgid = (int)L; { const int q = nwg / NXCD, r = nwg % NXCD, xcd = wgid % NXCD, off = wgid / NXCD; wgid = (xcd < r ? xcd * (q + 1) : r * (q + 1) + (xcd - r) * q) + off; }
        const int nig = WGM * nN, gid = wgid / nig, fm = gid * WGM, gsz = (nM - fm) < WGM ? (nM - fm) : WGM;
        const int pm = fm + ((wgid % nig) % gsz), pn = (wgid % nig) / gsz; int e = 0;
#pragma unroll
        for (int k = 1; k < 8; ++k) e += (pm >= tb[k]) ? 1 : 0;
        u.pm = pm; u.pn = e * nN + pn; return true;
    }
    __device__ __forceinline__ void a_ready(const Unit&) const {}
    __device__ __forceinline__ void done(const Unit&) const {}
};
struct TailOrder {
    static constexpr bool SPLITK = true;
    int nunits, nN, nsl, nt, G, c; int tb[9];
    __device__ __forceinline__ void init(int ntail, int nN_, int nsl_, int nt_, int G_, int c_) { nN = nN_; nsl = nsl_; nt = nt_; nunits = ntail * nN_ * nsl_; G = G_; c = c_; }
    __device__ __forceinline__ bool next(int i, Unit& u) const {
        const int L = i * G + c; if (L >= nunits) return false;
        const int ks = L % nsl, r = L / nsl, pn = r % nN, pm = 128 + r / nN; int e = 0;
#pragma unroll
        for (int k = 1; k < 8; ++k) e += (pm >= tb[k]) ? 1 : 0;
        u.pm = pm; u.pn = e * nN + pn; u.ko = ks * nt * 128; return true;
    }
    __device__ __forceinline__ void a_ready(const Unit&) const {}
    __device__ __forceinline__ void done(const Unit&) const {}
};
struct EpiPartF32 {
    static constexpr bool PERM = true, AFTER_DRAIN = false;
    float* P; int tpe; int slice_bytes; unsigned slice_elems;
    __device__ __forceinline__ void operator()(const f32x4 (&acc)[2][2][4][2], const Unit& u, int wr, int wc, int fr, int fq) const {
        float* const base = P + (size_t)(u.ko / slice_bytes) * slice_elems;
        const unsigned off0 = (unsigned)((u.pm - 128) * BM + wr * 64 + fr) * 2048u + (unsigned)((u.pn % tpe) * BM + wc * 32 + 8 * fq);
#pragma unroll
        for (int ai = 0; ai < 2; ++ai)
#pragma unroll
            for (int m = 0; m < 4; ++m)
#pragma unroll
                for (int bj = 0; bj < 2; ++bj) { f32x4* dst = (f32x4*)(base + (off0 + (unsigned)((ai * HALF + m * 16) * 2048 + bj * HALF)));
                    dst[0] = acc[ai][bj][m][0]; dst[1] = acc[ai][bj][m][1]; }
    }
};
template <class Epi, class Sched, bool ALIGN_EPI = false, bool SP2 = false, bool F8 = false>
__device__ __forceinline__ void gemm_phase(PG8_LAS unsigned char* lds, const Gemm g, const Sched& S, const Epi& E, const int tid) {
    const int wid = __builtin_amdgcn_readfirstlane(tid >> 6), lane = tid & 63, wr = wid >> 2, wc = wid & 3, fr = lane & 15, fq = lane >> 4;
    const int K = g.K; int nt = K / BK; if constexpr (Sched::SPLITK) nt = S.nt;
    unsigned voffA[2], voffB[2];
#pragma unroll
    for (int i = 0; i < 2; ++i) { int R, C; stage_rc(tid * 16 + i * 8192, R, C); const int Rb = Epi::PERM ? ((R & ~31) + perm32(R & 31)) : R;
        voffA[i] = (unsigned)(R * K + C) * 2u; voffB[i] = (unsigned)(Rb * K + C) * 2u; }
    const size_t kstep = (size_t)(BK * 2);
    const size_t hstep = (size_t)HALF * K * 2;
    const size_t tstep = 2 * hstep;
    const unsigned ldsw = (unsigned)wid * 1024u;
    const unsigned ldsb = (unsigned)__builtin_amdgcn_readfirstlane((int)((unsigned)(size_t)lds + ldsw));
    const int aoff = lds_byte(wr * 64 + fr, fq * 8), boff = lds_byte(wc * 32 + fr, fq * 8);
#define PG8_SA(b, h) (((b) * 2 + (h)) * HTB)
#define PG8_SB(b, h) ((4 + (b) * 2 + (h)) * HTB)
#define PG8_STAGE(bufoff, gbase, voff) do { _Pragma("unroll") for (int _i = 0; _i < 2; ++_i) { unsigned _keep; \
        asm volatile("s_mov_b32 %0, m0\n\ts_mov_b32 m0, %3\n\ts_nop 0\n\tglobal_load_lds_dwordx4 %1, %2\n\ts_mov_b32 m0, %0" : "=&s"(_keep) : "v"((voff)[_i]), "s"((const char*)(gbase)), "s"(ldsb + (unsigned)((bufoff) + _i * 8192)) : "memory"); } } while (0)
#define PG8_LDA(dst, b, h) do { _Pragma("unroll") for (int m = 0; m < 4; ++m) _Pragma("unroll") for (int k = 0; k < 2; ++k) dst[m][k] = *(const PG8_LAS bf16x8*)(lds + PG8_SA(b, h) + aoff + m * 2048 + k * 1024); } while (0)
#define PG8_LDB(dst, b, h) do { _Pragma("unroll") for (int n = 0; n < 2; ++n) _Pragma("unroll") for (int k = 0; k < 2; ++k) dst[n][k] = *(const PG8_LAS bf16x8*)(lds + PG8_SB(b, h) + boff + n * 2048 + k * 1024); } while (0)
#define PG8_CAT(x) __builtin_bit_cast(v8i32, __builtin_shufflevector(__builtin_bit_cast(i32x4, (x)[0]), __builtin_bit_cast(i32x4, (x)[1]), 0, 1, 2, 3, 4, 5, 6, 7))
#define PG8_MMA(ai, bj, At, Bt) do { __builtin_amdgcn_s_setprio(1); if constexpr (F8) asm volatile("s_nop 4" ::: "memory"); _Pragma("unroll") for (int m = 0; m < 4; ++m) _Pragma("unroll") for (int n = 0; n < 2; ++n) { \
        if constexpr (F8) { asm volatile("v_mfma_scale_f32_16x16x128_f8f6f4 %0, %1, %2, %0, %3, %3 op_sel_hi:[0,0,0]" : "+v"(acc[ai][bj][m][n]) : "v"(PG8_CAT(Bt[n])), "v"(PG8_CAT(At[m])), "v"(f8sc)); } \
        else { _Pragma("unroll") for (int k = 0; k < 2; ++k) acc[ai][bj][m][n] = __builtin_amdgcn_mfma_f32_16x16x32_bf16(Bt[n][k], At[m][k], acc[ai][bj][m][n], 0, 0, 0); } } __builtin_amdgcn_s_setprio(0); } while (0)
#define PG8_WAIT_V(n) asm volatile("s_waitcnt vmcnt(" #n ")" ::: "memory")
#define PG8_WAIT_L(n) asm volatile("s_waitcnt lgkmcnt(" #n ")" ::: "memory")
#define PG8_BAR __builtin_amdgcn_s_barrier()
#define PG8_SCHED __builtin_amdgcn_sched_barrier(0)
    const int f8sc = 0x7f7f7f7f;
    Unit cur, nxt; int ui = 0;
    if (!S.next(0, cur)) return;
    f32x4 acc[2][2][4][2];
#pragma unroll
    for (int a = 0; a < 2; ++a)
#pragma unroll
        for (int b = 0; b < 2; ++b)
#pragma unroll
            for (int m = 0; m < 4; ++m)
#pragma unroll
                for (int n = 0; n < 2; ++n) acc[a][b][m][n] = (f32x4){0.f, 0.f, 0.f, 0.f};
    bf16x8 At[4][2], B0[2][2], B1[2][2];
    const char* cA = (const char*)g.A + (size_t)cur.pm * tstep; const char* cB = (const char*)g.Bt + (size_t)cur.pn * tstep;
    if constexpr (Sched::SPLITK) { cA += cur.ko; cB += cur.ko; }
    S.a_ready(cur);
    if constexpr (SP2) {
        PG8_STAGE(PG8_SB(0, 0), cB, voffB); PG8_STAGE(PG8_SB(0, 1), cB + hstep, voffB); PG8_STAGE(PG8_SA(0, 0), cA, voffA); PG8_STAGE(PG8_SA(0, 1), cA + hstep, voffA);
        if (wr == 1) PG8_BAR;
        PG8_WAIT_V(2); PG8_BAR;
        PG8_STAGE(PG8_SB(1, 0), cB + kstep, voffB); PG8_STAGE(PG8_SA(1, 0), cA + kstep, voffA); PG8_STAGE(PG8_SB(1, 1), cB + hstep + kstep, voffB);
        PG8_WAIT_V(6); PG8_BAR;
    } else {
        PG8_STAGE(PG8_SB(0, 0), cB, voffB); PG8_STAGE(PG8_SA(0, 0), cA, voffA); PG8_STAGE(PG8_SB(0, 1), cB + hstep, voffB); PG8_STAGE(PG8_SA(0, 1), cA + hstep, voffA);
        if (wr == 1) PG8_BAR;
        PG8_WAIT_V(4); PG8_BAR;
        PG8_STAGE(PG8_SB(1, 0), cB + kstep, voffB); PG8_STAGE(PG8_SA(1, 0), cA + kstep, voffA); PG8_STAGE(PG8_SB(1, 1), cB + hstep + kstep, voffB);
        PG8_WAIT_V(6); PG8_BAR;
    }
    for (;;) {
        const bool has_next = S.next(ui + 1, nxt);
        const char* nA = has_next ? (const char*)g.A + (size_t)nxt.pm * tstep + (Sched::SPLITK ? nxt.ko : 0) : cA; const char* nB = has_next ? (const char*)g.Bt + (size_t)nxt.pn * tstep + (Sched::SPLITK ? nxt.ko : 0) : cB;
        for (int t = 0; t < nt; t += 2) {
            const bool last = (t == nt - 2);
            const char* a1 = cA + (size_t)(t + 1) * kstep;
            const char* a2 = last ? nA : cA + (size_t)(t + 2) * kstep; const char* b2 = last ? nB : cB + (size_t)(t + 2) * kstep;
            const char* a3 = a2 + kstep; const char* b3 = b2 + kstep;
            if (last && has_next) S.a_ready(nxt);
            if constexpr (SP2) {
            PG8_LDB(B0, 0, 0); PG8_LDB(B1, 0, 1); PG8_SCHED; PG8_LDA(At, 0, 0); PG8_STAGE(PG8_SA(1, 1), a1 + hstep, voffA);
            PG8_WAIT_V(8); PG8_WAIT_L(0); PG8_BAR; PG8_MMA(0, 0, At, B0); PG8_MMA(0, 1, At, B1); PG8_BAR; PG8_SCHED;
            PG8_LDA(At, 0, 1); PG8_STAGE(PG8_SB(0, 0), b2, voffB); PG8_STAGE(PG8_SB(0, 1), b2 + hstep, voffB); PG8_STAGE(PG8_SA(0, 0), a2, voffA);
            PG8_WAIT_V(8); PG8_WAIT_L(0); PG8_BAR; PG8_MMA(1, 0, At, B0); PG8_MMA(1, 1, At, B1); PG8_BAR; PG8_SCHED;
            PG8_LDB(B0, 1, 0); PG8_LDB(B1, 1, 1); PG8_SCHED; PG8_LDA(At, 1, 0); PG8_STAGE(PG8_SA(0, 1), a2 + hstep, voffA);
            PG8_WAIT_V(8); PG8_WAIT_L(0); PG8_BAR; PG8_MMA(0, 0, At, B0); PG8_MMA(0, 1, At, B1); PG8_BAR; PG8_SCHED;
            PG8_LDA(At, 1, 1); PG8_STAGE(PG8_SB(1, 0), b3, voffB); PG8_STAGE(PG8_SB(1, 1), b3 + hstep, voffB); PG8_STAGE(PG8_SA(1, 0), a3, voffA);
            PG8_WAIT_V(8); PG8_WAIT_L(0); PG8_BAR; PG8_MMA(1, 0, At, B0); PG8_MMA(1, 1, At, B1); PG8_BAR; PG8_SCHED;
            } else {
            PG8_LDB(B0, 0, 0); PG8_SCHED; PG8_LDA(At, 0, 0); PG8_STAGE(PG8_SA(1, 1), a1 + hstep, voffA);
            PG8_WAIT_L(8); PG8_BAR; PG8_WAIT_L(0); PG8_MMA(0, 0, At, B0); PG8_BAR; PG8_SCHED;
            PG8_LDB(B1, 0, 1); PG8_STAGE(PG8_SB(0, 0), b2, voffB);
            PG8_BAR; PG8_WAIT_L(0); PG8_MMA(0, 1, At, B1); PG8_BAR;
            PG8_LDA(At, 0, 1); PG8_STAGE(PG8_SA(0, 0), a2, voffA);
            PG8_BAR; PG8_WAIT_L(0); PG8_MMA(1, 0, At, B0); PG8_BAR; PG8_SCHED;
            PG8_STAGE(PG8_SB(0, 1), b2 + hstep, voffB);
            PG8_WAIT_V(6); PG8_BAR; PG8_MMA(1, 1, At, B1); PG8_BAR;
            PG8_LDB(B0, 1, 0); PG8_SCHED; PG8_LDA(At, 1, 0); PG8_STAGE(PG8_SA(0, 1), a2 + hstep, voffA);
            PG8_WAIT_L(8); PG8_BAR; PG8_WAIT_L(0); PG8_MMA(0, 0, At, B0); PG8_BAR; PG8_SCHED;
            PG8_LDB(B1, 1, 1); PG8_STAGE(PG8_SB(1, 0), b3, voffB);
            PG8_BAR; PG8_WAIT_L(0); PG8_MMA(0, 1, At, B1); PG8_BAR;
            PG8_LDA(At, 1, 1); PG8_STAGE(PG8_SA(1, 0), a3, voffA);
            PG8_BAR; PG8_WAIT_L(0); PG8_MMA(1, 0, At, B0); PG8_BAR; PG8_SCHED;
            PG8_STAGE(PG8_SB(1, 1), b3 + hstep, voffB);
            PG8_WAIT_V(6); PG8_BAR; PG8_MMA(1, 1, At, B1); PG8_BAR;
            }
        }
        if constexpr (ALIGN_EPI) { if (wr == 0) PG8_BAR; }
        if constexpr (F8) asm volatile("s_nop 15\n\ts_nop 15" ::: "memory");
        if constexpr (!Epi::AFTER_DRAIN) { E(acc, cur, wr, wc, fr, fq); S.done(cur); }
        if (!has_next) break;
#pragma unroll
        for (int a = 0; a < 2; ++a)
#pragma unroll
            for (int b = 0; b < 2; ++b)
#pragma unroll
                for (int m = 0; m < 4; ++m)
#pragma unroll
                    for (int n = 0; n < 2; ++n) acc[a][b][m][n] = (f32x4){0.f, 0.f, 0.f, 0.f};
        cur = nxt; cA = nA; cB = nB; ++ui;
        if constexpr (ALIGN_EPI) { if (wr == 1) PG8_BAR; }
    }
    PG8_WAIT_V(0);
    if constexpr (!ALIGN_EPI) { if (wr == 0) PG8_BAR; }
    PG8_BAR;
    if constexpr (Epi::AFTER_DRAIN) { E.fused(acc, cur, wr, wc, fr, fq, lds, wid, lane); S.done(cur); }
#undef PG8_SA
#undef PG8_SB
#undef PG8_STAGE
#undef PG8_LDA
#undef PG8_LDB
#undef PG8_MMA
#undef PG8_CAT
#undef PG8_WAIT_V
#undef PG8_WAIT_L
#undef PG8_BAR
#undef PG8_SCHED
}
}

#define GAS __attribute__((address_space(1)))
#define LAS __attribute__((address_space(3)))
typedef unsigned short bf16_t;
typedef short bf16x8 __attribute__((ext_vector_type(8)));
typedef short s16x4 __attribute__((ext_vector_type(4)));
typedef float f32x4 __attribute__((ext_vector_type(4)));
typedef float f32x16 __attribute__((ext_vector_type(16)));
typedef unsigned u32x4 __attribute__((ext_vector_type(4)));
typedef unsigned u32x2 __attribute__((ext_vector_type(2)));
#define LDS_WAIT() asm volatile("s_waitcnt lgkmcnt(0)" ::: "memory")
#define VM_WAIT() asm volatile("s_waitcnt vmcnt(0)" ::: "memory")
#define SBAR() __builtin_amdgcn_sched_barrier(0)

constexpr int BATCH = 4, SEQ = 4096, T = BATCH * SEQ, D = 2048, NH = 8, HD = 128, DH = NH * HD  , DQKV = 6144;
constexpr int DFF = 5504, DFFP = 5632  , DFE = 7168, NE = 8, MOE_ROWS = 2 * T + NE * 256;
#ifndef DENSE_F8
#define DENSE_F8 1
#endif
constexpr float EPS = 1e-6f;
constexpr int NWAVES = 8, NTHREADS = 512;
constexpr float LOG2E = 1.4426950408889634f, LN2 = 0.6931471805599453f;
constexpr float QSCALE = 0.08838834764831845f;
constexpr float F8_SH = 16.f, F8_SW = 512.f, F8_SACT = 8.f;

constexpr size_t MiB = 1u << 20;
constexpr size_t WS_CTL = 0, CTL_ZERO_BYTES = 1 * MiB;
constexpr size_t WS_BKT = 1 * MiB;
constexpr size_t WS_SEL = 2 * MiB;
constexpr size_t WS_GW = WS_SEL + 256 * 1024;
constexpr size_t WS_POS = WS_GW + 256 * 1024;
constexpr size_t WS_HIST = WS_POS + 256 * 1024;
constexpr size_t WS_MOEINFO = WS_HIST + 64 * 1024;
constexpr size_t WS_LSE = 3 * MiB;
constexpr size_t WS_WI = 8 * MiB;
constexpr size_t WS_WO = WS_WI + 2 * (size_t)DQKV * D * 2;
constexpr size_t WS_WGU_D = WS_WO + 2 * (size_t)D * D * 2;
constexpr size_t WS_WD_D = WS_WGU_D + (size_t)2 * DFF * D * 2;
constexpr size_t WS_WGU_M = WS_WD_D + (size_t)D * DFF * 2 + 512 * 1024;
constexpr size_t WS_WD_M = WS_WGU_M + (size_t)NE * 2 * DFE * D;
constexpr size_t WS_X = WS_WD_M + (size_t)NE * D * DFE;
constexpr size_t WS_H = WS_X + (size_t)T * D * 4;
constexpr size_t WS_R = WS_H + (size_t)T * D * 2;
constexpr size_t WS_QKV = WS_R;
constexpr size_t WS_OD = WS_QKV + (size_t)6 * T * DH * 2;
constexpr size_t WS_OS = WS_OD + (size_t)3 * T * DH * 2;
constexpr size_t WS_O = WS_OS + (size_t)T * DH * 2;
constexpr size_t WS_ACT = WS_R;
constexpr size_t WS_AS = WS_R + (size_t)MOE_ROWS * D * 2;
constexpr size_t WS_ACTM = WS_AS + (size_t)MOE_ROWS * D;
constexpr size_t WS_Y = WS_R;
constexpr int TAIL_T0 = 128, TAIL_MAXT = 7, TAIL_SL = 7, TAIL_NT = 8;
constexpr size_t WS_YP = WS_ACTM + (size_t)MOE_ROWS * DFE;
constexpr size_t WS_PART = WS_YP + (size_t)TAIL_SL * TAIL_MAXT * 256 * D * 4;
constexpr size_t WS_END_MOE = WS_PART + (size_t)T * 32 * 4, WS_END_ATT = WS_O + (size_t)T * D * 2, WS_END = WS_END_MOE > WS_END_ATT ? WS_END_MOE : WS_END_ATT;
static_assert(WS_ACT + (size_t)T * DFF * 2 <= WS_END, "region R");
static_assert(WS_END <= 1879048192ull, "workspace");
static_assert(TAIL_SL * TAIL_NT * 128 == DFE && WS_YP % 256 == 0, "split-K tail");
static_assert(WS_WI % 256 == 0 && WS_WO % 256 == 0 && WS_WGU_D % 256 == 0 && WS_WD_D % 256 == 0 && WS_WGU_M % 256 == 0 && WS_WD_M % 256 == 0 && WS_X % 256 == 0 && WS_H % 256 == 0 && WS_R % 256 == 0 && WS_ACTM % 256 == 0, "alignment");
constexpr int CW_AQ = 20480;
constexpr int CW_TAIL = 16384;
constexpr int CW_BAR = 4096;

constexpr int WSCR = 16896;
constexpr int SCR_BYTES = 8 * WSCR;
constexpr int TBL_OFF = SCR_BYTES, TBL_N = 200, TBL_BYTES = 3 * NH * TBL_N * 4;
constexpr int MISC_OFF = 154624;
constexpr int LDS_BYTES = 157696;
static_assert(TBL_OFF + TBL_BYTES <= MISC_OFF && MISC_OFF + 3072 <= LDS_BYTES, "LDS map");

#define XB_TMO      128
#define XB_XCNT(j)  (256  + 64 * (j))
#define XB_XSUB(j)  (1280 + 64 * (j))
#define XB_XGEN(j)  (2304 + 64 * (j))
#define XB_TOP      3328
#define XB_TOPGEN   3392
#define XCD_BAR_WORDS 3456
#define XB_SPIN_CAP (1u << 20)
__device__ __forceinline__ unsigned xb_ld(unsigned* p)              { return __hip_atomic_load(p, __ATOMIC_RELAXED, __HIP_MEMORY_SCOPE_AGENT); }
__device__ __forceinline__ unsigned xb_add(unsigned* p, unsigned v) { return __hip_atomic_fetch_add(p, v, __ATOMIC_RELAXED, __HIP_MEMORY_SCOPE_AGENT); }
__device__ __forceinline__ unsigned xb_xcc_id() { return (unsigned)__builtin_amdgcn_s_getreg((3 << 11) | 20) & 0xFu; }
#define XB_SPIN(cond, bar) do { unsigned _sp = 0; while (cond) { __builtin_amdgcn_s_sleep(1); \
    if ((++_sp & 255u) == 0u) { if (xb_ld(&(bar)[XB_TMO])) break; if (_sp > XB_SPIN_CAP) { atomicAdd(&(bar)[XB_TMO], 1u); break; } } } } while (0)
struct XcdBarrier { unsigned* bar; unsigned x; volatile LAS unsigned* st; };
__device__ __forceinline__ XcdBarrier xcd_barrier_post(unsigned* bar, volatile LAS unsigned* st) {
    XcdBarrier b; b.bar = bar; b.x = xb_xcc_id(); b.st = st;
    if (threadIdx.x == 0) (void)xb_add(&bar[XB_XCNT(b.x)], 1u);
    return b;
}
__device__ __forceinline__ void xcd_barrier_complete(unsigned* bar, unsigned x, unsigned& nloc, unsigned& nx) {
    const unsigned G = gridDim.x * gridDim.y * gridDim.z;
    unsigned sum, cnt, mine, sp = 0u;
    for (;;) {
        sum = 0u; cnt = 0u; mine = 0u;
#pragma unroll
        for (unsigned j = 0; j < 16; ++j) { const unsigned c = xb_ld(&bar[XB_XCNT(j)]); sum += c; cnt += (c > 0u) ? 1u : 0u; mine = (j == x) ? c : mine; }
        if (sum == G) break;
        __builtin_amdgcn_s_sleep(1);
        if ((++sp & 255u) == 0u) { if (xb_ld(&bar[XB_TMO])) break; if (sp > XB_SPIN_CAP) { atomicAdd(&bar[XB_TMO], 1u); break; } }
    }
    nloc = mine > 0u ? mine : 1u; nx = cnt > 0u ? cnt : 1u;
}
__device__ __forceinline__ void xcd_barrier(const XcdBarrier& b) {
    asm volatile("s_waitcnt vmcnt(0)" ::: "memory");
    __syncthreads();
    if (threadIdx.x == 0) {
        unsigned* bar = b.bar;
        __builtin_amdgcn_s_waitcnt(0);
        unsigned nloc = b.st[0], nx = b.st[1];
        if (nloc == 0u) { xcd_barrier_complete(bar, b.x, nloc, nx); b.st[0] = nloc; b.st[1] = nx; }
        const unsigned old = xb_add(&bar[XB_XSUB(b.x)], 1u);
        const unsigned gen = old / nloc;
        if (old + 1u == (gen + 1u) * nloc) {
            __builtin_amdgcn_fence(__ATOMIC_RELEASE, "agent");
            asm volatile("s_waitcnt vmcnt(0)" ::: "memory");
            const unsigned og = xb_add(&bar[XB_TOP], 1u);
            const unsigned tg = og / nx;
            if (og + 1u == (tg + 1u) * nx) xb_add(&bar[XB_TOPGEN], 1u);
            else XB_SPIN(xb_ld(&bar[XB_TOPGEN]) == tg, bar);
            __builtin_amdgcn_fence(__ATOMIC_ACQUIRE, "agent");
            xb_add(&bar[XB_XGEN(b.x)], 1u);
            asm volatile("s_waitcnt vmcnt(0)" ::: "memory");
        } else {
            XB_SPIN(xb_ld(&bar[XB_XGEN(b.x)]) == gen, bar);
            __builtin_amdgcn_fence(__ATOMIC_ACQUIRE, "agent");
            asm volatile("s_waitcnt vmcnt(0)" ::: "memory");
        }
#if defined(PHTIME)
        if (blockIdx.x == 0) { const unsigned s_ = b.st[2]; b.st[2] = s_ + 1u; bar[(12290 - CW_BAR) + s_] = (unsigned)__builtin_amdgcn_s_memrealtime(); }
#endif
    }
    __syncthreads();
}

__device__ __forceinline__ unsigned pk2(float lo, float hi) { unsigned r; asm volatile("v_cvt_pk_bf16_f32 %0, %1, %2" : "=v"(r) : "v"(lo), "v"(hi)); return r; }
__device__ __forceinline__ float bf_lo(unsigned w) { return __builtin_bit_cast(float, w << 16); }
__device__ __forceinline__ float bf_hi(unsigned w) { return __builtin_bit_cast(float, w & 0xffff0000u); }
__device__ __forceinline__ float wave_sum(float v) {
#pragma unroll
    for (int o = 1; o < 64; o <<= 1) v += __shfl_xor(v, o);
    return v;
}
__device__ __forceinline__ float dot4(f32x4 a) { return (a.x * a.x + a.y * a.y) + (a.z * a.z + a.w * a.w); }

struct Frame {
    LAS unsigned char* lds; volatile LAS unsigned* MISC;
    int tid, lane, wave, gw, G;
};

__device__ __forceinline__ void tr_item(const float* __restrict__ W, int K, int N, bf16_t* __restrict__ WT, int mode, LAS float* scr, int item, int lane) {
    const int nblk = N >> 6, kb = item / nblk, nb = item - kb * nblk, k0 = kb << 6, n0 = nb << 6;
    f32x4 v[16];
    const float* src = W + (size_t)(k0 + (lane >> 4)) * N + n0 + 4 * (lane & 15);
#pragma unroll
    for (int i = 0; i < 16; ++i) v[i] = __builtin_nontemporal_load((const f32x4*)(src + (size_t)(4 * i) * N));
#pragma unroll
    for (int i = 0; i < 16; ++i) { LAS float* d = scr + (4 * i + (lane >> 4)) * 65 + 4 * (lane & 15); d[0] = v[i][0]; d[1] = v[i][1]; d[2] = v[i][2]; d[3] = v[i][3]; }
    LDS_WAIT();
    const int c = lane & 7;
#pragma unroll
    for (int p = 0; p < 8; ++p) { const int n = (lane >> 3) + 8 * p; const LAS float* s = scr + (8 * c) * 65 + n;
        u32x4 o; o.x = pk2(s[0], s[65]); o.y = pk2(s[130], s[195]); o.z = pk2(s[260], s[325]); o.w = pk2(s[390], s[455]);
        const int nn = n0 + n; const int row = mode == 0 ? nn : (((nn >> 7) << 8) + (nn & 127) + (mode == 2 ? 128 : 0));
        *(u32x4*)(WT + (size_t)row * K + k0 + 8 * c) = o; }
    LDS_WAIT();
}
__device__ __forceinline__ void tr_item8(const float* __restrict__ W, int K, int N, unsigned char* __restrict__ WT, int ldk, int mode, LAS float* scr, int item, int lane) {
    const int nblk = N >> 6, kb = item / nblk, nb = item - kb * nblk, k0 = kb << 6, n0 = nb << 6;
    f32x4 v[16];
    const float* src = W + (size_t)(k0 + (lane >> 4)) * N + n0 + 4 * (lane & 15);
#pragma unroll
    for (int i = 0; i < 16; ++i) v[i] = __builtin_nontemporal_load((const f32x4*)(src + (size_t)(4 * i) * N));
#pragma unroll
    for (int i = 0; i < 16; ++i) { LAS float* d = scr + (4 * i + (lane >> 4)) * 65 + 4 * (lane & 15); d[0] = v[i][0]; d[1] = v[i][1]; d[2] = v[i][2]; d[3] = v[i][3]; }
    LDS_WAIT();
    const int c = lane & 7;
#pragma unroll
    for (int p = 0; p < 8; ++p) { const int n = (lane >> 3) + 8 * p; const LAS float* s = scr + (8 * c) * 65 + n;
        u32x2 o; o.x = pg8::pk4_fp8(s[0] * F8_SW, s[65] * F8_SW, s[130] * F8_SW, s[195] * F8_SW); o.y = pg8::pk4_fp8(s[260] * F8_SW, s[325] * F8_SW, s[390] * F8_SW, s[455] * F8_SW);
        const int nn = n0 + n; const int row = mode == 0 ? nn : (((nn >> 7) << 8) + (nn & 127) + (mode == 2 ? 128 : 0));
        *(u32x2*)(WT + (size_t)row * ldk + k0 + 8 * c) = o; }
    LDS_WAIT();
}

struct ConvDesc { const float* W; unsigned char* WT; int K, N, mode, f8, item, ldk; };
__device__ __forceinline__ void tr_load(const ConvDesc& d, f32x4 (&v)[16], int lane) {
    if (d.f8) {
        const int nblk = d.N >> 5, kb = d.item / nblk, nb = d.item - kb * nblk, k0 = kb << 7, n0 = nb << 5;
        const unsigned voff = (unsigned)(((lane >> 3) * d.N + 4 * (lane & 7)) * 4);
        const char* ub = (const char*)(d.W + (size_t)k0 * d.N + n0);
#pragma unroll
        for (int i = 0; i < 16; ++i) v[i] = __builtin_nontemporal_load((const f32x4*)(ub + (size_t)(8 * i) * d.N * 4 + voff));
    } else {
        const int nblk = d.N >> 6, kb = d.item / nblk, nb = d.item - kb * nblk, k0 = kb << 6, n0 = nb << 6;
        const unsigned voff = (unsigned)(((lane >> 4) * d.N + 4 * (lane & 15)) * 4);
        const char* ub = (const char*)(d.W + (size_t)k0 * d.N + n0);
#pragma unroll
        for (int i = 0; i < 16; ++i) v[i] = __builtin_nontemporal_load((const f32x4*)(ub + (size_t)(4 * i) * d.N * 4 + voff));
    }
}
__device__ __forceinline__ void tr_finish(const ConvDesc& d, const f32x4 (&v)[16], LAS float* scr, int lane) {
    if (d.f8) {
        const int nblk = d.N >> 5, kb = d.item / nblk, nb = d.item - kb * nblk, k0 = kb << 7, n0 = nb << 5;
#pragma unroll
        for (int i = 0; i < 16; ++i) { LAS float* q = scr + (8 * i + (lane >> 3)) * 33 + 4 * (lane & 7); q[0] = v[i][0]; q[1] = v[i][1]; q[2] = v[i][2]; q[3] = v[i][3]; }
        LDS_WAIT();
        const int c = lane & 7;
#pragma unroll
        for (int p = 0; p < 4; ++p) { const int n = (lane >> 3) + 8 * p; const LAS float* s = scr + (16 * c) * 33 + n;
            const int nn = n0 + n; const int row = d.mode == 0 ? nn : (((nn >> 7) << 8) + (nn & 127) + (d.mode == 2 ? 128 : 0));
            u32x4 o; o.x = pg8::pk4_fp8(s[0] * F8_SW, s[33] * F8_SW, s[66] * F8_SW, s[99] * F8_SW); o.y = pg8::pk4_fp8(s[132] * F8_SW, s[165] * F8_SW, s[198] * F8_SW, s[231] * F8_SW);
            o.z = pg8::pk4_fp8(s[264] * F8_SW, s[297] * F8_SW, s[330] * F8_SW, s[363] * F8_SW); o.w = pg8::pk4_fp8(s[396] * F8_SW, s[429] * F8_SW, s[462] * F8_SW, s[495] * F8_SW);
            __builtin_nontemporal_store(o, (u32x4*)(d.WT + (size_t)row * d.ldk + k0 + 16 * c)); }
        LDS_WAIT();
    } else {
        const int nblk = d.N >> 6, kb = d.item / nblk, nb = d.item - kb * nblk, k0 = kb << 6, n0 = nb << 6;
#pragma unroll
        for (int i = 0; i < 16; ++i) { LAS float* q = scr + (4 * i + (lane >> 4)) * 65 + 4 * (lane & 15); q[0] = v[i][0]; q[1] = v[i][1]; q[2] = v[i][2]; q[3] = v[i][3]; }
        LDS_WAIT();
        const int c = lane & 7;
#pragma unroll
        for (int p = 0; p < 8; ++p) { const int n = (lane >> 3) + 8 * p; const LAS float* s = scr + (8 * c) * 65 + n;
            const int nn = n0 + n; const int row = d.mode == 0 ? nn : (((nn >> 7) << 8) + (nn & 127) + (d.mode == 2 ? 128 : 0));
            u32x4 o; o.x = pk2(s[0], s[65]); o.y = pk2(s[130], s[195]); o.z = pk2(s[260], s[325]); o.w = pk2(s[390], s[455]);
            __builtin_nontemporal_store(o, (u32x4*)(d.WT + ((size_t)row * d.ldk + k0 + 8 * c) * 2)); }
        LDS_WAIT();
    }
}
__device__ __forceinline__ void rms_row_bf16(const float* xrow, const float* g, bf16_t* orow, int lane) {
    const f32x4* xr = (const f32x4*)xrow + lane; const f32x4* gr = (const f32x4*)g + lane;
    f32x4 v[8]; float ss = 0.f;
#pragma unroll
    for (int j = 0; j < 8; ++j) { v[j] = xr[64 * j]; ss += dot4(v[j]); }
    const float rstd = 1.0f / sqrtf(wave_sum(ss) * (1.0f / D) + EPS);
    u32x2* o8 = (u32x2*)orow + lane;
#pragma unroll
    for (int j = 0; j < 8; ++j) { const f32x4 gg = gr[64 * j]; u32x2 w; w.x = pk2(v[j].x * rstd * gg.x, v[j].y * rstd * gg.y); w.y = pk2(v[j].z * rstd * gg.z, v[j].w * rstd * gg.w); o8[64 * j] = w; }
}
__device__ __forceinline__ f32x4 ldxb(const bf16_t* xrow, int lane, int j) { const u32x2 w = ((const u32x2*)xrow)[lane + 64 * j]; return (f32x4){bf_lo(w.x), bf_hi(w.x), bf_lo(w.y), bf_hi(w.y)}; }
__device__ __forceinline__ void rms_row_b2b(const bf16_t* xrow, const float* g, bf16_t* orow, int lane) {
    const f32x4* gr = (const f32x4*)g + lane;
    f32x4 v[8]; float ss = 0.f;
#pragma unroll
    for (int j = 0; j < 8; ++j) { v[j] = ldxb(xrow, lane, j); ss += dot4(v[j]); }
    const float rstd = 1.0f / sqrtf(wave_sum(ss) * (1.0f / D) + EPS);
    u32x2* o8 = (u32x2*)orow + lane;
#pragma unroll
    for (int j = 0; j < 8; ++j) { const f32x4 gg = gr[64 * j]; u32x2 w; w.x = pk2(v[j].x * rstd * gg.x, v[j].y * rstd * gg.y); w.y = pk2(v[j].z * rstd * gg.z, v[j].w * rstd * gg.w); o8[64 * j] = w; }
}
__device__ __forceinline__ void rms_rows_b2b(const bf16_t* X, const float* g, bf16_t* H, int gw, int ngw, int lane) {
    f32x4 gq[8];
#pragma unroll
    for (int q = 0; q < 8; ++q) gq[q] = ((const f32x4*)g)[lane + 64 * q];
    for (int m0 = gw; m0 < T; m0 += 4 * ngw) {
        u32x2 raw[4][8];
#pragma unroll
        for (int r = 0; r < 4; ++r)
#pragma unroll
            for (int q = 0; q < 8; ++q) raw[r][q] = ((const u32x2*)(X + (size_t)(m0 + r * ngw) * D))[lane + 64 * q];
#pragma unroll
        for (int r = 0; r < 4; ++r) {
            f32x4 v[8]; float ss = 0.f;
#pragma unroll
            for (int q = 0; q < 8; ++q) { v[q] = (f32x4){bf_lo(raw[r][q].x), bf_hi(raw[r][q].x), bf_lo(raw[r][q].y), bf_hi(raw[r][q].y)}; ss += dot4(v[q]); }
            const float rstd = 1.0f / sqrtf(wave_sum(ss) * (1.0f / D) + EPS);
            u32x2* o8 = (u32x2*)(H + (size_t)(m0 + r * ngw) * D) + lane;
#pragma unroll
            for (int q = 0; q < 8; ++q) { u32x2 w; w.x = pk2(v[q].x * rstd * gq[q].x, v[q].y * rstd * gq[q].y); w.y = pk2(v[q].z * rstd * gq[q].z, v[q].w * rstd * gq[q].w); o8[64 * q] = w; }
        }
    }
}
__device__ __forceinline__ void rms_rows_f2b(const float* X, const float* g, bf16_t* H, int gw, int ngw, int lane) {
    f32x4 gq[8];
#pragma unroll
    for (int q = 0; q < 8; ++q) gq[q] = ((const f32x4*)g)[lane + 64 * q];
    for (int m0 = gw; m0 < T; m0 += 4 * ngw) {
        f32x4 v[4][8];
#pragma unroll
        for (int r = 0; r < 4; ++r)
#pragma unroll
            for (int q = 0; q < 8; ++q) v[r][q] = ((const f32x4*)(X + (size_t)(m0 + r * ngw) * D))[lane + 64 * q];
#pragma unroll
        for (int r = 0; r < 4; ++r) {
            float ss = 0.f;
#pragma unroll
            for (int q = 0; q < 8; ++q) ss += dot4(v[r][q]);
            const float rstd = 1.0f / sqrtf(wave_sum(ss) * (1.0f / D) + EPS);
            u32x2* o8 = (u32x2*)(H + (size_t)(m0 + r * ngw) * D) + lane;
#pragma unroll
            for (int q = 0; q < 8; ++q) { u32x2 w; w.x = pk2(v[r][q].x * rstd * gq[q].x, v[r][q].y * rstd * gq[q].y); w.y = pk2(v[r][q].z * rstd * gq[q].z, v[r][q].w * rstd * gq[q].w); o8[64 * q] = w; }
        }
    }
}
__device__ __forceinline__ int t5_bucket(int n) {
    if (n < 16) return n;
    int b = 16 + (int)(log((double)n / 16.0) / log(128.0) * 16.0);
    return b < 31 ? b : 31;
}

__device__ __forceinline__ void dma_tile_k(const bf16_t* base, size_t row_stride_bytes, LAS unsigned char* dst, const unsigned (&voff)[4]) {
#pragma unroll
    for (int i = 0; i < 8; ++i) {
        const char* ub = (const char*)base + (size_t)(4 * i) * row_stride_bytes;
        __builtin_amdgcn_global_load_lds((const unsigned*)(ub + voff[i & 3]), (LAS unsigned*)(dst + i * 1024), 16, 0, 0);
    }
}
__device__ __forceinline__ void dma_tile_v(const bf16_t* base, size_t row_stride_bytes, LAS unsigned char* dst, unsigned voff) {
#pragma unroll
    for (int i = 0; i < 8; ++i) {
        const char* ub = (const char*)base + (size_t)(4 * i) * row_stride_bytes;
        __builtin_amdgcn_global_load_lds((const unsigned*)(ub + voff), (LAS unsigned*)(dst + i * 1024), 16, 0, 0);
    }
}
#define TRRD(dst, addr, off) asm volatile("ds_read_b64_tr_b16 %0, %1 offset:%2" : "=&v"(dst) : "v"(addr), "i"(off) : "memory")

template <int MODE>
__device__ __forceinline__ void attn_item(LAS unsigned char* wl, const bf16_t* Qh, int qstride, const bf16_t* Kh, const bf16_t* Vh, bf16_t* Op, int ostride, float* lsep, int lstride,
                                          const LAS float* tb, int qg, int lane) {
    const int c = lane & 31, hi = lane >> 5;
    const int i0 = 32 * qg;
    const size_t rstride = (size_t)qstride;
    bf16x8 qf[8];
    { const bf16_t* qrow = Qh + (size_t)(i0 + c) * qstride + 8 * hi;
#pragma unroll
      for (int s = 0; s < 8; ++s) qf[s] = *(const bf16x8*)(qrow + 16 * s); }
    f32x16 o[4];
#pragma unroll
    for (int b = 0; b < 4; ++b)
#pragma unroll
        for (int r = 0; r < 16; ++r) o[b][r] = 0.f;
    float mx = -1e30f, lsum = 0.f, carry = 0.f;
    const int kt_first = MODE == 0 ? (qg > 4 ? qg - 4 : 0) : qg, kt_last = MODE == 0 ? qg : 0, kstep = MODE == 0 ? 1 : -1;
    LAS unsigned char* Kl = wl; LAS unsigned char* Vl = wl + 8192;
    const LAS unsigned char* kbase = Kl + c * 256;
    unsigned vb[4];
    { const int g = lane >> 4, q = (lane & 15) >> 2, p = lane & 3, h = g >> 1;
#pragma unroll
      for (int b = 0; b < 4; ++b) vb[b] = (unsigned)(uintptr_t)Vl + (4 * h + q) * 256 + (((4 * b + 2 * (g & 1) + (p >> 1)) ^ (q << 2)) << 4) + 8 * (p & 1); }
    unsigned voffk[4], voffv;
    { const int rr = lane >> 4, p = lane & 15;
#pragma unroll
      for (int i = 0; i < 4; ++i) voffk[i] = (unsigned)(rr * (int)rstride * 2 + ((p ^ ((4 * i + rr) & 15)) << 4));
      voffv = (unsigned)(rr * (int)rstride * 2 + ((p ^ (rr << 2)) << 4)); }
    dma_tile_k(Kh + (size_t)(32 * kt_first) * rstride, rstride * 2, Kl, voffk);
    dma_tile_v(Vh + (size_t)(32 * kt_first) * rstride, rstride * 2, Vl, voffv);
    bool early = false;
    for (int kt = kt_first;; kt += kstep) {
        const bool has_next = (kt != kt_last);
        const int j0 = 32 * kt;
        asm volatile("s_waitcnt vmcnt(8)" ::: "memory");
        f32x16 S;
#pragma unroll
        for (int r = 0; r < 16; ++r) S[r] = 0.f;
#pragma unroll
        for (int s = 0; s < 8; ++s) {
            const bf16x8 kf = *(const LAS bf16x8*)(kbase + ((((2 * s + hi) ^ (c & 15))) << 4));
            S = __builtin_amdgcn_mfma_f32_32x32x16_bf16(kf, qf[s], S, 0, 0, 0);
        }
        asm volatile("" ::: "memory");
        if (has_next) dma_tile_k(Kh + (size_t)(j0 + 32 * kstep) * rstride, rstride * 2, Kl, voffk);
        bf16x8 pb[2];
        if constexpr (MODE == 0) {
            const int a = 160 - (i0 - j0) - c + 4 * hi;
            const LAS float* tp = tb + a;
            float x[16]; float pm = -3e38f;
#pragma unroll
            for (int r = 0; r < 16; ++r) { x[r] = fmaf(S[r], QSCALE * LOG2E, tp[8 * (r >> 2) + (r & 3)]); pm = fmaxf(pm, x[r]); }
            { auto rr = __builtin_amdgcn_permlane32_swap(__float_as_uint(pm), __float_as_uint(pm), false, false); pm = fmaxf(__uint_as_float(rr[0]), __uint_as_float(rr[1])); }
            const float mn = fmaxf(mx, pm); const float alpha = __builtin_amdgcn_exp2f(mx - mn); mx = mn;
            float ps = 0.f;
#pragma unroll
            for (int r = 0; r < 16; ++r) { x[r] = __builtin_amdgcn_exp2f(x[r] - mn); ps += x[r]; }
            { auto rr = __builtin_amdgcn_permlane32_swap(__float_as_uint(ps), __float_as_uint(ps), false, false); ps = __uint_as_float(rr[0]) + __uint_as_float(rr[1]); }
            lsum = lsum * alpha + ps;
            if (__any(alpha < 1.f)) {
#pragma unroll
                for (int b = 0; b < 4; ++b)
#pragma unroll
                    for (int r = 0; r < 16; ++r) o[b][r] *= alpha;
            }
#pragma unroll
            for (int s = 0; s < 2; ++s) { u32x4 w; w.x = pk2(x[8 * s], x[8 * s + 1]); w.y = pk2(x[8 * s + 2], x[8 * s + 3]); w.z = pk2(x[8 * s + 4], x[8 * s + 5]); w.w = pk2(x[8 * s + 6], x[8 * s + 7]); pb[s] = __builtin_bit_cast(bf16x8, w); }
        } else {
            const bool diag = (j0 == i0);
            float lk[16], ls[16];
#pragma unroll
            for (int r = 0; r < 16; ++r) {
                const float z = S[r] * QSCALE; const float az = fabsf(z);
                const float sp = fmaxf(z, 0.f) + LN2 * __builtin_amdgcn_logf(1.0f + __builtin_amdgcn_exp2f(-az * LOG2E));
                const int key = 8 * (r >> 2) + 4 * hi + (r & 3);
                const bool valid = !diag || key < c;
                lk[r] = valid ? -sp : 0.f; ls[r] = valid ? (z - sp) : -1e30f;
            }
            float gs[4];
#pragma unroll
            for (int g = 0; g < 4; ++g) gs[g] = (lk[4 * g] + lk[4 * g + 1]) + (lk[4 * g + 2] + lk[4 * g + 3]);
            float pg[4];
#pragma unroll
            for (int g = 0; g < 4; ++g) { auto rr = __builtin_amdgcn_permlane32_swap(__float_as_uint(gs[g]), __float_as_uint(gs[g]), false, false); pg[g] = hi ? __uint_as_float(rr[0]) : __uint_as_float(rr[1]); }
            float suf[4]; float run = carry;
#pragma unroll
            for (int g = 3; g >= 0; --g) { if (hi == 0) { suf[g] = run + pg[g]; run = suf[g] + gs[g]; } else { suf[g] = run; run = run + gs[g] + pg[g]; } }
            float av[16];
#pragma unroll
            for (int g = 0; g < 4; ++g) { float lt = suf[g];
#pragma unroll
                for (int e = 3; e >= 0; --e) { av[4 * g + e] = __builtin_amdgcn_exp2f((ls[4 * g + e] + lt) * LOG2E); lt += lk[4 * g + e]; } }
            carry = run;
            early = __all(carry < -105.f);
#pragma unroll
            for (int s = 0; s < 2; ++s) { u32x4 w; w.x = pk2(av[8 * s], av[8 * s + 1]); w.y = pk2(av[8 * s + 2], av[8 * s + 3]); w.z = pk2(av[8 * s + 4], av[8 * s + 5]); w.w = pk2(av[8 * s + 6], av[8 * s + 7]); pb[s] = __builtin_bit_cast(bf16x8, w); }
        }
        if (has_next) asm volatile("s_waitcnt vmcnt(8)" ::: "memory"); else asm volatile("s_waitcnt vmcnt(0)" ::: "memory");
#pragma unroll
        for (int b = 0; b < 4; ++b) {
            s16x4 l0, h0, l1, h1;
            TRRD(l0, vb[b], 0); TRRD(h0, vb[b], 2048); TRRD(l1, vb[b], 4096); TRRD(h1, vb[b], 6144);
            asm volatile("s_waitcnt lgkmcnt(0)" ::: "memory"); SBAR();
            o[b] = __builtin_amdgcn_mfma_f32_32x32x16_bf16((bf16x8){l0[0], l0[1], l0[2], l0[3], h0[0], h0[1], h0[2], h0[3]}, pb[0], o[b], 0, 0, 0);
            o[b] = __builtin_amdgcn_mfma_f32_32x32x16_bf16((bf16x8){l1[0], l1[1], l1[2], l1[3], h1[0], h1[1], h1[2], h1[3]}, pb[1], o[b], 0, 0, 0);
        }
        asm volatile("" ::: "memory");
        if (!has_next || (MODE == 1 && early)) break;
        dma_tile_v(Vh + (size_t)(j0 + 32 * kstep) * rstride, rstride * 2, Vl, voffv);
    }
    if (MODE == 1) VM_WAIT();
    const float inv = MODE == 0 ? __builtin_amdgcn_rcpf(lsum) : 1.0f;
    bf16_t* orow = Op + (size_t)(i0 + c) * ostride + 4 * hi;
#pragma unroll
    for (int b = 0; b < 4; ++b)
#pragma unroll
        for (int g = 0; g < 4; ++g) { u32x2 w; w.x = pk2(o[b][4 * g] * inv, o[b][4 * g + 1] * inv); w.y = pk2(o[b][4 * g + 2] * inv, o[b][4 * g + 3] * inv); *(u32x2*)(orow + 32 * b + 8 * g) = w; }
    if (MODE == 0 && hi == 0) lsep[(size_t)(i0 + c) * lstride] = (mx + __builtin_amdgcn_logf(lsum)) * LN2;
}

struct Params { const float* in[16]; float* out; unsigned char* ws; int ph_lo, ph_hi; };
enum { IN_X = 0, IN_RELB, IN_ANG, IN_WIN, IN_GDIL, IN_GSB, IN_WO, IN_FNG, IN_DWG, IN_DWU, IN_DWD, IN_RW, IN_MWG, IN_MWU, IN_MWD, IN_FING };
constexpr int N_PHASES = 18;

typedef const __attribute__((address_space(4))) Params* KPtr;
__device__ __forceinline__ KPtr kparams() { KPtr p = (KPtr)__builtin_amdgcn_kernarg_segment_ptr(); asm volatile("" : "+s"(p)); return p; }
#define WSP(T, off) ((T)(ws + (off)))
__device__ __forceinline__ Frame make_frame() {
    Frame F; int t = threadIdx.x; asm volatile("" : "+v"(t));
    extern __shared__ __attribute__((aligned(16))) unsigned char lds_raw[];
    F.lds = (LAS unsigned char*)lds_raw; F.MISC = (volatile LAS unsigned*)(F.lds + MISC_OFF);
    F.tid = t; F.lane = t & 63; F.wave = __builtin_amdgcn_readfirstlane(t >> 6); F.G = gridDim.x; F.gw = blockIdx.x * NWAVES + F.wave;
    return F;
}
#define PHASE_ARGS() KPtr kp = kparams(); unsigned char* const ws = kp->ws; (void)ws; const Frame F = make_frame(); const int NGW = F.G * NWAVES; (void)NGW


constexpr int I_WI = (D / 64) * (DQKV / 64), I_WO = (D / 64) * (D / 64), I_DG = (D / 64) * (DFF / 64), I_DD = (DFF / 64) * (D / 64), I_MG = (D / 64) * (DFE / 64), I_MD = (DFE / 64) * (D / 64);
constexpr int CONV_A = I_WI + I_WO + 2 * I_DG + I_DD;
constexpr int CONV_B = I_WI + I_WO + NE * (2 * I_MG + I_MD);
static_assert(CONV_B % 2 == 0, "deferred conversion split");
__device__ __forceinline__ void conv_item(KPtr kp, unsigned char* ws, int it, LAS float* scr, int lane) {
    int r = it;
    if (r < CONV_A) {
        if (r < I_WI) { tr_item(kp->in[IN_WIN], D, DQKV, WSP(bf16_t*, WS_WI), 0, scr, r, lane); return; } r -= I_WI;
        if (r < I_WO) { tr_item(kp->in[IN_WO], D, D, WSP(bf16_t*, WS_WO), 0, scr, r, lane); return; } r -= I_WO;
#if DENSE_F8
        if (r < I_DG) { tr_item8(kp->in[IN_DWG], D, DFF, WSP(unsigned char*, WS_WGU_D), D, 1, scr, r, lane); return; } r -= I_DG;
        if (r < I_DG) { tr_item8(kp->in[IN_DWU], D, DFF, WSP(unsigned char*, WS_WGU_D), D, 2, scr, r, lane); return; } r -= I_DG;
        tr_item8(kp->in[IN_DWD], DFF, D, WSP(unsigned char*, WS_WD_D), DFFP, 0, scr, r, lane); return;
#else
        if (r < I_DG) { tr_item(kp->in[IN_DWG], D, DFF, WSP(bf16_t*, WS_WGU_D), 1, scr, r, lane); return; } r -= I_DG;
        if (r < I_DG) { tr_item(kp->in[IN_DWU], D, DFF, WSP(bf16_t*, WS_WGU_D), 2, scr, r, lane); return; } r -= I_DG;
        tr_item(kp->in[IN_DWD], DFF, D, WSP(bf16_t*, WS_WD_D), 0, scr, r, lane); return;
#endif
    }
    r -= CONV_A;
    if (r < I_WI) { tr_item(kp->in[IN_WIN] + (size_t)D * DQKV, D, DQKV, WSP(bf16_t*, WS_WI) + (size_t)DQKV * D, 0, scr, r, lane); return; } r -= I_WI;
    if (r < I_WO) { tr_item(kp->in[IN_WO] + (size_t)D * D, D, D, WSP(bf16_t*, WS_WO) + (size_t)D * D, 0, scr, r, lane); return; } r -= I_WO;
    if (r < NE * I_MG) { const int e = r / I_MG; tr_item8(kp->in[IN_MWG] + (size_t)e * D * DFE, D, DFE, WSP(unsigned char*, WS_WGU_M) + (size_t)e * 2 * DFE * D, D, 1, scr, r - e * I_MG, lane); return; } r -= NE * I_MG;
    if (r < NE * I_MG) { const int e = r / I_MG; tr_item8(kp->in[IN_MWU] + (size_t)e * D * DFE, D, DFE, WSP(unsigned char*, WS_WGU_M) + (size_t)e * 2 * DFE * D, D, 2, scr, r - e * I_MG, lane); return; } r -= NE * I_MG;
    { const int e = r / I_MD; tr_item8(kp->in[IN_MWD] + (size_t)e * DFE * D, DFE, D, WSP(unsigned char*, WS_WD_M) + (size_t)e * D * DFE, DFE, 0, scr, r - e * I_MD, lane); }
}

__device__ __forceinline__ ConvDesc conv_desc_a(KPtr kp, unsigned char* ws, int r) {
    ConvDesc d;
    if (r < I_WI) { d.W = kp->in[IN_WIN]; d.WT = WSP(unsigned char*, WS_WI); d.K = D; d.N = DQKV; d.mode = 0; d.f8 = 0; d.item = r; d.ldk = D; return d; } r -= I_WI;
    if (r < I_WO) { d.W = kp->in[IN_WO]; d.WT = WSP(unsigned char*, WS_WO); d.K = D; d.N = D; d.mode = 0; d.f8 = 0; d.item = r; d.ldk = D; return d; } r -= I_WO;
    if (r < I_DG) { d.W = kp->in[IN_DWG]; d.WT = WSP(unsigned char*, WS_WGU_D); d.K = D; d.N = DFF; d.mode = 1; d.f8 = DENSE_F8; d.item = r; d.ldk = D; return d; } r -= I_DG;
    if (r < I_DG) { d.W = kp->in[IN_DWU]; d.WT = WSP(unsigned char*, WS_WGU_D); d.K = D; d.N = DFF; d.mode = 2; d.f8 = DENSE_F8; d.item = r; d.ldk = D; return d; } r -= I_DG;
    d.W = kp->in[IN_DWD]; d.WT = WSP(unsigned char*, WS_WD_D); d.K = DFF; d.N = D; d.mode = 0; d.f8 = DENSE_F8; d.item = r; d.ldk = DENSE_F8 ? DFFP : DFF; return d;
}

__device__ __forceinline__ ConvDesc conv_desc_b(KPtr kp, unsigned char* ws, int r) {
    ConvDesc d;
    if (r < I_WI) { d.W = kp->in[IN_WIN] + (size_t)D * DQKV; d.WT = WSP(unsigned char*, WS_WI) + (size_t)DQKV * D * 2; d.K = D; d.N = DQKV; d.mode = 0; d.f8 = 0; d.item = r; d.ldk = D; return d; } r -= I_WI;
    if (r < I_WO) { d.W = kp->in[IN_WO] + (size_t)D * D; d.WT = WSP(unsigned char*, WS_WO) + (size_t)D * D * 2; d.K = D; d.N = D; d.mode = 0; d.f8 = 0; d.item = r; d.ldk = D; return d; } r -= I_WO;
    if (r < NE * I_MG) { const int e = r / I_MG; d.W = kp->in[IN_MWG] + (size_t)e * D * DFE; d.WT = WSP(unsigned char*, WS_WGU_M) + (size_t)e * 2 * DFE * D; d.K = D; d.N = DFE; d.mode = 1; d.f8 = 1; d.item = r - e * I_MG; d.ldk = D; return d; } r -= NE * I_MG;
    if (r < NE * I_MG) { const int e = r / I_MG; d.W = kp->in[IN_MWU] + (size_t)e * D * DFE; d.WT = WSP(unsigned char*, WS_WGU_M) + (size_t)e * 2 * DFE * D; d.K = D; d.N = DFE; d.mode = 2; d.f8 = 1; d.item = r - e * I_MG; d.ldk = D; return d; } r -= NE * I_MG;
    { const int e = r / I_MD; d.W = kp->in[IN_MWD] + (size_t)e * DFE * D; d.WT = WSP(unsigned char*, WS_WD_M) + (size_t)e * D * DFE; d.K = DFE; d.N = D; d.mode = 0; d.f8 = 1; d.item = r - e * I_MD; d.ldk = DFE; return d; }
}

#ifndef MK_ONE_LAUNCH
#define MK_ONE_LAUNCH 1
#endif
#ifndef NORM_FOLD
#define NORM_FOLD 0
#endif
__global__ void __launch_bounds__(NTHREADS, 2) mega_fwd(Params P) {
    const Frame F0 = make_frame();
    unsigned* ctl = (unsigned*)(P.ws + WS_CTL);
    for (int u = F0.tid; u < (LDS_BYTES - MISC_OFF) / 4; u += NTHREADS) ((LAS unsigned*)(F0.lds + MISC_OFF))[u] = 0u;
    __syncthreads();
    const int lo = P.ph_lo, hi = P.ph_hi;
    const bool one_phase = (hi - lo) == 1;
    XcdBarrier bar; bar.bar = ctl + CW_BAR; bar.x = 0; bar.st = nullptr;
    if (!one_phase) bar = xcd_barrier_post(ctl + CW_BAR, F0.MISC + 8);
#ifndef PH_MASK
#define PH_MASK 0x3ffffu
#endif
#ifndef PH_MASK2
#define PH_MASK2 0x3ffffu
#endif
#define IN(k) (((PH_MASK >> ((k) > 8 ? (k) - 8 : (k))) & 1u) != 0u && ((PH_MASK2 >> (k)) & 1u) != 0u && lo <= (k) && (k) < hi)
#if defined(PHTIME)
#define PH_STAMP(k) do { KPtr kq_ = kparams(); unsigned* const dq_ = (unsigned*)(kq_->ws + WS_CTL) + 12290 + (k); if (blockIdx.x == 0 && threadIdx.x == 0) *dq_ = (unsigned)__builtin_amdgcn_s_memrealtime(); } while (0)
#else
#define PH_STAMP(k) do {} while (0)
#endif
#define SEAM(k) do { if (IN(k) && IN((k) + 1)) xcd_barrier(bar); } while (0)
#ifndef REP_TYPES
#define REP_TYPES 0
#endif
#ifndef REP_PHASE
#define REP_PHASE -1
#endif
#ifndef REP_COUNT
#define REP_COUNT 2
#endif
#define PH_BEGIN(k) for (int _rep = 0; _rep < (((k) == REP_PHASE) ? REP_COUNT : 1); ++_rep) { if (_rep) xcd_barrier(bar); if (IN(k))
#define PH_END }

    PH_STAMP(-1);
    PH_BEGIN(0) {
        PHASE_ARGS(); bf16_t* const WI = WSP(bf16_t*, WS_WI); bf16_t* const WOt = WSP(bf16_t*, WS_WO); bf16_t* const WGUD = WSP(bf16_t*, WS_WGU_D); bf16_t* const WDD = WSP(bf16_t*, WS_WD_D);
        bf16_t* const WGUM = WSP(bf16_t*, WS_WGU_M); bf16_t* const WDM = WSP(bf16_t*, WS_WD_M); bf16_t* const H = WSP(bf16_t*, WS_H);
        if (blockIdx.x < 3 * NH) { float* tbg = WSP(float*, WS_BKT) + blockIdx.x * TBL_N; const int br = blockIdx.x / NH, h = blockIdx.x % NH, dd = br == 0 ? 1 : (br == 1 ? 4 : 16);
            if (F.tid < TBL_N) { const int m_ = 160 - F.tid; tbg[F.tid] = (m_ >= 0 && m_ <= 128) ? kp->in[IN_RELB][t5_bucket(dd * m_) * NH + h] * LOG2E : -1e30f; } }
        LAS float* scr = (LAS float*)(F.lds + F.wave * WSCR);
        {
            const int per = (CONV_A + NGW - 1) / NGW, npair = (per + 1) / 2;
#define CA_IDX(i_) (F.gw + (i_) * NGW < CONV_A ? F.gw + (i_) * NGW : CONV_A - 1)
            f32x4 va[16], vb[16];
            ConvDesc da = conv_desc_a(kp, ws, CA_IDX(0)), db;
            tr_load(da, va, F.lane);
            for (int p_ = 0; p_ < npair - 1; ++p_) {
                db = conv_desc_a(kp, ws, CA_IDX(2 * p_ + 1)); tr_load(db, vb, F.lane);
                tr_finish(da, va, scr, F.lane);
                da = conv_desc_a(kp, ws, CA_IDX(2 * p_ + 2)); tr_load(da, va, F.lane);
                tr_finish(db, vb, scr, F.lane);
            }
            db = conv_desc_a(kp, ws, CA_IDX(2 * npair - 1)); tr_load(db, vb, F.lane);
            tr_finish(da, va, scr, F.lane);
            tr_finish(db, vb, scr, F.lane);
#undef CA_IDX
        }
#if DENSE_F8
        { unsigned char* wdd = WSP(unsigned char*, WS_WD_D); for (int i = blockIdx.x * NTHREADS + F.tid; i < D * ((DFFP - DFF) / 16); i += F.G * NTHREADS) { const int row = i >> 3, c = i & 7; *(u32x4*)(wdd + (size_t)row * DFFP + DFF + 16 * c) = (u32x4){0u, 0u, 0u, 0u}; } }
#endif
        rms_rows_f2b(kp->in[IN_X], kp->in[IN_ANG], H, F.gw, NGW, F.lane);
    }
    PH_END SEAM(0);

    for (int layer = 0; layer < 2; ++layer) {
        const int pb = layer == 0 ? 1 : 9;
        int lo_l = lo, hi_l = hi; asm volatile("" : "+s"(lo_l), "+s"(hi_l)); const int lo = lo_l, hi = hi_l;
        PH_BEGIN(pb) {
            PHASE_ARGS(); bf16_t* const H = WSP(bf16_t*, WS_H); bf16_t* const WI = WSP(bf16_t*, WS_WI); bf16_t* const QKV = WSP(bf16_t*, WS_QKV);
            pg8::Gemm g{H, WI + (size_t)layer * DQKV * D, T, DQKV, D}; pg8::StaticOrder S; S.init(T, DQKV, F.G, (int)blockIdx.x);
#if DENSE_F8 && NORM_FOLD
            LAS float* const rsl = (LAS float*)(F.lds + MISC_OFF) + 512;
            { const int c_ = (int)blockIdx.x, pm0 = 8 * (c_ & 7) + ((c_ >> 3) & 7); float rv = 1.0f;
              if (layer && F.tid < 256) { const f32x4* pr = (const f32x4*)(WSP(const float*, WS_PART) + (size_t)(pm0 * 256 + F.tid) * 32); f32x4 a4 = pr[0];
#pragma unroll
                  for (int k = 1; k < 8; ++k) a4 += pr[k];
                  rv = 1.0f / sqrtf((a4[0] + a4[1] + a4[2] + a4[3]) * (1.0f / D) + EPS); }
              if (F.tid < 256) rsl[F.tid] = rv;
              __syncthreads(); }
            pg8::EpiQKV E{QKV, rsl};
#else
            pg8::EpiQKV E{QKV, (const LAS float*)nullptr};
#endif
            pg8::gemm_phase<pg8::EpiQKV, pg8::StaticOrder, true, true>(F.lds, g, S, E, F.tid);
        }
        PH_END SEAM(pb);
        PH_BEGIN(pb + 1) {
            PHASE_ARGS(); bf16_t* const QKV = WSP(bf16_t*, WS_QKV); bf16_t* const OD = WSP(bf16_t*, WS_OD); bf16_t* const OS = WSP(bf16_t*, WS_OS); float* const LSE = WSP(float*, WS_LSE);
            LAS float* tbl = (LAS float*)(F.lds + TBL_OFF);
            { const float* tbg = WSP(const float*, WS_BKT); for (int i = F.tid; i < 3 * NH * TBL_N; i += NTHREADS) tbl[i] = tbg[i]; }
            __syncthreads();
            LAS unsigned char* wl = F.lds + F.wave * WSCR;
            const size_t TS = (size_t)T * DH;
            const int cbase = CONV_A + layer * (CONV_B / 2); const int ncv = CONV_B / 2; constexpr int natt_c = 4 * 4096; const int natt = natt_c; (void)natt;
#ifndef F8_ALIGN
#define F8_ALIGN true
#endif
#ifndef ATT_NA
#define ATT_NA 4
#endif
            constexpr int NA = ATT_NA, NCV = 8 - ATT_NA;
            const int NCW = F.G * NCV;
            if (F.wave >= NA) {
                const Frame FC = make_frame();
                const int c0 = blockIdx.x * NCV + (F.wave - NA); const int roff = cbase - CONV_A;
#if defined(CONV2X)
                const int per0 = (ncv + NCW - 1) / NCW, per = CONV2X * per0, npair = (per + 1) / 2;
#define CV_IDX(i_) (roff + (c0 + ((i_) % per0) * NCW < ncv ? c0 + ((i_) % per0) * NCW : ncv - 1))
#else
                const int per = (ncv + NCW - 1) / NCW, npair = (per + 1) / 2;
#define CV_IDX(i_) (roff + (c0 + (i_) * NCW < ncv ? c0 + (i_) * NCW : ncv - 1))
#endif
                f32x4 va[16], vb[16];
                ConvDesc da = conv_desc_b(kp, ws, CV_IDX(0)), db;
                tr_load(da, va, FC.lane);
                for (int p = 0; p < npair - 1; ++p) {
                    db = conv_desc_b(kp, ws, CV_IDX(2 * p + 1)); tr_load(db, vb, FC.lane);
                    tr_finish(da, va, (LAS float*)wl, FC.lane);
                    da = conv_desc_b(kp, ws, CV_IDX(2 * p + 2)); tr_load(da, va, FC.lane);
                    tr_finish(db, vb, (LAS float*)wl, FC.lane);
                }
                db = conv_desc_b(kp, ws, CV_IDX(2 * npair - 1)); tr_load(db, vb, FC.lane);
                tr_finish(da, va, (LAS float*)wl, FC.lane);
                tr_finish(db, vb, (LAS float*)wl, FC.lane);
#undef CV_IDX
            }
            {
                const Frame FA = make_frame();
                static_assert(natt_c == 8 * 2048, "2048 items per XCD queue");
                unsigned* const aqb = (unsigned*)(ws + WS_CTL) + CW_AQ + 128 * layer;
                const int x0 = (int)(xb_xcc_id() & 7u);
#define AQ_FETCH(dst_, q_) { dst_ = 0u; if (FA.lane == 0) dst_ = __hip_atomic_fetch_add(aqb + 16 * (q_), 1u, __ATOMIC_RELAXED, __HIP_MEMORY_SCOPE_AGENT); }
                if (F.wave < NA) __builtin_amdgcn_s_setprio(2);
                for (int qs = 0; qs < 8; ++qs) { const int xq = (x0 + qs) & 7;
                unsigned nv, nn; AQ_FETCH(nv, xq);
                int n = __builtin_amdgcn_readfirstlane((int)nv);
                while (n < 2048) {
                    AQ_FETCH(nn, xq);
                    const int it = ((((15 - (n >> 7)) << 3) + xq) << 7) + (n & 127);
                    const int type = it >> 12, idx = it & 4095, bh = idx >> 7, rem = idx & 127, b = bh >> 3, h = bh & 7;
                    const size_t hb = (size_t)(bh * SEQ) * HD;
                    if (type < 3) {
                        const int sh = 2 * type, dil = 1 << sh;
                        const int gps = 128 >> sh, r = rem / gps, qg = rem - r * gps; const int tok0 = b * SEQ + r;
                        const size_t sub = hb + (size_t)r * HD;
                        attn_item<0>(wl, QKV + sub, dil * HD, QKV + TS + sub, QKV + 2 * TS + sub,
                                     OD + (size_t)type * TS + (size_t)tok0 * DH + h * HD, dil * DH, LSE + (size_t)type * T * NH + (size_t)tok0 * NH + h, dil * NH, tbl + (type * NH + h) * TBL_N, qg, FA.lane);
                    } else {
                        attn_item<1>(wl, QKV + 3 * TS + hb, HD, QKV + 4 * TS + hb, QKV + 5 * TS + hb, OS + (size_t)(b * SEQ) * DH + h * HD, DH, nullptr, 0, nullptr, rem, FA.lane);
                    }
                    n = __builtin_amdgcn_readfirstlane((int)nn);
                }
                }
                __builtin_amdgcn_s_setprio(0);
#undef AQ_FETCH
            }
        }
        PH_END SEAM(pb + 1);
        PH_BEGIN(pb + 2) {
            PHASE_ARGS(); bf16_t* const OD = WSP(bf16_t*, WS_OD); bf16_t* const OS = WSP(bf16_t*, WS_OS); float* const LSE = WSP(float*, WS_LSE); bf16_t* const O = WSP(bf16_t*, WS_O);
            const float* gd = kp->in[IN_GDIL] + (size_t)layer * DH; const float* gs = kp->in[IN_GSB] + (size_t)layer * DH;
            const int h = F.lane >> 3;
            f32x4 gdq[4], gsq[4];
#pragma unroll
            for (int k = 0; k < 4; ++k) { gdq[k] = ((const f32x4*)(gd + 16 * F.lane))[k]; gsq[k] = ((const f32x4*)(gs + 16 * F.lane))[k]; }
            for (int tb0 = F.gw; tb0 < T; tb0 += 2 * NGW) {
                float ls[2][3]; u32x4 ra[2][2], rbq[2][2], rcq[2][2], rsq[2][2];
#pragma unroll
                for (int r = 0; r < 2; ++r) { const int t = tb0 + r * NGW;
                    ls[r][0] = LSE[(size_t)t * NH + h]; ls[r][1] = LSE[(size_t)(T + t) * NH + h]; ls[r][2] = LSE[(size_t)(2 * T + t) * NH + h];
                    const u32x4* p0 = (const u32x4*)(OD + (size_t)t * DH + 16 * F.lane); const u32x4* p1 = (const u32x4*)(OD + (size_t)(T + t) * DH + 16 * F.lane); const u32x4* p2 = (const u32x4*)(OD + (size_t)(2 * T + t) * DH + 16 * F.lane);
                    const u32x4* ps = (const u32x4*)(OS + (size_t)t * DH + 16 * F.lane);
#pragma unroll
                    for (int k = 0; k < 2; ++k) { ra[r][k] = p0[k]; rbq[r][k] = p1[k]; rcq[r][k] = p2[k]; rsq[r][k] = ps[k]; } }
#pragma unroll
                for (int r = 0; r < 2; ++r) { const int t = tb0 + r * NGW;
                    const float l0 = ls[r][0], l1 = ls[r][1], l2 = ls[r][2];
                    const float lm = fmaxf(l0, fmaxf(l1, l2)); float w0 = __expf(l0 - lm), w1 = __expf(l1 - lm), w2 = __expf(l2 - lm); const float wi = 1.0f / (w0 + w1 + w2); w0 *= wi; w1 *= wi; w2 *= wi;
                    float vd[16], vs[16]; float ssd = 0.f, sss = 0.f;
#pragma unroll
                    for (int k = 0; k < 2; ++k)
#pragma unroll
                        for (int j = 0; j < 4; ++j) {
                            const float d0 = w0 * bf_lo(ra[r][k][j]) + w1 * bf_lo(rbq[r][k][j]) + w2 * bf_lo(rcq[r][k][j]), d1 = w0 * bf_hi(ra[r][k][j]) + w1 * bf_hi(rbq[r][k][j]) + w2 * bf_hi(rcq[r][k][j]);
                            vd[8 * k + 2 * j] = d0; vd[8 * k + 2 * j + 1] = d1; ssd += d0 * d0 + d1 * d1;
                            const float s0 = bf_lo(rsq[r][k][j]), s1 = bf_hi(rsq[r][k][j]); vs[8 * k + 2 * j] = s0; vs[8 * k + 2 * j + 1] = s1; sss += s0 * s0 + s1 * s1; }
                    const float rd = 1.0f / sqrtf(wave_sum(ssd) * (1.0f / DH) + EPS), rs = 1.0f / sqrtf(wave_sum(sss) * (1.0f / DH) + EPS);
                    u32x4 od[2], os[2];
#pragma unroll
                    for (int k = 0; k < 2; ++k) { const f32x4 ga = gdq[2 * k], gb = gdq[2 * k + 1], ha = gsq[2 * k], hb = gsq[2 * k + 1];
                        od[k].x = pk2(vd[8 * k] * rd * ga.x, vd[8 * k + 1] * rd * ga.y); od[k].y = pk2(vd[8 * k + 2] * rd * ga.z, vd[8 * k + 3] * rd * ga.w);
                        od[k].z = pk2(vd[8 * k + 4] * rd * gb.x, vd[8 * k + 5] * rd * gb.y); od[k].w = pk2(vd[8 * k + 6] * rd * gb.z, vd[8 * k + 7] * rd * gb.w);
                        os[k].x = pk2(vs[8 * k] * rs * ha.x, vs[8 * k + 1] * rs * ha.y); os[k].y = pk2(vs[8 * k + 2] * rs * ha.z, vs[8 * k + 3] * rs * ha.w);
                        os[k].z = pk2(vs[8 * k + 4] * rs * hb.x, vs[8 * k + 5] * rs * hb.y); os[k].w = pk2(vs[8 * k + 6] * rs * hb.z, vs[8 * k + 7] * rs * hb.w); }
                    u32x4* o0 = (u32x4*)(O + (size_t)t * D + 16 * F.lane); u32x4* o1 = (u32x4*)(O + (size_t)t * D + DH + 16 * F.lane);
                    o0[0] = od[0]; o0[1] = od[1]; o1[0] = os[0]; o1[1] = os[1];
                }
            }
        }
        PH_END SEAM(pb + 2);
        PH_BEGIN(pb + 3) {
            PHASE_ARGS(); bf16_t* const O = WSP(bf16_t*, WS_O); bf16_t* const WOt = WSP(bf16_t*, WS_WO); bf16_t* const X = WSP(bf16_t*, WS_X);
            pg8::Gemm g{O, WOt + (size_t)layer * D * D, T, D, D}; pg8::StaticOrder S; S.init(T, D, F.G, (int)blockIdx.x);
            pg8::EpiResB E{layer == 0 ? kp->in[IN_X] : (const float*)nullptr, X, X, D, 1.0f};
            pg8::gemm_phase<pg8::EpiResB, pg8::StaticOrder, true, true>(F.lds, g, S, E, F.tid);
        }
        PH_END SEAM(pb + 3);
        PH_BEGIN(pb + 4) {
            PHASE_ARGS(); const bf16_t* const X = WSP(const bf16_t*, WS_X); bf16_t* const H = WSP(bf16_t*, WS_H); int* const SEL = WSP(int*, WS_SEL); float* const GWT = WSP(float*, WS_GW); int* const HIST = WSP(int*, WS_HIST);
            const float* gF = kp->in[IN_FNG] + (size_t)layer * D;
#if DENSE_F8
            if (layer == 0) {
                unsigned char* ACT = WSP(unsigned char*, WS_ACT);
                f32x4 gq[8];
#pragma unroll
                for (int q = 0; q < 8; ++q) gq[q] = ((const f32x4*)gF)[F.lane + 64 * q];
                for (int m0 = F.gw; m0 < T; m0 += 4 * NGW) {
                    u32x2 raw[4][8];
#pragma unroll
                    for (int r = 0; r < 4; ++r)
#pragma unroll
                        for (int q = 0; q < 8; ++q) raw[r][q] = ((const u32x2*)(X + (size_t)(m0 + r * NGW) * D))[F.lane + 64 * q];
#pragma unroll
                    for (int r = 0; r < 4; ++r) { const int m = m0 + r * NGW;
                        f32x4 v[8]; float ss = 0.f;
#pragma unroll
                        for (int q = 0; q < 8; ++q) { v[q] = (f32x4){bf_lo(raw[r][q].x), bf_hi(raw[r][q].x), bf_lo(raw[r][q].y), bf_hi(raw[r][q].y)}; ss += dot4(v[q]); }
                        const float rstd = F8_SH / sqrtf(wave_sum(ss) * (1.0f / D) + EPS);
                        unsigned* o8 = (unsigned*)((unsigned char*)H + (size_t)m * D) + F.lane;
#pragma unroll
                        for (int q = 0; q < 8; ++q) o8[64 * q] = pg8::pk4_fp8(v[q].x * rstd * gq[q].x, v[q].y * rstd * gq[q].y, v[q].z * rstd * gq[q].z, v[q].w * rstd * gq[q].w);
                        { u32x4 z4 = (u32x4){0u, 0u, 0u, 0u}; asm volatile("" : "+v"(z4));
                          if (F.lane < (DFFP - DFF) / 16) *(u32x4*)(ACT + (size_t)m * DFFP + DFF + 16 * F.lane) = z4; }
                    }
                }
            }
#else
            if (layer == 0) rms_rows_b2b(X, gF, H, F.gw, NGW, F.lane);
#endif
            else {
                volatile LAS unsigned* hist = F.MISC + 16;
                const int rows_per_wg = T / F.G, rows_per_wave = rows_per_wg / NWAVES;
                { const f32x4* RW4 = (const f32x4*)kp->in[IN_RW]; LAS f32x4* RL = (LAS f32x4*)F.lds;
                  for (int u = F.tid; u < 4096; u += NTHREADS) { const int ln = u & 63, k = u >> 6, half = k & 1, qi = k >> 1, i = qi & 3, q = qi >> 2; RL[u] = RW4[(4 * (ln + 64 * q) + i) * 2 + half]; } }
                __syncthreads();
                const LAS f32x4* rl = (const LAS f32x4*)F.lds + F.lane;
                f32x4 gq[8];
#pragma unroll
                for (int q = 0; q < 8; ++q) gq[q] = ((const f32x4*)gF)[F.lane + 64 * q];
                for (int jb = 0; jb < rows_per_wave; jb += 8) {
                    const int tb0 = blockIdx.x * rows_per_wg + F.wave * rows_per_wave + jb;
                    u32x2 raw[8][8];
#pragma unroll
                    for (int r = 0; r < 8; ++r)
#pragma unroll
                        for (int q = 0; q < 8; ++q) raw[r][q] = ((const u32x2*)(X + (size_t)(tb0 + r) * D))[F.lane + 64 * q];
#pragma unroll
                    for (int r = 0; r < 8; ++r) { const int t = tb0 + r;
                    f32x4 v[8]; float ss = 0.f;
#pragma unroll
                    for (int q = 0; q < 8; ++q) { v[q] = (f32x4){bf_lo(raw[r][q].x), bf_hi(raw[r][q].x), bf_lo(raw[r][q].y), bf_hi(raw[r][q].y)}; ss += dot4(v[q]); }
                    const float rstd = 1.0f / sqrtf(wave_sum(ss) * (1.0f / D) + EPS);
                    float lg[8];
#pragma unroll
                    for (int e = 0; e < 8; ++e) lg[e] = 0.f;
                    unsigned* o8 = (unsigned*)((unsigned char*)H + (size_t)t * D) + F.lane;
#pragma unroll
                    for (int q = 0; q < 8; ++q) { const f32x4 gg = gq[q]; const f32x4 y = {v[q].x * rstd * gg.x, v[q].y * rstd * gg.y, v[q].z * rstd * gg.z, v[q].w * rstd * gg.w};
                        o8[64 * q] = pg8::pk4_fp8(y.x * F8_SH, y.y * F8_SH, y.z * F8_SH, y.w * F8_SH);
#pragma unroll
                        for (int i = 0; i < 4; ++i) { const f32x4 ra = rl[((q * 4 + i) * 2) * 64], rb = rl[((q * 4 + i) * 2 + 1) * 64]; const float yi = y[i];
                            lg[0] += yi * ra.x; lg[1] += yi * ra.y; lg[2] += yi * ra.z; lg[3] += yi * ra.w; lg[4] += yi * rb.x; lg[5] += yi * rb.y; lg[6] += yi * rb.z; lg[7] += yi * rb.w; } }
#pragma unroll
                    for (int e = 0; e < 8; ++e) lg[e] = wave_sum(lg[e]);
                    if (F.lane == 0) {
                        int e1 = 0; float v1 = lg[0];
#pragma unroll
                        for (int e = 1; e < 8; ++e) if (lg[e] > v1) { v1 = lg[e]; e1 = e; }
                        int e2 = -1; float v2 = -3e38f;
#pragma unroll
                        for (int e = 0; e < 8; ++e) if (e != e1 && lg[e] > v2) { v2 = lg[e]; e2 = e; }
                        const float ex = __expf(v2 - v1); const float w1 = 1.0f / (1.0f + ex), w2 = ex * w1;
                        SEL[2 * t] = e1; SEL[2 * t + 1] = e2; GWT[2 * t] = w1; GWT[2 * t + 1] = w2;
                        __hip_atomic_fetch_add((LAS unsigned*)&hist[e1], 1u, __ATOMIC_RELAXED, __HIP_MEMORY_SCOPE_WORKGROUP); __hip_atomic_fetch_add((LAS unsigned*)&hist[e2], 1u, __ATOMIC_RELAXED, __HIP_MEMORY_SCOPE_WORKGROUP);
                    }
                    }
                }
                __syncthreads();
                if (F.tid < 8) { HIST[blockIdx.x * 8 + F.tid] = (int)hist[F.tid]; }
            }
        }
        PH_END SEAM(pb + 4);
        if (layer == 0) {
#if DENSE_F8
            PH_BEGIN(6) {
                PHASE_ARGS(); const bf16_t* const H = WSP(const bf16_t*, WS_H); const bf16_t* const WGUD = WSP(const bf16_t*, WS_WGU_D); unsigned char* const ACT = WSP(unsigned char*, WS_ACT);
                pg8::Gemm g{H, WGUD, T, 2 * DFF, D / 2}; pg8::StaticOrder S; S.init(T, 2 * DFF, F.G, (int)blockIdx.x);
                pg8::EpiSwiGLU8 E{ACT, DFFP, DFF / 128, 1.0f / (F8_SH * F8_SW), F8_SACT};
                pg8::gemm_phase<pg8::EpiSwiGLU8, pg8::StaticOrder, true, true, true>(F.lds, g, S, E, F.tid);
            }
            PH_END SEAM(6);
            PH_BEGIN(7) {
                PHASE_ARGS(); const bf16_t* const ACT = WSP(const bf16_t*, WS_ACT); const bf16_t* const WDD = WSP(const bf16_t*, WS_WD_D); bf16_t* const X = WSP(bf16_t*, WS_X);
                pg8::Gemm g{ACT, WDD, T, D, DFFP / 2}; pg8::StaticOrder S; S.init(T, D, F.G, (int)blockIdx.x);
#if NORM_FOLD
                pg8::EpiResF32N E{X, X, D, 1.0f / (F8_SACT * F8_SW), kp->in[IN_ANG] + D, WSP(bf16_t*, WS_H), WSP(float*, WS_PART)};
                pg8::gemm_phase<pg8::EpiResF32N, pg8::StaticOrder, true, true, true>(F.lds, g, S, E, F.tid);
#else
                pg8::EpiResB E{(const float*)nullptr, X, X, D, 1.0f / (F8_SACT * F8_SW)};
                pg8::gemm_phase<pg8::EpiResB, pg8::StaticOrder, true, true, true>(F.lds, g, S, E, F.tid);
#endif
            }
#else
            PH_BEGIN(6) {
                PHASE_ARGS(); bf16_t* const H = WSP(bf16_t*, WS_H); bf16_t* const WGUD = WSP(bf16_t*, WS_WGU_D); bf16_t* const ACT = WSP(bf16_t*, WS_ACT);
                pg8::Gemm g{H, WGUD, T, 2 * DFF, D}; pg8::StaticOrder S; S.init(T, 2 * DFF, F.G, (int)blockIdx.x);
                pg8::EpiSwiGLU E{ACT, DFF, DFF / 128};
#if defined(CLKPROBE)
                const unsigned long long ct0 = __builtin_amdgcn_s_memtime(), cr0 = __builtin_amdgcn_s_memrealtime();
#endif
                pg8::gemm_phase<pg8::EpiSwiGLU, pg8::StaticOrder, true, true>(F.lds, g, S, E, F.tid);
#if defined(CLKPROBE)
                { const unsigned long long ct1 = __builtin_amdgcn_s_memtime(), cr1 = __builtin_amdgcn_s_memrealtime();
                  if (blockIdx.x == 5 && F.tid == 0) { const float ghz = (float)(ct1 - ct0) / (float)(cr1 - cr0) * 0.1f; const float us = (float)(cr1 - cr0) * 0.01f;
                      unsigned* dbg = (unsigned*)(ws + WS_CTL) + 12288; dbg[0] = (unsigned)(CLKPROBE == 1 ? (int)(ghz * 4.f) : (int)(us * 0.1f + 0.5f)); } }
#endif
            }
            PH_END SEAM(6);
            PH_BEGIN(7) {
                PHASE_ARGS(); bf16_t* const ACT = WSP(bf16_t*, WS_ACT); bf16_t* const WDD = WSP(bf16_t*, WS_WD_D); bf16_t* const X = WSP(bf16_t*, WS_X);
                pg8::Gemm g{ACT, WDD, T, D, DFF}; pg8::StaticOrder S; S.init(T, D, F.G, (int)blockIdx.x);
                pg8::EpiResB E{(const float*)nullptr, X, X, D, 1.0f};
                pg8::gemm_phase<pg8::EpiResB, pg8::StaticOrder, true, true>(F.lds, g, S, E, F.tid);
            }
#endif
            PH_END SEAM(7);
#if !(DENSE_F8 && NORM_FOLD)
            PH_BEGIN(8) { PHASE_ARGS(); const bf16_t* const X = WSP(const bf16_t*, WS_X); bf16_t* const H = WSP(bf16_t*, WS_H); rms_rows_b2b(X, kp->in[IN_ANG] + D, H, F.gw, NGW, F.lane); }
            PH_END SEAM(8);
#endif
        }
    }
    PH_BEGIN(14) {
        PHASE_ARGS(); bf16_t* const H = WSP(bf16_t*, WS_H); unsigned char* const AS = WSP(unsigned char*, WS_AS); int* const SEL = WSP(int*, WS_SEL); int* const POS = WSP(int*, WS_POS); int* const HIST = WSP(int*, WS_HIST); int* const MOEINFO = WSP(int*, WS_MOEINFO);
        volatile LAS unsigned* tot = F.MISC + 32; volatile LAS unsigned* pre = F.MISC + 40; volatile LAS unsigned* rbase = F.MISC + 48; volatile LAS unsigned* ent = F.MISC + 64;
        if (F.tid < 16) F.MISC[32 + F.tid] = 0u;
        __syncthreads();
        { const int e = F.tid & 7, ch = F.tid >> 3; unsigned st = 0, sp = 0;
#pragma unroll
          for (int k = 0; k < 4; ++k) { const int w = 4 * ch + k; const unsigned hv = (unsigned)HIST[w * 8 + e]; st += hv; if (w < (int)blockIdx.x) sp += hv; }
          __hip_atomic_fetch_add((LAS unsigned*)&tot[e], st, __ATOMIC_RELAXED, __HIP_MEMORY_SCOPE_WORKGROUP); __hip_atomic_fetch_add((LAS unsigned*)&pre[e], sp, __ATOMIC_RELAXED, __HIP_MEMORY_SCOPE_WORKGROUP); }
        __syncthreads();
        if (F.tid == 0) { unsigned tbv = 0;
            for (int e = 0; e < 8; ++e) { rbase[e] = tbv * 256u + pre[e]; if (blockIdx.x == 0) MOEINFO[e] = (int)tbv; tbv += (tot[e] + 255u) >> 8; }
            if (blockIdx.x == 0) MOEINFO[8] = (int)tbv; }
        const int t0 = blockIdx.x * 64;
        if (F.tid < 128) ent[F.tid] = (unsigned)SEL[2 * t0 + F.tid];
        __syncthreads();
        if (F.tid < 128) { const unsigned e = ent[F.tid]; unsigned rank = 0; for (int j = 0; j < F.tid; ++j) rank += (ent[j] == e) ? 1u : 0u;
            const unsigned pos = rbase[e] + rank; POS[2 * t0 + F.tid] = (int)pos; F.MISC[192 + F.tid] = pos; }
        __syncthreads();
        for (int q = 0; q < 16; q += 8) {
            u32x4 v[8][2];
#pragma unroll
            for (int k = 0; k < 8; ++k) { const int en = 16 * F.wave + q + k; const u32x4* src = (const u32x4*)((const unsigned char*)H + (size_t)(t0 + (en >> 1)) * D) + F.lane;
                v[k][0] = src[0]; v[k][1] = src[64]; }
#pragma unroll
            for (int k = 0; k < 8; ++k) { const int en = 16 * F.wave + q + k; u32x4* dst = (u32x4*)(AS + (size_t)F.MISC[192 + en] * D) + F.lane;
                dst[0] = v[k][0]; dst[64] = v[k][1]; }
        }
    }
    PH_END SEAM(14);
    if (IN(15) || IN(16)) {
        PHASE_ARGS(); int* const MOEINFO = WSP(int*, WS_MOEINFO); const bf16_t* const AS = WSP(const bf16_t*, WS_AS); const bf16_t* const WGUM = WSP(const bf16_t*, WS_WGU_M); unsigned char* const ACTM = WSP(unsigned char*, WS_ACTM); const bf16_t* const WDM = WSP(const bf16_t*, WS_WD_M); bf16_t* const Y = WSP(bf16_t*, WS_Y);
        int tbv[9];
#pragma unroll
        for (int k = 0; k < 9; ++k) tbv[k] = __builtin_amdgcn_readfirstlane((int)__hip_atomic_load((unsigned*)MOEINFO + k, __ATOMIC_RELAXED, __HIP_MEMORY_SCOPE_AGENT));
        PH_BEGIN(15) {
            pg8::Gemm g{AS, WGUM, MOE_ROWS, NE * 2 * DFE, D / 2}; pg8::GroupedOrder S; S.init(tbv[8], 2 * DFE / 256, F.G, (int)blockIdx.x);
#pragma unroll
            for (int k = 0; k < 9; ++k) S.tb[k] = tbv[k];
            pg8::EpiSwiGLU8 E{ACTM, DFE, 2 * DFE / 256, 1.0f / (F8_SH * F8_SW), F8_SACT};
            pg8::gemm_phase<pg8::EpiSwiGLU8, pg8::GroupedOrder, F8_ALIGN, true, true>(F.lds, g, S, E, F.tid);
        }
        PH_END SEAM(15);
        PH_BEGIN(16) {
#if defined(NO_TAIL)
            const int rmain = tbv[8];
#else
            const int rmain = tbv[8] < TAIL_T0 ? tbv[8] : TAIL_T0;
#endif
            pg8::Gemm g{(const bf16_t*)ACTM, WDM, MOE_ROWS, NE * D, DFE / 2}; pg8::GroupedOrder S; S.init(rmain, D / 256, F.G, (int)blockIdx.x);
#pragma unroll
            for (int k = 0; k < 9; ++k) S.tb[k] = tbv[k];
            pg8::EpiBf16G E{Y, D, D / 256};
            pg8::gemm_phase<pg8::EpiBf16G, pg8::GroupedOrder, F8_ALIGN, true, true>(F.lds, g, S, E, F.tid);
            pg8::TailOrder S2; S2.init(tbv[8] - rmain, D / 256, TAIL_SL, TAIL_NT, F.G, (int)blockIdx.x);
#pragma unroll
            for (int k = 0; k < 9; ++k) S2.tb[k] = tbv[k];
            pg8::EpiPartF32 E2{WSP(float*, WS_YP), D / 256, TAIL_NT * 128, (unsigned)(TAIL_MAXT * 256 * D)};
            pg8::gemm_phase<pg8::EpiPartF32, pg8::TailOrder, F8_ALIGN, true, true>(F.lds, g, S2, E2, F.tid);
        } PH_END
    }
    SEAM(16);
    PH_BEGIN(17) {
        PHASE_ARGS(); const bf16_t* const X = WSP(const bf16_t*, WS_X); bf16_t* const Y = WSP(bf16_t*, WS_Y); int* const POS = WSP(int*, WS_POS); float* const GWT = WSP(float*, WS_GW);
        const float* gfin = kp->in[IN_FING];
#if defined(PHTIME)
        xcd_barrier(bar);
#endif
        {
            const int ntr = (WSP(const int*, WS_MOEINFO)[8] - TAIL_T0) * 256; const float* const YP = WSP(const float*, WS_YP);
            for (int r = F.gw; r < ntr; r += NGW) {
#pragma unroll
                for (int jh = 0; jh < 2; ++jh) { f32x4 s[4];
#pragma unroll
                    for (int j = 0; j < 4; ++j) s[j] = ((const f32x4*)(YP + (size_t)r * D))[F.lane + 64 * (4 * jh + j)];
#pragma unroll
                    for (int k = 1; k < TAIL_SL; ++k)
#pragma unroll
                        for (int j = 0; j < 4; ++j) s[j] += ((const f32x4*)(YP + ((size_t)k * TAIL_MAXT * 256 + r) * D))[F.lane + 64 * (4 * jh + j)];
#pragma unroll
                    for (int j = 0; j < 4; ++j) { u32x2 w; w.x = pk2(s[j].x, s[j].y); w.y = pk2(s[j].z, s[j].w); ((u32x2*)(Y + (size_t)(TAIL_T0 * 256 + r) * D))[F.lane + 64 * (4 * jh + j)] = w; }
                }
            }
            if (!one_phase) xcd_barrier(bar);
        }
#if defined(PHTIME)
        unsigned dbgv; { const unsigned s0_ = __hip_atomic_load((unsigned*)(ws + WS_CTL) + 12290 + PHTIME - 1, __ATOMIC_RELAXED, __HIP_MEMORY_SCOPE_AGENT), s1_ = __hip_atomic_load((unsigned*)(ws + WS_CTL) + 12290 + PHTIME, __ATOMIC_RELAXED, __HIP_MEMORY_SCOPE_AGENT);
            const float us_ = (float)(s1_ - s0_) * 0.01f; int v_ = (int)floorf(log2f(us_ / (float)(PHUNIT)) * 6.0f); v_ = v_ < 0 ? 0 : (v_ > 29 ? 29 : v_); dbgv = (unsigned)(1 + v_); }
#elif defined(CLKPROBE)
        const unsigned dbgv = __hip_atomic_load((unsigned*)(ws + WS_CTL) + 12288, __ATOMIC_RELAXED, __HIP_MEMORY_SCOPE_AGENT);
#endif
        f32x4 gq[8];
#pragma unroll
        for (int j = 0; j < 8; ++j) gq[j] = ((const f32x4*)gfin)[F.lane + 64 * j];
        int ppa[8][2]; float wwa[8][2];
#pragma unroll
        for (int k = 0; k < 8; ++k) { const int t = F.gw + k * NGW; ppa[k][0] = POS[2 * t]; ppa[k][1] = POS[2 * t + 1]; wwa[k][0] = GWT[2 * t]; wwa[k][1] = GWT[2 * t + 1]; }
#pragma unroll
        for (int k = 0; k < 8; ++k) { ppa[k][0] = __builtin_amdgcn_readfirstlane(ppa[k][0]); ppa[k][1] = __builtin_amdgcn_readfirstlane(ppa[k][1]);
            wwa[k][0] = __builtin_bit_cast(float, __builtin_amdgcn_readfirstlane(__builtin_bit_cast(int, wwa[k][0]))) * (1.0f / (F8_SACT * F8_SW));
            wwa[k][1] = __builtin_bit_cast(float, __builtin_amdgcn_readfirstlane(__builtin_bit_cast(int, wwa[k][1]))) * (1.0f / (F8_SACT * F8_SW)); }
        static_assert(T % (8 * 2048) == 0, "eight tokens per wave");
#pragma unroll
        for (int kb = 0; kb < 8; kb += 2) { const int tb0 = F.gw + kb * NGW;
            int pp[2][2]; float ww[2][2];
#pragma unroll
            for (int r = 0; r < 2; ++r) { pp[r][0] = ppa[kb + r][0]; pp[r][1] = ppa[kb + r][1]; ww[r][0] = wwa[kb + r][0]; ww[r][1] = wwa[kb + r][1]; }
            u32x2 rx[2][8], ra[2][8], rb[2][8];
#pragma unroll
            for (int r = 0; r < 2; ++r) { const int t = tb0 + r * NGW;
                const u32x2* xr = (const u32x2*)(X + (size_t)t * D) + F.lane; const u32x2* y0 = (const u32x2*)(Y + (size_t)pp[r][0] * D) + F.lane; const u32x2* y1 = (const u32x2*)(Y + (size_t)pp[r][1] * D) + F.lane;
#pragma unroll
                for (int j = 0; j < 8; ++j) { rx[r][j] = xr[64 * j]; ra[r][j] = y0[64 * j]; rb[r][j] = y1[64 * j]; } }
#pragma unroll
            for (int r = 0; r < 2; ++r) { const int t = tb0 + r * NGW; const float w0 = ww[r][0], w1 = ww[r][1];
                f32x4 v[8]; float ss = 0.f;
#pragma unroll
                for (int j = 0; j < 8; ++j) { const u32x2 x2 = rx[r][j], a = ra[r][j], b = rb[r][j];
                    v[j].x = bf_lo(x2.x) + w0 * bf_lo(a.x) + w1 * bf_lo(b.x); v[j].y = bf_hi(x2.x) + w0 * bf_hi(a.x) + w1 * bf_hi(b.x); v[j].z = bf_lo(x2.y) + w0 * bf_lo(a.y) + w1 * bf_lo(b.y); v[j].w = bf_hi(x2.y) + w0 * bf_hi(a.y) + w1 * bf_hi(b.y);
                    ss += dot4(v[j]); }
                const float rstd = 1.0f / sqrtf(wave_sum(ss) * (1.0f / D) + EPS);
                f32x4* orow = (f32x4*)(kp->out + (size_t)t * D) + F.lane;
#pragma unroll
                for (int j = 0; j < 8; ++j) { const f32x4 gg = gq[j]; f32x4 ov = (f32x4){v[j].x * rstd * gg.x, v[j].y * rstd * gg.y, v[j].z * rstd * gg.z, v[j].w * rstd * gg.w};
#if defined(CLKPROBE) || defined(PHTIME)
                    ov = ov * (1.0f + (float)dbgv);
#endif
                    orow[64 * j] = ov; }
            }
        }
    } PH_END
#undef IN
#undef SEAM
}

#ifndef MK_ONE_LAUNCH
#define MK_ONE_LAUNCH 1
#endif
extern "C" void kernel_launch(void* const* d_in, const int* in_sizes, int n_in, void* d_out, int out_size, void* d_ws, size_t ws_size, hipStream_t stream) {
    static int grid = 0;
    if (grid == 0) {
        if (n_in != 16 || in_sizes[0] != T * D || out_size != T * D || ws_size < WS_END) { fprintf(stderr, "kernel_launch: shape/workspace mismatch (n_in %d, in0 %d, out %d, ws %zu, need %zu)\n", n_in, n_in > 0 ? in_sizes[0] : -1, out_size, ws_size, (size_t)WS_END); grid = -1; return; }
        int dev = 0, cus = 0, per_cu = 0;
        if (hipGetDevice(&dev) != hipSuccess || hipDeviceGetAttribute(&cus, hipDeviceAttributeMultiprocessorCount, dev) != hipSuccess) { grid = -1; return; }
        if (hipFuncSetAttribute((const void*)mega_fwd, hipFuncAttributeMaxDynamicSharedMemorySize, LDS_BYTES) != hipSuccess) { fprintf(stderr, "kernel_launch: hipFuncSetAttribute failed\n"); grid = -1; return; }
        if (hipOccupancyMaxActiveBlocksPerMultiprocessor(&per_cu, (const void*)mega_fwd, NTHREADS, LDS_BYTES) != hipSuccess || per_cu < 1) fprintf(stderr, "kernel_launch: occupancy query says %d\n", per_cu);
        (void)hipGetLastError();
        grid = cus;
        if (grid != 256) { fprintf(stderr, "kernel_launch: built for 256 CUs, found %d\n", cus); grid = -1; return; }
    }
    if (grid < 0) return;
    (void)hipMemsetAsync((char*)d_ws + WS_CTL, 0, CTL_ZERO_BYTES, stream);
    Params p{};
    for (int i = 0; i < 16; ++i) p.in[i] = (const float*)d_in[i];
    p.out = (float*)d_out; p.ws = (unsigned char*)d_ws;
#if MK_ONE_LAUNCH
    p.ph_lo = 0; p.ph_hi = N_PHASES;
    hipLaunchKernelGGL(mega_fwd, dim3(grid), dim3(NTHREADS), LDS_BYTES, stream, p);
#else
    for (int ph = 0; ph < N_PHASES; ++ph) { p.ph_lo = ph; p.ph_hi = ph + 1; hipLaunchKernelGGL(mega_fwd, dim3(grid), dim3(NTHREADS), LDS_BYTES, stream, p); }
#endif
}
```

```cpp
#include <hip/hip_runtime.h>
#include <cstdio>
#include <cstdint>
namespace pg8 {
#define PG8_LAS __attribute__((address_space(3)))
typedef unsigned short bf16_t;
typedef short bf16x8 __attribute__((ext_vector_type(8)));
typedef float f32x4 __attribute__((ext_vector_type(4)));
typedef unsigned u32x4 __attribute__((ext_vector_type(4)));
typedef int i32x4 __attribute__((ext_vector_type(4)));
typedef int v8i32 __attribute__((ext_vector_type(8)));
typedef unsigned u32x2 __attribute__((ext_vector_type(2)));
constexpr int BM = 256, BK = 64, HALF = 128, HTB = HALF * BK * 2  , STAGE_BYTES = 8 * HTB, NXCD = 8, WGM = 8;

__host__ __device__ __forceinline__ int lds_byte(int r, int c) { const int st = (r >> 4) * 2 + (c >> 5), rr = r & 15, cc = c & 31, ob = rr * 64 + cc * 2; return st * 1024 + (ob ^ (((ob >> 9) & 1) << 5)); }
__host__ __device__ __forceinline__ void stage_rc(int b, int& R, int& C) { const int st = b / 1024, sb = b % 1024, swz = sb ^ (((sb >> 9) & 1) << 5); R = (st >> 1) * 16 + swz / 64; C = (st & 1) * 32 + (swz % 64) / 2; }
__host__ __device__ __forceinline__ int perm32(int rho) { const int n = rho >> 4, i = rho & 15; return 8 * (i >> 2) + 4 * n + (i & 3); }

struct Unit { int pm, pn, ko; };
struct Gemm { const bf16_t* A; const bf16_t* Bt; int M, N, K; };

struct StaticOrder {
    static constexpr bool SPLITK = false;
    int nM, nN, nwg, G, c;
    __host__ __device__ void init(int M, int N, int G_, int c_) { nM = M / BM; nN = N / BM; nwg = nM * nN; G = G_; c = c_; }
    __host__ __device__ bool next(int i, Unit& u) const {
        const long L = (long)i * G + c; if (L >= nwg) return false;
        int wgid = (int)L; { const int q = nwg / NXCD, r = nwg % NXCD, xcd = wgid % NXCD, off = wgid / NXCD; wgid = (xcd < r ? xcd * (q + 1) : r * (q + 1) + (xcd - r) * q) + off; }
        const int nig = WGM * nN, gid = wgid / nig, fm = gid * WGM, gsz = (nM - fm) < WGM ? (nM - fm) : WGM;
        u.pm = fm + ((wgid % nig) % gsz); u.pn = (wgid % nig) / gsz; return true;
    }
    __device__ __forceinline__ void a_ready(const Unit&) const {}
    __device__ __forceinline__ void done(const Unit&) const {}
};

__device__ __forceinline__ unsigned cvt_pk_bf16(float lo, float hi) { unsigned r; asm volatile("v_cvt_pk_bf16_f32 %0, %1, %2" : "=v"(r) : "v"(lo), "v"(hi)); return r; }

struct EpiBf16 {
    static constexpr bool PERM = true, AFTER_DRAIN = false;
    bf16_t* O; int ldc; int split_cols; size_t split_stride; int tpe;
    __device__ __forceinline__ void operator()(const f32x4 (&acc)[2][2][4][2], const Unit& u, int wr, int wc, int fr, int fq) const {
        const int row0 = u.pm * BM + wr * 64 + fr; int colt = (tpe ? (u.pn % tpe) : u.pn) * BM; bf16_t* base = O;
        if (split_cols) { const int t = colt / split_cols; base += (size_t)t * split_stride; colt -= t * split_cols; }
        const int col0 = colt + wc * 32 + 8 * fq;
#pragma unroll
        for (int ai = 0; ai < 2; ++ai)
#pragma unroll
            for (int m = 0; m < 4; ++m) { bf16_t* rowp = base + (size_t)(row0 + ai * HALF + m * 16) * ldc + col0;
#pragma unroll
                for (int bj = 0; bj < 2; ++bj) { const f32x4 v0 = acc[ai][bj][m][0], v1 = acc[ai][bj][m][1];
                    u32x4 w; w.x = cvt_pk_bf16(v0[0], v0[1]); w.y = cvt_pk_bf16(v0[2], v0[3]); w.z = cvt_pk_bf16(v1[0], v1[1]); w.w = cvt_pk_bf16(v1[2], v1[3]);
                    *(u32x4*)(rowp + bj * HALF) = w; } }
    }
};


struct EpiBf16G {
    static constexpr bool PERM = true, AFTER_DRAIN = false;
    bf16_t* O; int ldc; int tpe;
    __device__ __forceinline__ void operator()(const f32x4 (&acc)[2][2][4][2], const Unit& u, int wr, int wc, int fr, int fq) const {
        const unsigned off0 = (unsigned)(u.pm * BM + wr * 64 + fr) * (unsigned)ldc + (unsigned)((u.pn % tpe) * BM + wc * 32 + 8 * fq);
#pragma unroll
        for (int ai = 0; ai < 2; ++ai)
#pragma unroll
            for (int m = 0; m < 4; ++m)
#pragma unroll
                for (int bj = 0; bj < 2; ++bj) { const f32x4 v0 = acc[ai][bj][m][0], v1 = acc[ai][bj][m][1];
                    u32x4 w; w.x = cvt_pk_bf16(v0[0], v0[1]); w.y = cvt_pk_bf16(v0[2], v0[3]); w.z = cvt_pk_bf16(v1[0], v1[1]); w.w = cvt_pk_bf16(v1[2], v1[3]);
                    *(u32x4*)(O + (off0 + (unsigned)((ai * HALF + m * 16) * ldc + bj * HALF))) = w; }
    }
};
struct EpiQKV {
    static constexpr bool PERM = true, AFTER_DRAIN = false;
    bf16_t* O; const PG8_LAS float* rsl;
    __device__ __forceinline__ void operator()(const f32x4 (&acc)[2][2][4][2], const Unit& u, int wr, int wc, int fr, int fq) const {
        const int t = u.pn >> 2, hp = u.pn & 3; const int m0 = u.pm * BM, b = m0 >> 12, s0 = (m0 & 4095) + wr * 64 + fr;
        const size_t TS = (size_t)16384 * 1024;
        bf16_t* base = O + (size_t)t * TS + wc * 32 + 8 * fq;
#pragma unroll
        for (int ai = 0; ai < 2; ++ai)
#pragma unroll
            for (int m = 0; m < 4; ++m) { const int s = s0 + ai * HALF + m * 16;
                float rs = 1.0f; if (rsl) rs = rsl[wr * 64 + fr + ai * HALF + m * 16];
#pragma unroll
                for (int bj = 0; bj < 2; ++bj) { const f32x4 v0 = acc[ai][bj][m][0] * rs, v1 = acc[ai][bj][m][1] * rs;
                    u32x4 w; w.x = cvt_pk_bf16(v0[0], v0[1]); w.y = cvt_pk_bf16(v0[2], v0[3]); w.z = cvt_pk_bf16(v1[0], v1[1]); w.w = cvt_pk_bf16(v1[2], v1[3]);
                    const size_t hb = (size_t)((b * 8 + 2 * hp + bj) * 4096);
                    *(u32x4*)(base + (hb + s) * 128) = w; } }
    }
};
struct EpiResB {
    static constexpr bool PERM = true, AFTER_DRAIN = false;
    const float* basef; const bf16_t* baseb; bf16_t* out; int ldc; float scale;
    __device__ __forceinline__ void operator()(const f32x4 (&acc)[2][2][4][2], const Unit& u, int wr, int wc, int fr, int fq) const {
        const unsigned off0 = (unsigned)(u.pm * BM + wr * 64 + fr) * (unsigned)ldc + (unsigned)(u.pn * BM + wc * 32 + 8 * fq);
#pragma unroll
        for (int ai = 0; ai < 2; ++ai) {
            f32x4 b0[4][2], b1[4][2];
            if (basef) {
#pragma unroll
                for (int m = 0; m < 4; ++m)
#pragma unroll
                    for (int bj = 0; bj < 2; ++bj) { const unsigned o = off0 + (unsigned)((ai * HALF + m * 16) * ldc + bj * HALF); b0[m][bj] = *(const f32x4*)(basef + o); b1[m][bj] = *(const f32x4*)(basef + o + 4); }
            } else {
                u32x4 w[4][2];
#pragma unroll
                for (int m = 0; m < 4; ++m)
#pragma unroll
                    for (int bj = 0; bj < 2; ++bj) w[m][bj] = *(const u32x4*)(baseb + (off0 + (unsigned)((ai * HALF + m * 16) * ldc + bj * HALF)));
#pragma unroll
                for (int m = 0; m < 4; ++m)
#pragma unroll
                    for (int bj = 0; bj < 2; ++bj) { const u32x4 q = w[m][bj];
                        b0[m][bj] = (f32x4){__builtin_bit_cast(float, q.x << 16), __builtin_bit_cast(float, q.x & 0xffff0000u), __builtin_bit_cast(float, q.y << 16), __builtin_bit_cast(float, q.y & 0xffff0000u)};
                        b1[m][bj] = (f32x4){__builtin_bit_cast(float, q.z << 16), __builtin_bit_cast(float, q.z & 0xffff0000u), __builtin_bit_cast(float, q.w << 16), __builtin_bit_cast(float, q.w & 0xffff0000u)}; }
            }
#pragma unroll
            for (int m = 0; m < 4; ++m)
#pragma unroll
                for (int bj = 0; bj < 2; ++bj) { const f32x4 v0 = b0[m][bj] + acc[ai][bj][m][0] * scale, v1 = b1[m][bj] + acc[ai][bj][m][1] * scale;
                    u32x4 wv; wv.x = cvt_pk_bf16(v0[0], v0[1]); wv.y = cvt_pk_bf16(v0[2], v0[3]); wv.z = cvt_pk_bf16(v1[0], v1[1]); wv.w = cvt_pk_bf16(v1[2], v1[3]);
                    *(u32x4*)(out + (off0 + (unsigned)((ai * HALF + m * 16) * ldc + bj * HALF))) = wv; }
            asm volatile("" ::: "memory");
        }
    }
};
struct EpiResF32 {
    static constexpr bool PERM = false, AFTER_DRAIN = false;
    const float* base; float* out; int ldc; float scale;
    __device__ __forceinline__ void operator()(const f32x4 (&acc)[2][2][4][2], const Unit& u, int wr, int wc, int fr, int fq) const {
        const int row0 = u.pm * BM + wr * 64 + fr, col0 = u.pn * BM + wc * 32 + 4 * fq;
#pragma unroll
        for (int ai = 0; ai < 2; ++ai)
#pragma unroll
            for (int m = 0; m < 4; ++m) { const size_t off = (size_t)(row0 + ai * HALF + m * 16) * ldc + col0;
                f32x4 bs[2][2];
#pragma unroll
                for (int bj = 0; bj < 2; ++bj)
#pragma unroll
                    for (int n = 0; n < 2; ++n) bs[bj][n] = *(const f32x4*)(base + off + bj * HALF + n * 16);
#pragma unroll
                for (int bj = 0; bj < 2; ++bj)
#pragma unroll
                    for (int n = 0; n < 2; ++n) *(f32x4*)(out + off + bj * HALF + n * 16) = bs[bj][n] + acc[ai][bj][m][n] * scale;
                asm volatile("" ::: "memory"); }
    }
};
struct EpiResF32N {
    static constexpr bool PERM = false, AFTER_DRAIN = false;
    const float* base; float* out; int ldc; float scale; const float* gain; bf16_t* Hn; float* part;
    __device__ __forceinline__ void operator()(const f32x4 (&acc)[2][2][4][2], const Unit& u, int wr, int wc, int fr, int fq) const {
        const int row0 = u.pm * BM + wr * 64 + fr, col0 = u.pn * BM + wc * 32 + 4 * fq;
        f32x4 gn[2][2];
#pragma unroll
        for (int bj = 0; bj < 2; ++bj)
#pragma unroll
            for (int n = 0; n < 2; ++n) gn[bj][n] = *(const f32x4*)(gain + col0 + bj * HALF + n * 16);
#pragma unroll
        for (int ai = 0; ai < 2; ++ai)
#pragma unroll
            for (int m = 0; m < 4; ++m) { const int row = row0 + ai * HALF + m * 16; const size_t off = (size_t)row * ldc + col0;
                f32x4 bs[2][2]; float ss = 0.f;
#pragma unroll
                for (int bj = 0; bj < 2; ++bj)
#pragma unroll
                    for (int n = 0; n < 2; ++n) bs[bj][n] = *(const f32x4*)(base + off + bj * HALF + n * 16);
#pragma unroll
                for (int bj = 0; bj < 2; ++bj)
#pragma unroll
                    for (int n = 0; n < 2; ++n) { const f32x4 xn = bs[bj][n] + acc[ai][bj][m][n] * scale; *(f32x4*)(out + off + bj * HALF + n * 16) = xn;
                        ss += xn[0] * xn[0] + xn[1] * xn[1] + xn[2] * xn[2] + xn[3] * xn[3];
                        const f32x4 hg = xn * gn[bj][n]; u32x2 w; w.x = cvt_pk_bf16(hg[0], hg[1]); w.y = cvt_pk_bf16(hg[2], hg[3]);
                        *(u32x2*)(Hn + off + bj * HALF + n * 16) = w; }
                ss += __shfl_xor(ss, 16); ss += __shfl_xor(ss, 32);
                if (fq == 0) part[(size_t)row * 32 + (u.pn * 4 + wc)] = ss;
                asm volatile("" ::: "memory"); }
    }
};
__device__ __forceinline__ float silu_mul(float g, float u) { return g * u * __builtin_amdgcn_rcpf(1.0f + __builtin_amdgcn_exp2f(g * -1.4426950408889634f)); }
struct EpiSwiGLU {
    static constexpr bool PERM = true, AFTER_DRAIN = false;
    bf16_t* O; int ldc; int tpe;
    __device__ __forceinline__ void operator()(const f32x4 (&acc)[2][2][4][2], const Unit& u, int wr, int wc, int fr, int fq) const {
        const int row0 = u.pm * BM + wr * 64 + fr, col0 = (u.pn % tpe) * HALF + wc * 32 + 8 * fq;
#pragma unroll
        for (int ai = 0; ai < 2; ++ai)
#pragma unroll
            for (int m = 0; m < 4; ++m) { bf16_t* rowp = O + (size_t)(row0 + ai * HALF + m * 16) * ldc + col0;
                const f32x4 g0 = acc[ai][0][m][0], g1 = acc[ai][0][m][1], u0 = acc[ai][1][m][0], u1 = acc[ai][1][m][1];
                u32x4 w; w.x = cvt_pk_bf16(silu_mul(g0[0], u0[0]), silu_mul(g0[1], u0[1])); w.y = cvt_pk_bf16(silu_mul(g0[2], u0[2]), silu_mul(g0[3], u0[3]));
                w.z = cvt_pk_bf16(silu_mul(g1[0], u1[0]), silu_mul(g1[1], u1[1])); w.w = cvt_pk_bf16(silu_mul(g1[2], u1[2]), silu_mul(g1[3], u1[3]));
                *(u32x4*)rowp = w; }
    }
};

__device__ __forceinline__ unsigned pk4_fp8(float a, float b, float c, float d) {
    a = __builtin_amdgcn_fmed3f(a, -448.f, 448.f); b = __builtin_amdgcn_fmed3f(b, -448.f, 448.f); c = __builtin_amdgcn_fmed3f(c, -448.f, 448.f); d = __builtin_amdgcn_fmed3f(d, -448.f, 448.f);
    int p = __builtin_amdgcn_cvt_pk_fp8_f32(a, b, 0, false); p = __builtin_amdgcn_cvt_pk_fp8_f32(c, d, p, true); return (unsigned)p;
}
struct EpiSwiGLU8 {
    static constexpr bool PERM = true, AFTER_DRAIN = false;
    unsigned char* O; int ldc; int tpe; float in_scale, out_scale;
    typedef float f32x2 __attribute__((ext_vector_type(2)));
    __device__ __forceinline__ unsigned pk4(const f32x4 g, const f32x4 uu, const f32x2 c1, const f32x2 c2) const {
        const f32x2 ga = {g[0], g[1]}, gb = {g[2], g[3]}, ua = {uu[0], uu[1]}, ub = {uu[2], uu[3]};
        const f32x2 ta = ga * c2, tb = gb * c2;
        f32x2 ea = {__builtin_amdgcn_exp2f(ta[0]), __builtin_amdgcn_exp2f(ta[1])}, eb = {__builtin_amdgcn_exp2f(tb[0]), __builtin_amdgcn_exp2f(tb[1])};
        const f32x2 one = {1.0f, 1.0f};
        ea = ea + one; eb = eb + one;
        const f32x2 ra = {__builtin_amdgcn_rcpf(ea[0]), __builtin_amdgcn_rcpf(ea[1])}, rb = {__builtin_amdgcn_rcpf(eb[0]), __builtin_amdgcn_rcpf(eb[1])};
        const f32x2 qa = (ga * ua) * c1 * ra, qb = (gb * ub) * c1 * rb;
        return pk4_fp8(qa[0], qa[1], qb[0], qb[1]);
    }
    __device__ __forceinline__ void operator()(const f32x4 (&acc)[2][2][4][2], const Unit& u, int wr, int wc, int fr, int fq) const {
        const int row0 = u.pm * BM + wr * 64 + fr, col0 = (u.pn % tpe) * HALF + wc * 32 + 8 * fq;
        const float k1 = in_scale * in_scale * out_scale, k2 = -1.4426950408889634f * in_scale;
        const f32x2 c1 = {k1, k1}, c2 = {k2, k2};
#pragma unroll
        for (int ai = 0; ai < 2; ++ai)
#pragma unroll
            for (int m = 0; m < 4; ++m) { unsigned char* rowp = O + (size_t)(row0 + ai * HALF + m * 16) * ldc + col0;
                u32x2 w; w.x = pk4(acc[ai][0][m][0], acc[ai][1][m][0], c1, c2); w.y = pk4(acc[ai][0][m][1], acc[ai][1][m][1], c1, c2);
                *(u32x2*)rowp = w; }
    }
};
struct GroupedOrder {
    static constexpr bool SPLITK = false;
    int nM, nN, nwg, G, c; int tb[9];
    __device__ __forceinline__ void init(int RT, int nN_, int G_, int c_) { nM = RT; nN = nN_; nwg = nM * nN; G = G_; c = c_; }
    __device__ __forceinline__ bool next(int i, Unit& u) const {
        const long L = (long)i * G + c; if (L >= nwg) return false;
        int wgid = (int)L; { const int q = nwg / NXCD, r = nwg % NXCD, xcd = wgid % NXCD, off = wgid / NXCD; wgid = (xcd < r ? xcd * (q + 1) : r * (q + 1) + (xcd - r) * q) + off; }
        const int nig = WGM * nN, gid = wgid / nig, fm = gid * WGM, gsz = (nM - fm) < WGM ? (nM - fm) : WGM;
        const int pm = fm + ((wgid % nig) % gsz), pn = (wgid % nig) / gsz; int e = 0;
#pragma unroll
        for (int k = 1; k < 8; ++k) e += (pm >= tb[k]) ? 1 : 0;
        u.pm = pm; u.pn = e * nN + pn; return true;
    }
    __device__ __forceinline__ void a_ready(const Unit&) const {}
    __device__ __forceinline__ void done(const Unit&) const {}
};
struct TailOrder {
    static constexpr bool SPLITK = true;
    int nunits, nN, nsl, nt, G, c; int tb[9];
    __device__ __forceinline__ void init(int ntail, int nN_, int nsl_, int nt_, int G_, int c_) { nN = nN_; nsl = nsl_; nt = nt_; nunits = ntail * nN_ * nsl_; G = G_; c = c_; }
    __device__ __forceinline__ bool next(int i, Unit& u) const {
        const int L = i * G + c; if (L >= nunits) return false;
        const int ks = L % nsl, r = L / nsl, pn = r % nN, pm = 128 + r / nN; int e = 0;
#pragma unroll
        for (int k = 1; k < 8; ++k) e += (pm >= tb[k]) ? 1 : 0;
        u.pm = pm; u.pn = e * nN + pn; u.ko = ks * nt * 128; return true;
    }
    __device__ __forceinline__ void a_ready(const Unit&) const {}
    __device__ __forceinline__ void done(const Unit&) const {}
};
struct EpiPartF32 {
    static constexpr bool PERM = true, AFTER_DRAIN = false;
    float* P; int tpe; int slice_bytes; unsigned slice_elems;
    __device__ __forceinline__ void operator()(const f32x4 (&acc)[2][2][4][2], const Unit& u, int wr, int wc, int fr, int fq) const {
        float* const base = P + (size_t)(u.ko / slice_bytes) * slice_elems;
        const unsigned off0 = (unsigned)((u.pm - 128) * BM + wr * 64 + fr) * 2048u + (unsigned)((u.pn % tpe) * BM + wc * 32 + 8 * fq);
#pragma unroll
        for (int ai = 0; ai < 2; ++ai)
#pragma unroll
            for (int m = 0; m < 4; ++m)
#pragma unroll
                for (int bj = 0; bj < 2; ++bj) { f32x4* dst = (f32x4*)(base + (off0 + (unsigned)((ai * HALF + m * 16) * 2048 + bj * HALF)));
                    dst[0] = acc[ai][bj][m][0]; dst[1] = acc[ai][bj][m][1]; }
    }
};
template <class Epi, class Sched, bool ALIGN_EPI = false, bool SP2 = false, bool F8 = false>
__device__ __forceinline__ void gemm_phase(PG8_LAS unsigned char* lds, const Gemm g, const Sched& S, const Epi& E, const int tid) {
    const int wid = __builtin_amdgcn_readfirstlane(tid >> 6), lane = tid & 63, wr = wid >> 2, wc = wid & 3, fr = lane & 15, fq = lane >> 4;
    const int K = g.K; int nt = K / BK; if constexpr (Sched::SPLITK) nt = S.nt;
    unsigned voffA[2], voffB[2];
#pragma unroll
    for (int i = 0; i < 2; ++i) { int R, C; stage_rc(tid * 16 + i * 8192, R, C); const int Rb = Epi::PERM ? ((R & ~31) + perm32(R & 31)) : R;
        voffA[i] = (unsigned)(R * K + C) * 2u; voffB[i] = (unsigned)(Rb * K + C) * 2u; }
    const size_t kstep = (size_t)(BK * 2);
    const size_t hstep = (size_t)HALF * K * 2;
    const size_t tstep = 2 * hstep;
    const unsigned ldsw = (unsigned)wid * 1024u;
    const unsigned ldsb = (unsigned)__builtin_amdgcn_readfirstlane((int)((unsigned)(size_t)lds + ldsw));
    const int aoff = lds_byte(wr * 64 + fr, fq * 8), boff = lds_byte(wc * 32 + fr, fq * 8);
#define PG8_SA(b, h) (((b) * 2 + (h)) * HTB)
#define PG8_SB(b, h) ((4 + (b) * 2 + (h)) * HTB)
#define PG8_STAGE(bufoff, gbase, voff) do { _Pragma("unroll") for (int _i = 0; _i < 2; ++_i) { unsigned _keep; \
        asm volatile("s_mov_b32 %0, m0\n\ts_mov_b32 m0, %3\n\ts_nop 0\n\tglobal_load_lds_dwordx4 %1, %2\n\ts_mov_b32 m0, %0" : "=&s"(_keep) : "v"((voff)[_i]), "s"((const char*)(gbase)), "s"(ldsb + (unsigned)((bufoff) + _i * 8192)) : "memory"); } } while (0)
#define PG8_LDA(dst, b, h) do { _Pragma("unroll") for (int m = 0; m < 4; ++m) _Pragma("unroll") for (int k = 0; k < 2; ++k) dst[m][k] = *(const PG8_LAS bf16x8*)(lds + PG8_SA(b, h) + aoff + m * 2048 + k * 1024); } while (0)
#define PG8_LDB(dst, b, h) do { _Pragma("unroll") for (int n = 0; n < 2; ++n) _Pragma("unroll") for (int k = 0; k < 2; ++k) dst[n][k] = *(const PG8_LAS bf16x8*)(lds + PG8_SB(b, h) + boff + n * 2048 + k * 1024); } while (0)
#define PG8_CAT(x) __builtin_bit_cast(v8i32, __builtin_shufflevector(__builtin_bit_cast(i32x4, (x)[0]), __builtin_bit_cast(i32x4, (x)[1]), 0, 1, 2, 3, 4, 5, 6, 7))
#define PG8_MMA(ai, bj, At, Bt) do { __builtin_amdgcn_s_setprio(1); if constexpr (F8) asm volatile("s_nop 4" ::: "memory"); _Pragma("unroll") for (int m = 0; m < 4; ++m) _Pragma("unroll") for (int n = 0; n < 2; ++n) { \
        if constexpr (F8) { asm volatile("v_mfma_scale_f32_16x16x128_f8f6f4 %0, %1, %2, %0, %3, %3 op_sel_hi:[0,0,0]" : "+v"(acc[ai][bj][m][n]) : "v"(PG8_CAT(Bt[n])), "v"(PG8_CAT(At[m])), "v"(f8sc)); } \
        else { _Pragma("unroll") for (int k = 0; k < 2; ++k) acc[ai][bj][m][n] = __builtin_amdgcn_mfma_f32_16x16x32_bf16(Bt[n][k], At[m][k], acc[ai][bj][m][n], 0, 0, 0); } } __builtin_amdgcn_s_setprio(0); } while (0)
#define PG8_WAIT_V(n) asm volatile("s_waitcnt vmcnt(" #n ")" ::: "memory")
#define PG8_WAIT_L(n) asm volatile("s_waitcnt lgkmcnt(" #n ")" ::: "memory")
#define PG8_BAR __builtin_amdgcn_s_barrier()
#define PG8_SCHED __builtin_amdgcn_sched_barrier(0)
    const int f8sc = 0x7f7f7f7f;
    Unit cur, nxt; int ui = 0;
    if (!S.next(0, cur)) return;
    f32x4 acc[2][2][4][2];
#pragma unroll
    for (int a = 0; a < 2; ++a)
#pragma unroll
        for (int b = 0; b < 2; ++b)
#pragma unroll
            for (int m = 0; m < 4; ++m)
#pragma unroll
                for (int n = 0; n < 2; ++n) acc[a][b][m][n] = (f32x4){0.f, 0.f, 0.f, 0.f};
    bf16x8 At[4][2], B0[2][2], B1[2][2];
    const char* cA = (const char*)g.A + (size_t)cur.pm * tstep; const char* cB = (const char*)g.Bt + (size_t)cur.pn * tstep;
    if constexpr (Sched::SPLITK) { cA += cur.ko; cB += cur.ko; }
    S.a_ready(cur);
    if constexpr (SP2) {
        PG8_STAGE(PG8_SB(0, 0), cB, voffB); PG8_STAGE(PG8_SB(0, 1), cB + hstep, voffB); PG8_STAGE(PG8_SA(0, 0), cA, voffA); PG8_STAGE(PG8_SA(0, 1), cA + hstep, voffA);
        if (wr == 1) PG8_BAR;
        PG8_WAIT_V(2); PG8_BAR;
        PG8_STAGE(PG8_SB(1, 0), cB + kstep, voffB); PG8_STAGE(PG8_SA(1, 0), cA + kstep, voffA); PG8_STAGE(PG8_SB(1, 1), cB + hstep + kstep, voffB);
        PG8_WAIT_V(6); PG8_BAR;
    } else {
        PG8_STAGE(PG8_SB(0, 0), cB, voffB); PG8_STAGE(PG8_SA(0, 0), cA, voffA); PG8_STAGE(PG8_SB(0, 1), cB + hstep, voffB); PG8_STAGE(PG8_SA(0, 1), cA + hstep, voffA);
        if (wr == 1) PG8_BAR;
        PG8_WAIT_V(4); PG8_BAR;
        PG8_STAGE(PG8_SB(1, 0), cB + kstep, voffB); PG8_STAGE(PG8_SA(1, 0), cA + kstep, voffA); PG8_STAGE(PG8_SB(1, 1), cB + hstep + kstep, voffB);
        PG8_WAIT_V(6); PG8_BAR;
    }
    for (;;) {
        const bool has_next = S.next(ui + 1, nxt);
        const char* nA = has_next ? (const char*)g.A + (size_t)nxt.pm * tstep + (Sched::SPLITK ? nxt.ko : 0) : cA; const char* nB = has_next ? (const char*)g.Bt + (size_t)nxt.pn * tstep + (Sched::SPLITK ? nxt.ko : 0) : cB;
        for (int t = 0; t < nt; t += 2) {
            const bool last = (t == nt - 2);
            const char* a1 = cA + (size_t)(t + 1) * kstep;
            const char* a2 = last ? nA : cA + (size_t)(t + 2) * kstep; const char* b2 = last ? nB : cB + (size_t)(t + 2) * kstep;
            const char* a3 = a2 + kstep; const char* b3 = b2 + kstep;
            if (last && has_next) S.a_ready(nxt);
            if constexpr (SP2) {
            PG8_LDB(B0, 0, 0); PG8_LDB(B1, 0, 1); PG8_SCHED; PG8_LDA(At, 0, 0); PG8_STAGE(PG8_SA(1, 1), a1 + hstep, voffA);
            PG8_WAIT_V(8); PG8_WAIT_L(0); PG8_BAR; PG8_MMA(0, 0, At, B0); PG8_MMA(0, 1, At, B1); PG8_BAR; PG8_SCHED;
            PG8_LDA(At, 0, 1); PG8_STAGE(PG8_SB(0, 0), b2, voffB); PG8_STAGE(PG8_SB(0, 1), b2 + hstep, voffB); PG8_STAGE(PG8_SA(0, 0), a2, voffA);
            PG8_WAIT_V(8); PG8_WAIT_L(0); PG8_BAR; PG8_MMA(1, 0, At, B0); PG8_MMA(1, 1, At, B1); PG8_BAR; PG8_SCHED;
            PG8_LDB(B0, 1, 0); PG8_LDB(B1, 1, 1); PG8_SCHED; PG8_LDA(At, 1, 0); PG8_STAGE(PG8_SA(0, 1), a2 + hstep, voffA);
            PG8_WAIT_V(8); PG8_WAIT_L(0); PG8_BAR; PG8_MMA(0, 0, At, B0); PG8_MMA(0, 1, At, B1); PG8_BAR; PG8_SCHED;
            PG8_LDA(At, 1, 1); PG8_STAGE(PG8_SB(1, 0), b3, voffB); PG8_STAGE(PG8_SB(1, 1), b3 + hstep, voffB); PG8_STAGE(PG8_SA(1, 0), a3, voffA);
            PG8_WAIT_V(8); PG8_WAIT_L(0); PG8_BAR; PG8_MMA(1, 0, At, B0); PG8_MMA(1, 1, At, B1); PG8_BAR; PG8_SCHED;
            } else {
            PG8_LDB(B0, 0, 0); PG8_SCHED; PG8_LDA(At, 0, 0); PG8_STAGE(PG8_SA(1, 1), a1 + hstep, voffA);
            PG8_WAIT_L(8); PG8_BAR; PG8_WAIT_L(0); PG8_MMA(0, 0, At, B0); PG8_BAR; PG8_SCHED;
            PG8_LDB(B1, 0, 1); PG8_STAGE(PG8_SB(0, 0), b2, voffB);
            PG8_BAR; PG8_WAIT_L(0); PG8_MMA(0, 1, At, B1); PG8_BAR;
            PG8_LDA(At, 0, 1); PG8_STAGE(PG8_SA(0, 0), a2, voffA);
            PG8_BAR; PG8_WAIT_L(0); PG8_MMA(1, 0, At, B0); PG8_BAR; PG8_SCHED;
            PG8_STAGE(PG8_SB(0, 1), b2 + hstep, voffB);
            PG8_WAIT_V(6); PG8_BAR; PG8_MMA(1, 1, At, B1); PG8_BAR;
            PG8_LDB(B0, 1, 0); PG8_SCHED; PG8_LDA(At, 1, 0); PG8_STAGE(PG8_SA(0, 1), a2 + hstep, voffA);
            PG8_WAIT_L(8); PG8_BAR; PG8_WAIT_L(0); PG8_MMA(0, 0, At, B0); PG8_BAR; PG8_SCHED;
            PG8_LDB(B1, 1, 1); PG8_STAGE(PG8_SB(1, 0), b3, voffB);
            PG8_BAR; PG8_WAIT_L(0); PG8_MMA(0, 1, At, B1); PG8_BAR;
            PG8_LDA(At, 1, 1); PG8_STAGE(PG8_SA(1, 0), a3, voffA);
            PG8_BAR; PG8_WAIT_L(0); PG8_MMA(1, 0, At, B0); PG8_BAR; PG8_SCHED;
            PG8_STAGE(PG8_SB(1, 1), b3 + hstep, voffB);
            PG8_WAIT_V(6); PG8_BAR; PG8_MMA(1, 1, At, B1); PG8_BAR;
            }
        }
        if constexpr (ALIGN_EPI) { if (wr == 0) PG8_BAR; }
        if constexpr (F8) asm volatile("s_nop 15\n\ts_nop 15" ::: "memory");
        if constexpr (!Epi::AFTER_DRAIN) { E(acc, cur, wr, wc, fr, fq); S.done(cur); }
        if (!has_next) break;
#pragma unroll
        for (int a = 0; a < 2; ++a)
#pragma unroll
            for (int b = 0; b < 2; ++b)
#pragma unroll
                for (int m = 0; m < 4; ++m)
#pragma unroll
                    for (int n = 0; n < 2; ++n) acc[a][b][m][n] = (f32x4){0.f, 0.f, 0.f, 0.f};
        cur = nxt; cA = nA; cB = nB; ++ui;
        if constexpr (ALIGN_EPI) { if (wr == 1) PG8_BAR; }
    }
    PG8_WAIT_V(0);
    if constexpr (!ALIGN_EPI) { if (wr == 0) PG8_BAR; }
    PG8_BAR;
    if constexpr (Epi::AFTER_DRAIN) { E.fused(acc, cur, wr, wc, fr, fq, lds, wid, lane); S.done(cur); }
#undef PG8_SA
#undef PG8_SB
#undef PG8_STAGE
#undef PG8_LDA
#undef PG8_LDB
#undef PG8_MMA
#undef PG8_CAT
#undef PG8_WAIT_V
#undef PG8_WAIT_L
#undef PG8_BAR
#undef PG8_SCHED
}
}

#define GAS __attribute__((address_space(1)))
#define LAS __attribute__((address_space(3)))
typedef unsigned short bf16_t;
typedef short bf16x8 __attribute__((ext_vector_type(8)));
typedef short s16x4 __attribute__((ext_vector_type(4)));
typedef float f32x4 __attribute__((ext_vector_type(4)));
typedef float f32x16 __attribute__((ext_vector_type(16)));
typedef unsigned u32x4 __attribute__((ext_vector_type(4)));
typedef unsigned u32x2 __attribute__((ext_vector_type(2)));
#define LDS_WAIT() asm volatile("s_waitcnt lgkmcnt(0)" ::: "memory")
#define VM_WAIT() asm volatile("s_waitcnt vmcnt(0)" ::: "memory")
#define SBAR() __builtin_amdgcn_sched_barrier(0)

constexpr int BATCH = 4, SEQ = 4096, T = BATCH * SEQ, D = 2048, NH = 8, HD = 128, DH = NH * HD  , DQKV = 6144;
constexpr int DFF = 5504, DFFP = 5632  , DFE = 7168, NE = 8, MOE_ROWS = 2 * T + NE * 256;
#ifndef DENSE_F8
#define DENSE_F8 1
#endif
constexpr float EPS = 1e-6f;
constexpr int NWAVES = 8, NTHREADS = 512;
constexpr float LOG2E = 1.4426950408889634f, LN2 = 0.6931471805599453f;
constexpr float QSCALE = 0.08838834764831845f;
constexpr float F8_SH = 16.f, F8_SW = 512.f, F8_SACT = 8.f;

constexpr size_t MiB = 1u << 20;
constexpr size_t WS_CTL = 0, CTL_ZERO_BYTES = 1 * MiB;
constexpr size_t WS_BKT = 1 * MiB;
constexpr size_t WS_SEL = 2 * MiB;
constexpr size_t WS_GW = WS_SEL + 256 * 1024;
constexpr size_t WS_POS = WS_GW + 256 * 1024;
constexpr size_t WS_HIST = WS_POS + 256 * 1024;
constexpr size_t WS_MOEINFO = WS_HIST + 64 * 1024;
constexpr size_t WS_LSE = 3 * MiB;
constexpr size_t WS_WI = 8 * MiB;
constexpr size_t WS_WO = WS_WI + 2 * (size_t)DQKV * D * 2;
constexpr size_t WS_WGU_D = WS_WO + 2 * (size_t)D * D * 2;
constexpr size_t WS_WD_D = WS_WGU_D + (size_t)2 * DFF * D * 2;
constexpr size_t WS_WGU_M = WS_WD_D + (size_t)D * DFF * 2 + 512 * 1024;
constexpr size_t WS_WD_M = WS_WGU_M + (size_t)NE * 2 * DFE * D;
constexpr size_t WS_X = WS_WD_M + (size_t)NE * D * DFE;
constexpr size_t WS_H = WS_X + (size_t)T * D * 4;
constexpr size_t WS_R = WS_H + (size_t)T * D * 2;
constexpr size_t WS_QKV = WS_R;
constexpr size_t WS_OD = WS_QKV + (size_t)6 * T * DH * 2;
constexpr size_t WS_OS = WS_OD + (size_t)3 * T * DH * 2;
constexpr size_t WS_O = WS_OS + (size_t)T * DH * 2;
constexpr size_t WS_ACT = WS_R;
constexpr size_t WS_AS = WS_R + (size_t)MOE_ROWS * D * 2;
constexpr size_t WS_ACTM = WS_AS + (size_t)MOE_ROWS * D;
constexpr size_t WS_Y = WS_R;
constexpr int TAIL_T0 = 128, TAIL_MAXT = 7, TAIL_SL = 7, TAIL_NT = 8;
constexpr size_t WS_YP = WS_ACTM + (size_t)MOE_ROWS * DFE;
constexpr size_t WS_PART = WS_YP + (size_t)TAIL_SL * TAIL_MAXT * 256 * D * 4;
constexpr size_t WS_END_MOE = WS_PART + (size_t)T * 32 * 4, WS_END_ATT = WS_O + (size_t)T * D * 2, WS_END = WS_END_MOE > WS_END_ATT ? WS_END_MOE : WS_END_ATT;
static_assert(WS_ACT + (size_t)T * DFF * 2 <= WS_END, "region R");
static_assert(WS_END <= 1879048192ull, "workspace");
static_assert(TAIL_SL * TAIL_NT * 128 == DFE && WS_YP % 256 == 0, "split-K tail");
static_assert(WS_WI % 256 == 0 && WS_WO % 256 == 0 && WS_WGU_D % 256 == 0 && WS_WD_D % 256 == 0 && WS_WGU_M % 256 == 0 && WS_WD_M % 256 == 0 && WS_X % 256 == 0 && WS_H % 256 == 0 && WS_R % 256 == 0 && WS_ACTM % 256 == 0, "alignment");
constexpr int CW_AQ = 20480;
constexpr int CW_TAIL = 16384;
constexpr int CW_BAR = 4096;

constexpr int WSCR = 16896;
constexpr int SCR_BYTES = 8 * WSCR;
constexpr int TBL_OFF = SCR_BYTES, TBL_N = 200, TBL_BYTES = 3 * NH * TBL_N * 4;
constexpr int MISC_OFF = 154624;
constexpr int LDS_BYTES = 157696;
static_assert(TBL_OFF + TBL_BYTES <= MISC_OFF && MISC_OFF + 3072 <= LDS_BYTES, "LDS map");

#define XB_TMO      128
#define XB_XCNT(j)  (256  + 64 * (j))
#define XB_XSUB(j)  (1280 + 64 * (j))
#define XB_XGEN(j)  (2304 + 64 * (j))
#define XB_TOP      3328
#define XB_TOPGEN   3392
#define XCD_BAR_WORDS 3456
#define XB_SPIN_CAP (1u << 20)
__device__ __forceinline__ unsigned xb_ld(unsigned* p)              { return __hip_atomic_load(p, __ATOMIC_RELAXED, __HIP_MEMORY_SCOPE_AGENT); }
__device__ __forceinline__ unsigned xb_add(unsigned* p, unsigned v) { return __hip_atomic_fetch_add(p, v, __ATOMIC_RELAXED, __HIP_MEMORY_SCOPE_AGENT); }
__device__ __forceinline__ unsigned xb_xcc_id() { return (unsigned)__builtin_amdgcn_s_getreg((3 << 11) | 20) & 0xFu; }
#define XB_SPIN(cond, bar) do { unsigned _sp = 0; while (cond) { __builtin_amdgcn_s_sleep(1); \
    if ((++_sp & 255u) == 0u) { if (xb_ld(&(bar)[XB_TMO])) break; if (_sp > XB_SPIN_CAP) { atomicAdd(&(bar)[XB_TMO], 1u); break; } } } } while (0)
struct XcdBarrier { unsigned* bar; unsigned x; volatile LAS unsigned* st; };
__device__ __forceinline__ XcdBarrier xcd_barrier_post(unsigned* bar, volatile LAS unsigned* st) {
    XcdBarrier b; b.bar = bar; b.x = xb_xcc_id(); b.st = st;
    if (threadIdx.x == 0) (void)xb_add(&bar[XB_XCNT(b.x)], 1u);
    return b;
}
__device__ __forceinline__ void xcd_barrier_complete(unsigned* bar, unsigned x, unsigned& nloc, unsigned& nx) {
    const unsigned G = gridDim.x * gridDim.y * gridDim.z;
    unsigned sum, cnt, mine, sp = 0u;
    for (;;) {
        sum = 0u; cnt = 0u; mine = 0u;
#pragma unroll
        for (unsigned j = 0; j < 16; ++j) { const unsigned c = xb_ld(&bar[XB_XCNT(j)]); sum += c; cnt += (c > 0u) ? 1u : 0u; mine = (j == x) ? c : mine; }
        if (sum == G) break;
        __builtin_amdgcn_s_sleep(1);
        if ((++sp & 255u) == 0u) { if (xb_ld(&bar[XB_TMO])) break; if (sp > XB_SPIN_CAP) { atomicAdd(&bar[XB_TMO], 1u); break; } }
    }
    nloc = mine > 0u ? mine : 1u; nx = cnt > 0u ? cnt : 1u;
}
__device__ __forceinline__ void xcd_barrier(const XcdBarrier& b) {
    asm volatile("s_waitcnt vmcnt(0)" ::: "memory");
    __syncthreads();
    if (threadIdx.x == 0) {
        unsigned* bar = b.bar;
        __builtin_amdgcn_s_waitcnt(0);
        unsigned nloc = b.st[0], nx = b.st[1];
        if (nloc == 0u) { xcd_barrier_complete(bar, b.x, nloc, nx); b.st[0] = nloc; b.st[1] = nx; }
        const unsigned old = xb_add(&bar[XB_XSUB(b.x)], 1u);
        const unsigned gen = old / nloc;
        if (old + 1u == (gen + 1u) * nloc) {
            __builtin_amdgcn_fence(__ATOMIC_RELEASE, "agent");
            asm volatile("s_waitcnt vmcnt(0)" ::: "memory");
            const unsigned og = xb_add(&bar[XB_TOP], 1u);
            const unsigned tg = og / nx;
            if (og + 1u == (tg + 1u) * nx) xb_add(&bar[XB_TOPGEN], 1u);
            else XB_SPIN(xb_ld(&bar[XB_TOPGEN]) == tg, bar);
            __builtin_amdgcn_fence(__ATOMIC_ACQUIRE, "agent");
            xb_add(&bar[XB_XGEN(b.x)], 1u);
            asm volatile("s_waitcnt vmcnt(0)" ::: "memory");
        } else {
            XB_SPIN(xb_ld(&bar[XB_XGEN(b.x)]) == gen, bar);
            __builtin_amdgcn_fence(__ATOMIC_ACQUIRE, "agent");
            asm volatile("s_waitcnt vmcnt(0)" ::: "memory");
        }
#if defined(PHTIME)
        if (blockIdx.x == 0) { const unsigned s_ = b.st[2]; b.st[2] = s_ + 1u; bar[(12290 - CW_BAR) + s_] = (unsigned)__builtin_amdgcn_s_memrealtime(); }
#endif
    }
    __syncthreads();
}

__device__ __forceinline__ unsigned pk2(float lo, float hi) { unsigned r; asm volatile("v_cvt_pk_bf16_f32 %0, %1, %2" : "=v"(r) : "v"(lo), "v"(hi)); return r; }
__device__ __forceinline__ float bf_lo(unsigned w) { return __builtin_bit_cast(float, w << 16); }
__device__ __forceinline__ float bf_hi(unsigned w) { return __builtin_bit_cast(float, w & 0xffff0000u); }
__device__ __forceinline__ float wave_sum(float v) {
#pragma unroll
    for (int o = 1; o < 64; o <<= 1) v += __shfl_xor(v, o);
    return v;
}
__device__ __forceinline__ float dot4(f32x4 a) { return (a.x * a.x + a.y * a.y) + (a.z * a.z + a.w * a.w); }

struct Frame {
    LAS unsigned char* lds; volatile LAS unsigned* MISC;
    int tid, lane, wave, gw, G;
};

__device__ __forceinline__ void tr_item(const float* __restrict__ W, int K, int N, bf16_t* __restrict__ WT, int mode, LAS float* scr, int item, int lane) {
    const int nblk = N >> 6, kb = item / nblk, nb = item - kb * nblk, k0 = kb << 6, n0 = nb << 6;
    f32x4 v[16];
    const float* src = W + (size_t)(k0 + (lane >> 4)) * N + n0 + 4 * (lane & 15);
#pragma unroll
    for (int i = 0; i < 16; ++i) v[i] = __builtin_nontemporal_load((const f32x4*)(src + (size_t)(4 * i) * N));
#pragma unroll
    for (int i = 0; i < 16; ++i) { LAS float* d = scr + (4 * i + (lane >> 4)) * 65 + 4 * (lane & 15); d[0] = v[i][0]; d[1] = v[i][1]; d[2] = v[i][2]; d[3] = v[i][3]; }
    LDS_WAIT();
    const int c = lane & 7;
#pragma unroll
    for (int p = 0; p < 8; ++p) { const int n = (lane >> 3) + 8 * p; const LAS float* s = scr + (8 * c) * 65 + n;
        u32x4 o; o.x = pk2(s[0], s[65]); o.y = pk2(s[130], s[195]); o.z = pk2(s[260], s[325]); o.w = pk2(s[390], s[455]);
        const int nn = n0 + n; const int row = mode == 0 ? nn : (((nn >> 7) << 8) + (nn & 127) + (mode == 2 ? 128 : 0));
        *(u32x4*)(WT + (size_t)row * K + k0 + 8 * c) = o; }
    LDS_WAIT();
}
__device__ __forceinline__ void tr_item8(const float* __restrict__ W, int K, int N, unsigned char* __restrict__ WT, int ldk, int mode, LAS float* scr, int item, int lane) {
    const int nblk = N >> 6, kb = item / nblk, nb = item - kb * nblk, k0 = kb << 6, n0 = nb << 6;
    f32x4 v[16];
    const float* src = W + (size_t)(k0 + (lane >> 4)) * N + n0 + 4 * (lane & 15);
#pragma unroll
    for (int i = 0; i < 16; ++i) v[i] = __builtin_nontemporal_load((const f32x4*)(src + (size_t)(4 * i) * N));
#pragma unroll
    for (int i = 0; i < 16; ++i) { LAS float* d = scr + (4 * i + (lane >> 4)) * 65 + 4 * (lane & 15); d[0] = v[i][0]; d[1] = v[i][1]; d[2] = v[i][2]; d[3] = v[i][3]; }
    LDS_WAIT();
    const int c = lane & 7;
#pragma unroll
    for (int p = 0; p < 8; ++p) { const int n = (lane >> 3) + 8 * p; const LAS float* s = scr + (8 * c) * 65 + n;
        u32x2 o; o.x = pg8::pk4_fp8(s[0] * F8_SW, s[65] * F8_SW, s[130] * F8_SW, s[195] * F8_SW); o.y = pg8::pk4_fp8(s[260] * F8_SW, s[325] * F8_SW, s[390] * F8_SW, s[455] * F8_SW);
        const int nn = n0 + n; const int row = mode == 0 ? nn : (((nn >> 7) << 8) + (nn & 127) + (mode == 2 ? 128 : 0));
        *(u32x2*)(WT + (size_t)row * ldk + k0 + 8 * c) = o; }
    LDS_WAIT();
}

struct ConvDesc { const float* W; unsigned char* WT; int K, N, mode, f8, item, ldk; };
__device__ __forceinline__ void tr_load(const ConvDesc& d, f32x4 (&v)[16], int lane) {
    if (d.f8) {
        const int nblk = d.N >> 5, kb = d.item / nblk, nb = d.item - kb * nblk, k0 = kb << 7, n0 = nb << 5;
        const unsigned voff = (unsigned)(((lane >> 3) * d.N + 4 * (lane & 7)) * 4);
        const char* ub = (const char*)(d.W + (size_t)k0 * d.N + n0);
#pragma unroll
        for (int i = 0; i < 16; ++i) v[i] = __builtin_nontemporal_load((const f32x4*)(ub + (size_t)(8 * i) * d.N * 4 + voff));
    } else {
        const int nblk = d.N >> 6, kb = d.item / nblk, nb = d.item - kb * nblk, k0 = kb << 6, n0 = nb << 6;
        const unsigned voff = (unsigned)(((lane >> 4) * d.N + 4 * (lane & 15)) * 4);
        const char* ub = (const char*)(d.W + (size_t)k0 * d.N + n0);
#pragma unroll
        for (int i = 0; i < 16; ++i) v[i] = __builtin_nontemporal_load((const f32x4*)(ub + (size_t)(4 * i) * d.N * 4 + voff));
    }
}
__device__ __forceinline__ void tr_finish(const ConvDesc& d, const f32x4 (&v)[16], LAS float* scr, int lane) {
    if (d.f8) {
        const int nblk = d.N >> 5, kb = d.item / nblk, nb = d.item - kb * nblk, k0 = kb << 7, n0 = nb << 5;
#pragma unroll
        for (int i = 0; i < 16; ++i) { LAS float* q = scr + (8 * i + (lane >> 3)) * 33 + 4 * (lane & 7); q[0] = v[i][0]; q[1] = v[i][1]; q[2] = v[i][2]; q[3] = v[i][3]; }
        LDS_WAIT();
        const int c = lane & 7;
#pragma unroll
        for (int p = 0; p < 4; ++p) { const int n = (lane >> 3) + 8 * p; const LAS float* s = scr + (16 * c) * 33 + n;
            const int nn = n0 + n; const int row = d.mode == 0 ? nn : (((nn >> 7) << 8) + (nn & 127) + (d.mode == 2 ? 128 : 0));
            u32x4 o; o.x = pg8::pk4_fp8(s[0] * F8_SW, s[33] * F8_SW, s[66] * F8_SW, s[99] * F8_SW); o.y = pg8::pk4_fp8(s[132] * F8_SW, s[165] * F8_SW, s[198] * F8_SW, s[231] * F8_SW);
            o.z = pg8::pk4_fp8(s[264] * F8_SW, s[297] * F8_SW, s[330] * F8_SW, s[363] * F8_SW); o.w = pg8::pk4_fp8(s[396] * F8_SW, s[429] * F8_SW, s[462] * F8_SW, s[495] * F8_SW);
            __builtin_nontemporal_store(o, (u32x4*)(d.WT + (size_t)row * d.ldk + k0 + 16 * c)); }
        LDS_WAIT();
    } else {
        const int nblk = d.N >> 6, kb = d.item / nblk, nb = d.item - kb * nblk, k0 = kb << 6, n0 = nb << 6;
#pragma unroll
        for (int i = 0; i < 16; ++i) { LAS float* q = scr + (4 * i + (lane >> 4)) * 65 + 4 * (lane & 15); q[0] = v[i][0]; q[1] = v[i][1]; q[2] = v[i][2]; q[3] = v[i][3]; }
        LDS_WAIT();
        const int c = lane & 7;
#pragma unroll
        for (int p = 0; p < 8; ++p) { const int n = (lane >> 3) + 8 * p; const LAS float* s = scr + (8 * c) * 65 + n;
            const int nn = n0 + n; const int row = d.mode == 0 ? nn : (((nn >> 7) << 8) + (nn & 127) + (d.mode == 2 ? 128 : 0));
            u32x4 o; o.x = pk2(s[0], s[65]); o.y = pk2(s[130], s[195]); o.z = pk2(s[260], s[325]); o.w = pk2(s[390], s[455]);
            __builtin_nontemporal_store(o, (u32x4*)(d.WT + ((size_t)row * d.ldk + k0 + 8 * c) * 2)); }
        LDS_WAIT();
    }
}
__device__ __forceinline__ void rms_row_bf16(const float* xrow, const float* g, bf16_t* orow, int lane) {
    const f32x4* xr = (const f32x4*)xrow + lane; const f32x4* gr = (const f32x4*)g + lane;
    f32x4 v[8]; float ss = 0.f;
#pragma unroll
    for (int j = 0; j < 8; ++j) { v[j] = xr[64 * j]; ss += dot4(v[j]); }
    const float rstd = 1.0f / sqrtf(wave_sum(ss) * (1.0f / D) + EPS);
    u32x2* o8 = (u32x2*)orow + lane;
#pragma unroll
    for (int j = 0; j < 8; ++j) { const f32x4 gg = gr[64 * j]; u32x2 w; w.x = pk2(v[j].x * rstd * gg.x, v[j].y * rstd * gg.y); w.y = pk2(v[j].z * rstd * gg.z, v[j].w * rstd * gg.w); o8[64 * j] = w; }
}
__device__ __forceinline__ f32x4 ldxb(const bf16_t* xrow, int lane, int j) { const u32x2 w = ((const u32x2*)xrow)[lane + 64 * j]; return (f32x4){bf_lo(w.x), bf_hi(w.x), bf_lo(w.y), bf_hi(w.y)}; }
__device__ __forceinline__ void rms_row_b2b(const bf16_t* xrow, const float* g, bf16_t* orow, int lane) {
    const f32x4* gr = (const f32x4*)g + lane;
    f32x4 v[8]; float ss = 0.f;
#pragma unroll
    for (int j = 0; j < 8; ++j) { v[j] = ldxb(xrow, lane, j); ss += dot4(v[j]); }
    const float rstd = 1.0f / sqrtf(wave_sum(ss) * (1.0f / D) + EPS);
    u32x2* o8 = (u32x2*)orow + lane;
#pragma unroll
    for (int j = 0; j < 8; ++j) { const f32x4 gg = gr[64 * j]; u32x2 w; w.x = pk2(v[j].x * rstd * gg.x, v[j].y * rstd * gg.y); w.y = pk2(v[j].z * rstd * gg.z, v[j].w * rstd * gg.w); o8[64 * j] = w; }
}
__device__ __forceinline__ void rms_rows_b2b(const bf16_t* X, const float* g, bf16_t* H, int gw, int ngw, int lane) {
    f32x4 gq[8];
#pragma unroll
    for (int q = 0; q < 8; ++q) gq[q] = ((const f32x4*)g)[lane + 64 * q];
    for (int m0 = gw; m0 < T; m0 += 4 * ngw) {
        u32x2 raw[4][8];
#pragma unroll
        for (int r = 0; r < 4; ++r)
#pragma unroll
            for (int q = 0; q < 8; ++q) raw[r][q] = ((const u32x2*)(X + (size_t)(m0 + r * ngw) * D))[lane + 64 * q];
#pragma unroll
        for (int r = 0; r < 4; ++r) {
            f32x4 v[8]; float ss = 0.f;
#pragma unroll
            for (int q = 0; q < 8; ++q) { v[q] = (f32x4){bf_lo(raw[r][q].x), bf_hi(raw[r][q].x), bf_lo(raw[r][q].y), bf_hi(raw[r][q].y)}; ss += dot4(v[q]); }
            const float rstd = 1.0f / sqrtf(wave_sum(ss) * (1.0f / D) + EPS);
            u32x2* o8 = (u32x2*)(H + (size_t)(m0 + r * ngw) * D) + lane;
#pragma unroll
            for (int q = 0; q < 8; ++q) { u32x2 w; w.x = pk2(v[q].x * rstd * gq[q].x, v[q].y * rstd * gq[q].y); w.y = pk2(v[q].z * rstd * gq[q].z, v[q].w * rstd * gq[q].w); o8[64 * q] = w; }
        }
    }
}
__device__ __forceinline__ void rms_rows_f2b(const float* X, const float* g, bf16_t* H, int gw, int ngw, int lane) {
    f32x4 gq[8];
#pragma unroll
    for (int q = 0; q < 8; ++q) gq[q] = ((const f32x4*)g)[lane + 64 * q];
    for (int m0 = gw; m0 < T; m0 += 4 * ngw) {
        f32x4 v[4][8];
#pragma unroll
        for (int r = 0; r < 4; ++r)
#pragma unroll
            for (int q = 0; q < 8; ++q) v[r][q] = ((const f32x4*)(X + (size_t)(m0 + r * ngw) * D))[lane + 64 * q];
#pragma unroll
        for (int r = 0; r < 4; ++r) {
            float ss = 0.f;
#pragma unroll
            for (int q = 0; q < 8; ++q) ss += dot4(v[r][q]);
            const float rstd = 1.0f / sqrtf(wave_sum(ss) * (1.0f / D) + EPS);
            u32x2* o8 = (u32x2*)(H + (size_t)(m0 + r * ngw) * D) + lane;
#pragma unroll
            for (int q = 0; q < 8; ++q) { u32x2 w; w.x = pk2(v[r][q].x * rstd * gq[q].x, v[r][q].y * rstd * gq[q].y); w.y = pk2(v[r][q].z * rstd * gq[q].z, v[r][q].w * rstd * gq[q].w); o8[64 * q] = w; }
        }
    }
}
__device__ __forceinline__ int t5_bucket(int n) {
    if (n < 16) return n;
    int b = 16 + (int)(log((double)n / 16.0) / log(128.0) * 16.0);
    return b < 31 ? b : 31;
}

__device__ __forceinline__ void dma_tile_k(const bf16_t* base, size_t row_stride_bytes, LAS unsigned char* dst, const unsigned (&voff)[4]) {
#pragma unroll
    for (int i = 0; i < 8; ++i) {
        const char* ub = (const char*)base + (size_t)(4 * i) * row_stride_bytes;
        __builtin_amdgcn_global_load_lds((const unsigned*)(ub + voff[i & 3]), (LAS unsigned*)(dst + i * 1024), 16, 0, 0);
    }
}
__device__ __forceinline__ void dma_tile_v(const bf16_t* base, size_t row_stride_bytes, LAS unsigned char* dst, unsigned voff) {
#pragma unroll
    for (int i = 0; i < 8; ++i) {
        const char* ub = (const char*)base + (size_t)(4 * i) * row_stride_bytes;
        __builtin_amdgcn_global_load_lds((const unsigned*)(ub + voff), (LAS unsigned*)(dst + i * 1024), 16, 0, 0);
    }
}
#define TRRD(dst, addr, off) asm volatile("ds_read_b64_tr_b16 %0, %1 offset:%2" : "=&v"(dst) : "v"(addr), "i"(off) : "memory")

template <int MODE>
__device__ __forceinline__ void attn_item(LAS unsigned char* wl, const bf16_t* Qh, int qstride, const bf16_t* Kh, const bf16_t* Vh, bf16_t* Op, int ostride, float* lsep, int lstride,
                                          const LAS float* tb, int qg, int lane) {
    const int c = lane & 31, hi = lane >> 5;
    const int i0 = 32 * qg;
    const size_t rstride = (size_t)qstride;
    bf16x8 qf[8];
    { const bf16_t* qrow = Qh + (size_t)(i0 + c) * qstride + 8 * hi;
#pragma unroll
      for (int s = 0; s < 8; ++s) qf[s] = *(const bf16x8*)(qrow + 16 * s); }
    f32x16 o[4];
#pragma unroll
    for (int b = 0; b < 4; ++b)
#pragma unroll
        for (int r = 0; r < 16; ++r) o[b][r] = 0.f;
    float mx = -1e30f, lsum = 0.f, carry = 0.f;
    const int kt_first = MODE == 0 ? (qg > 4 ? qg - 4 : 0) : qg, kt_last = MODE == 0 ? qg : 0, kstep = MODE == 0 ? 1 : -1;
    LAS unsigned char* Kl = wl; LAS unsigned char* Vl = wl + 8192;
    const LAS unsigned char* kbase = Kl + c * 256;
    unsigned vb[4];
    { const int g = lane >> 4, q = (lane & 15) >> 2, p = lane & 3, h = g >> 1;
#pragma unroll
      for (int b = 0; b < 4; ++b) vb[b] = (unsigned)(uintptr_t)Vl + (4 * h + q) * 256 + (((4 * b + 2 * (g & 1) + (p >> 1)) ^ (q << 2)) << 4) + 8 * (p & 1); }
    unsigned voffk[4], voffv;
    { const int rr = lane >> 4, p = lane & 15;
#pragma unroll
      for (int i = 0; i < 4; ++i) voffk[i] = (unsigned)(rr * (int)rstride * 2 + ((p ^ ((4 * i + rr) & 15)) << 4));
      voffv = (unsigned)(rr * (int)rstride * 2 + ((p ^ (rr << 2)) << 4)); }
    dma_tile_k(Kh + (size_t)(32 * kt_first) * rstride, rstride * 2, Kl, voffk);
    dma_tile_v(Vh + (size_t)(32 * kt_first) * rstride, rstride * 2, Vl, voffv);
    bool early = false;
    for (int kt = kt_first;; kt += kstep) {
        const bool has_next = (kt != kt_last);
        const int j0 = 32 * kt;
        asm volatile("s_waitcnt vmcnt(8)" ::: "memory");
        f32x16 S;
#pragma unroll
        for (int r = 0; r < 16; ++r) S[r] = 0.f;
#pragma unroll
        for (int s = 0; s < 8; ++s) {
            const bf16x8 kf = *(const LAS bf16x8*)(kbase + ((((2 * s + hi) ^ (c & 15))) << 4));
            S = __builtin_amdgcn_mfma_f32_32x32x16_bf16(kf, qf[s], S, 0, 0, 0);
        }
        asm volatile("" ::: "memory");
        if (has_next) dma_tile_k(Kh + (size_t)(j0 + 32 * kstep) * rstride, rstride * 2, Kl, voffk);
        bf16x8 pb[2];
        if constexpr (MODE == 0) {
            const int a = 160 - (i0 - j0) - c + 4 * hi;
            const LAS float* tp = tb + a;
            float x[16]; float pm = -3e38f;
#pragma unroll
            for (int r = 0; r < 16; ++r) { x[r] = fmaf(S[r], QSCALE * LOG2E, tp[8 * (r >> 2) + (r & 3)]); pm = fmaxf(pm, x[r]); }
            { auto rr = __builtin_amdgcn_permlane32_swap(__float_as_uint(pm), __float_as_uint(pm), false, false); pm = fmaxf(__uint_as_float(rr[0]), __uint_as_float(rr[1])); }
            const float mn = fmaxf(mx, pm); const float alpha = __builtin_amdgcn_exp2f(mx - mn); mx = mn;
            float ps = 0.f;
#pragma unroll
            for (int r = 0; r < 16; ++r) { x[r] = __builtin_amdgcn_exp2f(x[r] - mn); ps += x[r]; }
            { auto rr = __builtin_amdgcn_permlane32_swap(__float_as_uint(ps), __float_as_uint(ps), false, false); ps = __uint_as_float(rr[0]) + __uint_as_float(rr[1]); }
            lsum = lsum * alpha + ps;
            if (__any(alpha < 1.f)) {
#pragma unroll
                for (int b = 0; b < 4; ++b)
#pragma unroll
                    for (int r = 0; r < 16; ++r) o[b][r] *= alpha;
            }
#pragma unroll
            for (int s = 0; s < 2; ++s) { u32x4 w; w.x = pk2(x[8 * s], x[8 * s + 1]); w.y = pk2(x[8 * s + 2], x[8 * s + 3]); w.z = pk2(x[8 * s + 4], x[8 * s + 5]); w.w = pk2(x[8 * s + 6], x[8 * s + 7]); pb[s] = __builtin_bit_cast(bf16x8, w); }
        } else {
            const bool diag = (j0 == i0);
            float lk[16], ls[16];
#pragma unroll
            for (int r = 0; r < 16; ++r) {
                const float z = S[r] * QSCALE; const float az = fabsf(z);
                const float sp = fmaxf(z, 0.f) + LN2 * __builtin_amdgcn_logf(1.0f + __builtin_amdgcn_exp2f(-az * LOG2E));
                const int key = 8 * (r >> 2) + 4 * hi + (r & 3);
                const bool valid = !diag || key < c;
                lk[r] = valid ? -sp : 0.f; ls[r] = valid ? (z - sp) : -1e30f;
            }
            float gs[4];
#pragma unroll
            for (int g = 0; g < 4; ++g) gs[g] = (lk[4 * g] + lk[4 * g + 1]) + (lk[4 * g + 2] + lk[4 * g + 3]);
            float pg[4];
#pragma unroll
            for (int g = 0; g < 4; ++g) { auto rr = __builtin_amdgcn_permlane32_swap(__float_as_uint(gs[g]), __float_as_uint(gs[g]), false, false); pg[g] = hi ? __uint_as_float(rr[0]) : __uint_as_float(rr[1]); }
            float suf[4]; float run = carry;
#pragma unroll
            for (int g = 3; g >= 0; --g) { if (hi == 0) { suf[g] = run + pg[g]; run = suf[g] + gs[g]; } else { suf[g] = run; run = run + gs[g] + pg[g]; } }
            float av[16];
#pragma unroll
            for (int g = 0; g < 4; ++g) { float lt = suf[g];
#pragma unroll
                for (int e = 3; e >= 0; --e) { av[4 * g + e] = __builtin_amdgcn_exp2f((ls[4 * g + e] + lt) * LOG2E); lt += lk[4 * g + e]; } }
            carry = run;
            early = __all(carry < -105.f);
#pragma unroll
            for (int s = 0; s < 2; ++s) { u32x4 w; w.x = pk2(av[8 * s], av[8 * s + 1]); w.y = pk2(av[8 * s + 2], av[8 * s + 3]); w.z = pk2(av[8 * s + 4], av[8 * s + 5]); w.w = pk2(av[8 * s + 6], av[8 * s + 7]); pb[s] = __builtin_bit_cast(bf16x8, w); }
        }
        if (has_next) asm volatile("s_waitcnt vmcnt(8)" ::: "memory"); else asm volatile("s_waitcnt vmcnt(0)" ::: "memory");
#pragma unroll
        for (int b = 0; b < 4; ++b) {
            s16x4 l0, h0, l1, h1;
            TRRD(l0, vb[b], 0); TRRD(h0, vb[b], 2048); TRRD(l1, vb[b], 4096); TRRD(h1, vb[b], 6144);
            asm volatile("s_waitcnt lgkmcnt(0)" ::: "memory"); SBAR();
            o[b] = __builtin_amdgcn_mfma_f32_32x32x16_bf16((bf16x8){l0[0], l0[1], l0[2], l0[3], h0[0], h0[1], h0[2], h0[3]}, pb[0], o[b], 0, 0, 0);
            o[b] = __builtin_amdgcn_mfma_f32_32x32x16_bf16((bf16x8){l1[0], l1[1], l1[2], l1[3], h1[0], h1[1], h1[2], h1[3]}, pb[1], o[b], 0, 0, 0);
        }
        asm volatile("" ::: "memory");
        if (!has_next || (MODE == 1 && early)) break;
        dma_tile_v(Vh + (size_t)(j0 + 32 * kstep) * rstride, rstride * 2, Vl, voffv);
    }
    if (MODE == 1) VM_WAIT();
    const float inv = MODE == 0 ? __builtin_amdgcn_rcpf(lsum) : 1.0f;
    bf16_t* orow = Op + (size_t)(i0 + c) * ostride + 4 * hi;
#pragma unroll
    for (int b = 0; b < 4; ++b)
#pragma unroll
        for (int g = 0; g < 4; ++g) { u32x2 w; w.x = pk2(o[b][4 * g] * inv, o[b][4 * g + 1] * inv); w.y = pk2(o[b][4 * g + 2] * inv, o[b][4 * g + 3] * inv); *(u32x2*)(orow + 32 * b + 8 * g) = w; }
    if (MODE == 0 && hi == 0) lsep[(size_t)(i0 + c) * lstride] = (mx + __builtin_amdgcn_logf(lsum)) * LN2;
}

struct Params { const float* in[16]; float* out; unsigned char* ws; int ph_lo, ph_hi; };
enum { IN_X = 0, IN_RELB, IN_ANG, IN_WIN, IN_GDIL, IN_GSB, IN_WO, IN_FNG, IN_DWG, IN_DWU, IN_DWD, IN_RW, IN_MWG, IN_MWU, IN_MWD, IN_FING };
constexpr int N_PHASES = 18;

typedef const __attribute__((address_space(4))) Params* KPtr;
__device__ __forceinline__ KPtr kparams() { KPtr p = (KPtr)__builtin_amdgcn_kernarg_segment_ptr(); asm volatile("" : "+s"(p)); return p; }
#define WSP(T, off) ((T)(ws + (off)))
__device__ __forceinline__ Frame make_frame() {
    Frame F; int t = threadIdx.x; asm volatile("" : "+v"(t));
    extern __shared__ __attribute__((aligned(16))) unsigned char lds_raw[];
    F.lds = (LAS unsigned char*)lds_raw; F.MISC = (volatile LAS unsigned*)(F.lds + MISC_OFF);
    F.tid = t; F.lane = t & 63; F.wave = __builtin_amdgcn_readfirstlane(t >> 6); F.G = gridDim.x; F.gw = blockIdx.x * NWAVES + F.wave;
    return F;
}
#define PHASE_ARGS() KPtr kp = kparams(); unsigned char* const ws = kp->ws; (void)ws; const Frame F = make_frame(); const int NGW = F.G * NWAVES; (void)NGW


constexpr int I_WI = (D / 64) * (DQKV / 64), I_WO = (D / 64) * (D / 64), I_DG = (D / 64) * (DFF / 64), I_DD = (DFF / 64) * (D / 64), I_MG = (D / 64) * (DFE / 64), I_MD = (DFE / 64) * (D / 64);
constexpr int CONV_A = I_WI + I_WO + 2 * I_DG + I_DD;
constexpr int CONV_B = I_WI + I_WO + NE * (2 * I_MG + I_MD);
static_assert(CONV_B % 2 == 0, "deferred conversion split");
__device__ __forceinline__ void conv_item(KPtr kp, unsigned char* ws, int it, LAS float* scr, int lane) {
    int r = it;
    if (r < CONV_A) {
        if (r < I_WI) { tr_item(kp->in[IN_WIN], D, DQKV, WSP(bf16_t*, WS_WI), 0, scr, r, lane); return; } r -= I_WI;
        if (r < I_WO) { tr_item(kp->in[IN_WO], D, D, WSP(bf16_t*, WS_WO), 0, scr, r, lane); return; } r -= I_WO;
#if DENSE_F8
        if (r < I_DG) { tr_item8(kp->in[IN_DWG], D, DFF, WSP(unsigned char*, WS_WGU_D), D, 1, scr, r, lane); return; } r -= I_DG;
        if (r < I_DG) { tr_item8(kp->in[IN_DWU], D, DFF, WSP(unsigned char*, WS_WGU_D), D, 2, scr, r, lane); return; } r -= I_DG;
        tr_item8(kp->in[IN_DWD], DFF, D, WSP(unsigned char*, WS_WD_D), DFFP, 0, scr, r, lane); return;
#else
        if (r < I_DG) { tr_item(kp->in[IN_DWG], D, DFF, WSP(bf16_t*, WS_WGU_D), 1, scr, r, lane); return; } r -= I_DG;
        if (r < I_DG) { tr_item(kp->in[IN_DWU], D, DFF, WSP(bf16_t*, WS_WGU_D), 2, scr, r, lane); return; } r -= I_DG;
        tr_item(kp->in[IN_DWD], DFF, D, WSP(bf16_t*, WS_WD_D), 0, scr, r, lane); return;
#endif
    }
    r -= CONV_A;
    if (r < I_WI) { tr_item(kp->in[IN_WIN] + (size_t)D * DQKV, D, DQKV, WSP(bf16_t*, WS_WI) + (size_t)DQKV * D, 0, scr, r, lane); return; } r -= I_WI;
    if (r < I_WO) { tr_item(kp->in[IN_WO] + (size_t)D * D, D, D, WSP(bf16_t*, WS_WO) + (size_t)D * D, 0, scr, r, lane); return; } r -= I_WO;
    if (r < NE * I_MG) { const int e = r / I_MG; tr_item8(kp->in[IN_MWG] + (size_t)e * D * DFE, D, DFE, WSP(unsigned char*, WS_WGU_M) + (size_t)e * 2 * DFE * D, D, 1, scr, r - e * I_MG, lane); return; } r -= NE * I_MG;
    if (r < NE * I_MG) { const int e = r / I_MG; tr_item8(kp->in[IN_MWU] + (size_t)e * D * DFE, D, DFE, WSP(unsigned char*, WS_WGU_M) + (size_t)e * 2 * DFE * D, D, 2, scr, r - e * I_MG, lane); return; } r -= NE * I_MG;
    { const int e = r / I_MD; tr_item8(kp->in[IN_MWD] + (size_t)e * DFE * D, DFE, D, WSP(unsigned char*, WS_WD_M) + (size_t)e * D * DFE, DFE, 0, scr, r - e * I_MD, lane); }
}

__device__ __forceinline__ ConvDesc conv_desc_a(KPtr kp, unsigned char* ws, int r) {
    ConvDesc d;
    if (r < I_WI) { d.W = kp->in[IN_WIN]; d.WT = WSP(unsigned char*, WS_WI); d.K = D; d.N = DQKV; d.mode = 0; d.f8 = 0; d.item = r; d.ldk = D; return d; } r -= I_WI;
    if (r < I_WO) { d.W = kp->in[IN_WO]; d.WT = WSP(unsigned char*, WS_WO); d.K = D; d.N = D; d.mode = 0; d.f8 = 0; d.item = r; d.ldk = D; return d; } r -= I_WO;
    if (r < I_DG) { d.W = kp->in[IN_DWG]; d.WT = WSP(unsigned char*, WS_WGU_D); d.K = D; d.N = DFF; d.mode = 1; d.f8 = DENSE_F8; d.item = r; d.ldk = D; return d; } r -= I_DG;
    if (r < I_DG) { d.W = kp->in[IN_DWU]; d.WT = WSP(unsigned char*, WS_WGU_D); d.K = D; d.N = DFF; d.mode = 2; d.f8 = DENSE_F8; d.item = r; d.ldk = D; return d; } r -= I_DG;
    d.W = kp->in[IN_DWD]; d.WT = WSP(unsigned char*, WS_WD_D); d.K = DFF; d.N = D; d.mode = 0; d.f8 = DENSE_F8; d.item = r; d.ldk = DENSE_F8 ? DFFP : DFF; return d;
}

__device__ __forceinline__ ConvDesc conv_desc_b(KPtr kp, unsigned char* ws, int r) {
    ConvDesc d;
    if (r < I_WI) { d.W = kp->in[IN_WIN] + (size_t)D * DQKV; d.WT = WSP(unsigned char*, WS_WI) + (size_t)DQKV * D * 2; d.K = D; d.N = DQKV; d.mode = 0; d.f8 = 0; d.item = r; d.ldk = D; return d; } r -= I_WI;
    if (r < I_WO) { d.W = kp->in[IN_WO] + (size_t)D * D; d.WT = WSP(unsigned char*, WS_WO) + (size_t)D * D * 2; d.K = D; d.N = D; d.mode = 0; d.f8 = 0; d.item = r; d.ldk = D; return d; } r -= I_WO;
    if (r < NE * I_MG) { const int e = r / I_MG; d.W = kp->in[IN_MWG] + (size_t)e * D * DFE; d.WT = WSP(unsigned char*, WS_WGU_M) + (size_t)e * 2 * DFE * D; d.K = D; d.N = DFE; d.mode = 1; d.f8 = 1; d.item = r - e * I_MG; d.ldk = D; return d; } r -= NE * I_MG;
    if (r < NE * I_MG) { const int e = r / I_MG; d.W = kp->in[IN_MWU] + (size_t)e * D * DFE; d.WT = WSP(unsigned char*, WS_WGU_M) + (size_t)e * 2 * DFE * D; d.K = D; d.N = DFE; d.mode = 2; d.f8 = 1; d.item = r - e * I_MG; d.ldk = D; return d; } r -= NE * I_MG;
    { const int e = r / I_MD; d.W = kp->in[IN_MWD] + (size_t)e * DFE * D; d.WT = WSP(unsigned char*, WS_WD_M) + (size_t)e * D * DFE; d.K = DFE; d.N = D; d.mode = 0; d.f8 = 1; d.item = r - e * I_MD; d.ldk = DFE; return d; }
}

#ifndef MK_ONE_LAUNCH
#define MK_ONE_LAUNCH 1
#endif
#ifndef NORM_FOLD
#define NORM_FOLD 0
#endif
__global__ void __launch_bounds__(NTHREADS, 2) mega_fwd(Params P) {
    const Frame F0 = make_frame();
    unsigned* ctl = (unsigned*)(P.ws + WS_CTL);
    for (int u = F0.tid; u < (LDS_BYTES - MISC_OFF) / 4; u += NTHREADS) ((LAS unsigned*)(F0.lds + MISC_OFF))[u] = 0u;
    __syncthreads();
    const int lo = P.ph_lo, hi = P.ph_hi;
    const bool one_phase = (hi - lo) == 1;
    XcdBarrier bar; bar.bar = ctl + CW_BAR; bar.x = 0; bar.st = nullptr;
    if (!one_phase) bar = xcd_barrier_post(ctl + CW_BAR, F0.MISC + 8);
#ifndef PH_MASK
#define PH_MASK 0x3ffffu
#endif
#ifndef PH_MASK2
#define PH_MASK2 0x3ffffu
#endif
#define IN(k) (((PH_MASK >> ((k) > 8 ? (k) - 8 : (k))) & 1u) != 0u && ((PH_MASK2 >> (k)) & 1u) != 0u && lo <= (k) && (k) < hi)
#if defined(PHTIME)
#define PH_STAMP(k) do { KPtr kq_ = kparams(); unsigned* const dq_ = (unsigned*)(kq_->ws + WS_CTL) + 12290 + (k); if (blockIdx.x == 0 && threadIdx.x == 0) *dq_ = (unsigned)__builtin_amdgcn_s_memrealtime(); } while (0)
#else
#define PH_STAMP(k) do {} while (0)
#endif
#define SEAM(k) do { if (IN(k) && IN((k) + 1)) xcd_barrier(bar); } while (0)
#ifndef REP_TYPES
#define REP_TYPES 0
#endif
#ifndef REP_PHASE
#define REP_PHASE -1
#endif
#ifndef REP_COUNT
#define REP_COUNT 2
#endif
#define PH_BEGIN(k) for (int _rep = 0; _rep < (((k) == REP_PHASE) ? REP_COUNT : 1); ++_rep) { if (_rep) xcd_barrier(bar); if (IN(k))
#define PH_END }

    PH_STAMP(-1);
    PH_BEGIN(0) {
        PHASE_ARGS(); bf16_t* const WI = WSP(bf16_t*, WS_WI); bf16_t* const WOt = WSP(bf16_t*, WS_WO); bf16_t* const WGUD = WSP(bf16_t*, WS_WGU_D); bf16_t* const WDD = WSP(bf16_t*, WS_WD_D);
        bf16_t* const WGUM = WSP(bf16_t*, WS_WGU_M); bf16_t* const WDM = WSP(bf16_t*, WS_WD_M); bf16_t* const H = WSP(bf16_t*, WS_H);
        if (blockIdx.x < 3 * NH) { float* tbg = WSP(float*, WS_BKT) + blockIdx.x * TBL_N; const int br = blockIdx.x / NH, h = blockIdx.x % NH, dd = br == 0 ? 1 : (br == 1 ? 4 : 16);
            if (F.tid < TBL_N) { const int m_ = 160 - F.tid; tbg[F.tid] = (m_ >= 0 && m_ <= 128) ? kp->in[IN_RELB][t5_bucket(dd * m_) * NH + h] * LOG2E : -1e30f; } }
        LAS float* scr = (LAS float*)(F.lds + F.wave * WSCR);
        {
            const int per = (CONV_A + NGW - 1) / NGW, npair = (per + 1) / 2;
#define CA_IDX(i_) (F.gw + (i_) * NGW < CONV_A ? F.gw + (i_) * NGW : CONV_A - 1)
            f32x4 va[16], vb[16];
            ConvDesc da = conv_desc_a(kp, ws, CA_IDX(0)), db;
            tr_load(da, va, F.lane);
            for (int p_ = 0; p_ < npair - 1; ++p_) {
                db = conv_desc_a(kp, ws, CA_IDX(2 * p_ + 1)); tr_load(db, vb, F.lane);
                tr_finish(da, va, scr, F.lane);
                da = conv_desc_a(kp, ws, CA_IDX(2 * p_ + 2)); tr_load(da, va, F.lane);
                tr_finish(db, vb, scr, F.lane);
            }
            db = conv_desc_a(kp, ws, CA_IDX(2 * npair - 1)); tr_load(db, vb, F.lane);
            tr_finish(da, va, scr, F.lane);
            tr_finish(db, vb, scr, F.lane);
#undef CA_IDX
        }
#if DENSE_F8
        { unsigned char* wdd = WSP(unsigned char*, WS_WD_D); for (int i = blockIdx.x * NTHREADS + F.tid; i < D * ((DFFP - DFF) / 16); i += F.G * NTHREADS) { const int row = i >> 3, c = i & 7; *(u32x4*)(wdd + (size_t)row * DFFP + DFF + 16 * c) = (u32x4){0u, 0u, 0u, 0u}; } }
#endif
        rms_rows_f2b(kp->in[IN_X], kp->in[IN_ANG], H, F.gw, NGW, F.lane);
    }
    PH_END SEAM(0);

    for (int layer = 0; layer < 2; ++layer) {
        const int pb = layer == 0 ? 1 : 9;
        int lo_l = lo, hi_l = hi; asm volatile("" : "+s"(lo_l), "+s"(hi_l)); const int lo = lo_l, hi = hi_l;
        PH_BEGIN(pb) {
            PHASE_ARGS(); bf16_t* const H = WSP(bf16_t*, WS_H); bf16_t* const WI = WSP(bf16_t*, WS_WI); bf16_t* const QKV = WSP(bf16_t*, WS_QKV);
            pg8::Gemm g{H, WI + (size_t)layer * DQKV * D, T, DQKV, D}; pg8::StaticOrder S; S.init(T, DQKV, F.G, (int)blockIdx.x);
#if DENSE_F8 && NORM_FOLD
            LAS float* const rsl = (LAS float*)(F.lds + MISC_OFF) + 512;
            { const int c_ = (int)blockIdx.x, pm0 = 8 * (c_ & 7) + ((c_ >> 3) & 7); float rv = 1.0f;
              if (layer && F.tid < 256) { const f32x4* pr = (const f32x4*)(WSP(const float*, WS_PART) + (size_t)(pm0 * 256 + F.tid) * 32); f32x4 a4 = pr[0];
#pragma unroll
                  for (int k = 1; k < 8; ++k) a4 += pr[k];
                  rv = 1.0f / sqrtf((a4[0] + a4[1] + a4[2] + a4[3]) * (1.0f / D) + EPS); }
              if (F.tid < 256) rsl[F.tid] = rv;
              __syncthreads(); }
            pg8::EpiQKV E{QKV, rsl};
#else
            pg8::EpiQKV E{QKV, (const LAS float*)nullptr};
#endif
            pg8::gemm_phase<pg8::EpiQKV, pg8::StaticOrder, true, true>(F.lds, g, S, E, F.tid);
        }
        PH_END SEAM(pb);
        PH_BEGIN(pb + 1) {
            PHASE_ARGS(); bf16_t* const QKV = WSP(bf16_t*, WS_QKV); bf16_t* const OD = WSP(bf16_t*, WS_OD); bf16_t* const OS = WSP(bf16_t*, WS_OS); float* const LSE = WSP(float*, WS_LSE);
            LAS float* tbl = (LAS float*)(F.lds + TBL_OFF);
            { const float* tbg = WSP(const float*, WS_BKT); for (int i = F.tid; i < 3 * NH * TBL_N; i += NTHREADS) tbl[i] = tbg[i]; }
            __syncthreads();
            LAS unsigned char* wl = F.lds + F.wave * WSCR;
            const size_t TS = (size_t)T * DH;
            const int cbase = CONV_A + layer * (CONV_B / 2); const int ncv = CONV_B / 2; constexpr int natt_c = 4 * 4096; const int natt = natt_c; (void)natt;
#ifndef F8_ALIGN
#define F8_ALIGN true
#endif
#ifndef ATT_NA
#define ATT_NA 4
#endif
            constexpr int NA = ATT_NA, NCV = 8 - ATT_NA;
            const int NCW = F.G * NCV;
            if (F.wave >= NA) {
                const Frame FC = make_frame();
                const int c0 = blockIdx.x * NCV + (F.wave - NA); const int roff = cbase - CONV_A;
#if defined(CONV2X)
                const int per0 = (ncv + NCW - 1) / NCW, per = CONV2X * per0, npair = (per + 1) / 2;
#define CV_IDX(i_) (roff + (c0 + ((i_) % per0) * NCW < ncv ? c0 + ((i_) % per0) * NCW : ncv - 1))
#else
                const int per = (ncv + NCW - 1) / NCW, npair = (per + 1) / 2;
#define CV_IDX(i_) (roff + (c0 + (i_) * NCW < ncv ? c0 + (i_) * NCW : ncv - 1))
#endif
                f32x4 va[16], vb[16];
                ConvDesc da = conv_desc_b(kp, ws, CV_IDX(0)), db;
                tr_load(da, va, FC.lane);
                for (int p = 0; p < npair - 1; ++p) {
                    db = conv_desc_b(kp, ws, CV_IDX(2 * p + 1)); tr_load(db, vb, FC.lane);
                    tr_finish(da, va, (LAS float*)wl, FC.lane);
                    da = conv_desc_b(kp, ws, CV_IDX(2 * p + 2)); tr_load(da, va, FC.lane);
                    tr_finish(db, vb, (LAS float*)wl, FC.lane);
                }
                db = conv_desc_b(kp, ws, CV_IDX(2 * npair - 1)); tr_load(db, vb, FC.lane);
                tr_finish(da, va, (LAS float*)wl, FC.lane);
                tr_finish(db, vb, (LAS float*)wl, FC.lane);
#undef CV_IDX
            }
            {
                const Frame FA = make_frame();
                static_assert(natt_c == 8 * 2048, "2048 items per XCD queue");
                unsigned* const aqb = (unsigned*)(ws + WS_CTL) + CW_AQ + 128 * layer;
                const int x0 = (int)(xb_xcc_id() & 7u);
#define AQ_FETCH(dst_, q_) { dst_ = 0u; if (FA.lane == 0) dst_ = __hip_atomic_fetch_add(aqb + 16 * (q_), 1u, __ATOMIC_RELAXED, __HIP_MEMORY_SCOPE_AGENT); }
                if (F.wave < NA) __builtin_amdgcn_s_setprio(2);
                for (int qs = 0; qs < 8; ++qs) { const int xq = (x0 + qs) & 7;
                unsigned nv, nn; AQ_FETCH(nv, xq);
                int n = __builtin_amdgcn_readfirstlane((int)nv);
                while (n < 2048) {
                    AQ_FETCH(nn, xq);
                    const int it = ((((15 - (n >> 7)) << 3) + xq) << 7) + (n & 127);
                    const int type = it >> 12, idx = it & 4095, bh = idx >> 7, rem = idx & 127, b = bh >> 3, h = bh & 7;
                    const size_t hb = (size_t)(bh * SEQ) * HD;
                    if (type < 3) {
                        const int sh = 2 * type, dil = 1 << sh;
                        const int gps = 128 >> sh, r = rem / gps, qg = rem - r * gps; const int tok0 = b * SEQ + r;
                        const size_t sub = hb + (size_t)r * HD;
                        attn_item<0>(wl, QKV + sub, dil * HD, QKV + TS + sub, QKV + 2 * TS + sub,
                                     OD + (size_t)type * TS + (size_t)tok0 * DH + h * HD, dil * DH, LSE + (size_t)type * T * NH + (size_t)tok0 * NH + h, dil * NH, tbl + (type * NH + h) * TBL_N, qg, FA.lane);
                    } else {
                        attn_item<1>(wl, QKV + 3 * TS + hb, HD, QKV + 4 * TS + hb, QKV + 5 * TS + hb, OS + (size_t)(b * SEQ) * DH + h * HD, DH, nullptr, 0, nullptr, rem, FA.lane);
                    }
                    n = __builtin_amdgcn_readfirstlane((int)nn);
                }
                }
                __builtin_amdgcn_s_setprio(0);
#undef AQ_FETCH
            }
        }
        PH_END SEAM(pb + 1);
        PH_BEGIN(pb + 2) {
            PHASE_ARGS(); bf16_t* const OD = WSP(bf16_t*, WS_OD); bf16_t* const OS = WSP(bf16_t*, WS_OS); float* const LSE = WSP(float*, WS_LSE); bf16_t* const O = WSP(bf16_t*, WS_O);
            const float* gd = kp->in[IN_GDIL] + (size_t)layer * DH; const float* gs = kp->in[IN_GSB] + (size_t)layer * DH;
            const int h = F.lane >> 3;
            f32x4 gdq[4], gsq[4];
#pragma unroll
            for (int k = 0; k < 4; ++k) { gdq[k] = ((const f32x4*)(gd + 16 * F.lane))[k]; gsq[k] = ((const f32x4*)(gs + 16 * F.lane))[k]; }
            for (int tb0 = F.gw; tb0 < T; tb0 += 2 * NGW) {
                float ls[2][3]; u32x4 ra[2][2], rbq[2][2], rcq[2][2], rsq[2][2];
#pragma unroll
                for (int r = 0; r < 2; ++r) { const int t = tb0 + r * NGW;
                    ls[r][0] = LSE[(size_t)t * NH + h]; ls[r][1] = LSE[(size_t)(T + t) * NH + h]; ls[r][2] = LSE[(size_t)(2 * T + t) * NH + h];
                    const u32x4* p0 = (const u32x4*)(OD + (size_t)t * DH + 16 * F.lane); const u32x4* p1 = (const u32x4*)(OD + (size_t)(T + t) * DH + 16 * F.lane); const u32x4* p2 = (const u32x4*)(OD + (size_t)(2 * T + t) * DH + 16 * F.lane);
                    const u32x4* ps = (const u32x4*)(OS + (size_t)t * DH + 16 * F.lane);
#pragma unroll
                    for (int k = 0; k < 2; ++k) { ra[r][k] = p0[k]; rbq[r][k] = p1[k]; rcq[r][k] = p2[k]; rsq[r][k] = ps[k]; } }
#pragma unroll
                for (int r = 0; r < 2; ++r) { const int t = tb0 + r * NGW;
                    const float l0 = ls[r][0], l1 = ls[r][1], l2 = ls[r][2];
                    const float lm = fmaxf(l0, fmaxf(l1, l2)); float w0 = __expf(l0 - lm), w1 = __expf(l1 - lm), w2 = __expf(l2 - lm); const float wi = 1.0f / (w0 + w1 + w2); w0 *= wi; w1 *= wi; w2 *= wi;
                    float vd[16], vs[16]; float ssd = 0.f, sss = 0.f;
#pragma unroll
                    for (int k = 0; k < 2; ++k)
#pragma unroll
                        for (int j = 0; j < 4; ++j) {
                            const float d0 = w0 * bf_lo(ra[r][k][j]) + w1 * bf_lo(rbq[r][k][j]) + w2 * bf_lo(rcq[r][k][j]), d1 = w0 * bf_hi(ra[r][k][j]) + w1 * bf_hi(rbq[r][k][j]) + w2 * bf_hi(rcq[r][k][j]);
                            vd[8 * k + 2 * j] = d0; vd[8 * k + 2 * j + 1] = d1; ssd += d0 * d0 + d1 * d1;
                            const float s0 = bf_lo(rsq[r][k][j]), s1 = bf_hi(rsq[r][k][j]); vs[8 * k + 2 * j] = s0; vs[8 * k + 2 * j + 1] = s1; sss += s0 * s0 + s1 * s1; }
                    const float rd = 1.0f / sqrtf(wave_sum(ssd) * (1.0f / DH) + EPS), rs = 1.0f / sqrtf(wave_sum(sss) * (1.0f / DH) + EPS);
                    u32x4 od[2], os[2];
#pragma unroll
                    for (int k = 0; k < 2; ++k) { const f32x4 ga = gdq[2 * k], gb = gdq[2 * k + 1], ha = gsq[2 * k], hb = gsq[2 * k + 1];
                        od[k].x = pk2(vd[8 * k] * rd * ga.x, vd[8 * k + 1] * rd * ga.y); od[k].y = pk2(vd[8 * k + 2] * rd * ga.z, vd[8 * k + 3] * rd * ga.w);
                        od[k].z = pk2(vd[8 * k + 4] * rd * gb.x, vd[8 * k + 5] * rd * gb.y); od[k].w = pk2(vd[8 * k + 6] * rd * gb.z, vd[8 * k + 7] * rd * gb.w);
                        os[k].x = pk2(vs[8 * k] * rs * ha.x, vs[8 * k + 1] * rs * ha.y); os[k].y = pk2(vs[8 * k + 2] * rs * ha.z, vs[8 * k + 3] * rs * ha.w);
                        os[k].z = pk2(vs[8 * k + 4] * rs * hb.x, vs[8 * k + 5] * rs * hb.y); os[k].w = pk2(vs[8 * k + 6] * rs * hb.z, vs[8 * k + 7] * rs * hb.w); }
                    u32x4* o0 = (u32x4*)(O + (size_t)t * D + 16 * F.lane); u32x4* o1 = (u32x4*)(O + (size_t)t * D + DH + 16 * F.lane);
                    o0[0] = od[0]; o0[1] = od[1]; o1[0] = os[0]; o1[1] = os[1];
                }
            }
        }
        PH_END SEAM(pb + 2);
        PH_BEGIN(pb + 3) {
            PHASE_ARGS(); bf16_t* const O = WSP(bf16_t*, WS_O); bf16_t* const WOt = WSP(bf16_t*, WS_WO); bf16_t* const X = WSP(bf16_t*, WS_X);
            pg8::Gemm g{O, WOt + (size_t)layer * D * D, T, D, D}; pg8::StaticOrder S; S.init(T, D, F.G, (int)blockIdx.x);
            pg8::EpiResB E{layer == 0 ? kp->in[IN_X] : (const float*)nullptr, X, X, D, 1.0f};
            pg8::gemm_phase<pg8::EpiResB, pg8::StaticOrder, true, true>(F.lds, g, S, E, F.tid);
        }
        PH_END SEAM(pb + 3);
        PH_BEGIN(pb + 4) {
            PHASE_ARGS(); const bf16_t* const X = WSP(const bf16_t*, WS_X); bf16_t* const H = WSP(bf16_t*, WS_H); int* const SEL = WSP(int*, WS_SEL); float* const GWT = WSP(float*, WS_GW); int* const HIST = WSP(int*, WS_HIST);
            const float* gF = kp->in[IN_FNG] + (size_t)layer * D;
#if DENSE_F8
            if (layer == 0) {
                unsigned char* ACT = WSP(unsigned char*, WS_ACT);
                f32x4 gq[8];
#pragma unroll
                for (int q = 0; q < 8; ++q) gq[q] = ((const f32x4*)gF)[F.lane + 64 * q];
                for (int m0 = F.gw; m0 < T; m0 += 4 * NGW) {
                    u32x2 raw[4][8];
#pragma unroll
                    for (int r = 0; r < 4; ++r)
#pragma unroll
                        for (int q = 0; q < 8; ++q) raw[r][q] = ((const u32x2*)(X + (size_t)(m0 + r * NGW) * D))[F.lane + 64 * q];
#pragma unroll
                    for (int r = 0; r < 4; ++r) { const int m = m0 + r * NGW;
                        f32x4 v[8]; float ss = 0.f;
#pragma unroll
                        for (int q = 0; q < 8; ++q) { v[q] = (f32x4){bf_lo(raw[r][q].x), bf_hi(raw[r][q].x), bf_lo(raw[r][q].y), bf_hi(raw[r][q].y)}; ss += dot4(v[q]); }
                        const float rstd = F8_SH / sqrtf(wave_sum(ss) * (1.0f / D) + EPS);
                        unsigned* o8 = (unsigned*)((unsigned char*)H + (size_t)m * D) + F.lane;
#pragma unroll
                        for (int q = 0; q < 8; ++q) o8[64 * q] = pg8::pk4_fp8(v[q].x * rstd * gq[q].x, v[q].y * rstd * gq[q].y, v[q].z * rstd * gq[q].z, v[q].w * rstd * gq[q].w);
                        { u32x4 z4 = (u32x4){0u, 0u, 0u, 0u}; asm volatile("" : "+v"(z4));
                          if (F.lane < (DFFP - DFF) / 16) *(u32x4*)(ACT + (size_t)m * DFFP + DFF + 16 * F.lane) = z4; }
                    }
                }
            }
#else
            if (layer == 0) rms_rows_b2b(X, gF, H, F.gw, NGW, F.lane);
#endif
            else {
                volatile LAS unsigned* hist = F.MISC + 16;
                const int rows_per_wg = T / F.G, rows_per_wave = rows_per_wg / NWAVES;
                { const f32x4* RW4 = (const f32x4*)kp->in[IN_RW]; LAS f32x4* RL = (LAS f32x4*)F.lds;
                  for (int u = F.tid; u < 4096; u += NTHREADS) { const int ln = u & 63, k = u >> 6, half = k & 1, qi = k >> 1, i = qi & 3, q = qi >> 2; RL[u] = RW4[(4 * (ln + 64 * q) + i) * 2 + half]; } }
                __syncthreads();
                const LAS f32x4* rl = (const LAS f32x4*)F.lds + F.lane;
                f32x4 gq[8];
#pragma unroll
                for (int q = 0; q < 8; ++q) gq[q] = ((const f32x4*)gF)[F.lane + 64 * q];
                for (int jb = 0; jb < rows_per_wave; jb += 4) {
                    const int tb0 = blockIdx.x * rows_per_wg + F.wave * rows_per_wave + jb;
                    u32x2 raw[4][8];
#pragma unroll
                    for (int r = 0; r < 4; ++r)
#pragma unroll
                        for (int q = 0; q < 8; ++q) raw[r][q] = ((const u32x2*)(X + (size_t)(tb0 + r) * D))[F.lane + 64 * q];
#pragma unroll
                    for (int r = 0; r < 4; ++r) { const int t = tb0 + r;
                    f32x4 v[8]; float ss = 0.f;
#pragma unroll
                    for (int q = 0; q < 8; ++q) { v[q] = (f32x4){bf_lo(raw[r][q].x), bf_hi(raw[r][q].x), bf_lo(raw[r][q].y), bf_hi(raw[r][q].y)}; ss += dot4(v[q]); }
                    const float rstd = 1.0f / sqrtf(wave_sum(ss) * (1.0f / D) + EPS);
                    float lg[8];
#pragma unroll
                    for (int e = 0; e < 8; ++e) lg[e] = 0.f;
                    unsigned* o8 = (unsigned*)((unsigned char*)H + (size_t)t * D) + F.lane;
#pragma unroll
                    for (int q = 0; q < 8; ++q) { const f32x4 gg = gq[q]; const f32x4 y = {v[q].x * rstd * gg.x, v[q].y * rstd * gg.y, v[q].z * rstd * gg.z, v[q].w * rstd * gg.w};
                        o8[64 * q] = pg8::pk4_fp8(y.x * F8_SH, y.y * F8_SH, y.z * F8_SH, y.w * F8_SH);
#pragma unroll
                        for (int i = 0; i < 4; ++i) { const f32x4 ra = rl[((q * 4 + i) * 2) * 64], rb = rl[((q * 4 + i) * 2 + 1) * 64]; const float yi = y[i];
                            lg[0] += yi * ra.x; lg[1] += yi * ra.y; lg[2] += yi * ra.z; lg[3] += yi * ra.w; lg[4] += yi * rb.x; lg[5] += yi * rb.y; lg[6] += yi * rb.z; lg[7] += yi * rb.w; } }
#pragma unroll
                    for (int e = 0; e < 8; ++e) lg[e] = wave_sum(lg[e]);
                    if (F.lane == 0) {
                        int e1 = 0; float v1 = lg[0];
#pragma unroll
                        for (int e = 1; e < 8; ++e) if (lg[e] > v1) { v1 = lg[e]; e1 = e; }
                        int e2 = -1; float v2 = -3e38f;
#pragma unroll
                        for (int e = 0; e < 8; ++e) if (e != e1 && lg[e] > v2) { v2 = lg[e]; e2 = e; }
                        const float ex = __expf(v2 - v1); const float w1 = 1.0f / (1.0f + ex), w2 = ex * w1;
                        SEL[2 * t] = e1; SEL[2 * t + 1] = e2; GWT[2 * t] = w1; GWT[2 * t + 1] = w2;
                        __hip_atomic_fetch_add((LAS unsigned*)&hist[e1], 1u, __ATOMIC_RELAXED, __HIP_MEMORY_SCOPE_WORKGROUP); __hip_atomic_fetch_add((LAS unsigned*)&hist[e2], 1u, __ATOMIC_RELAXED, __HIP_MEMORY_SCOPE_WORKGROUP);
                    }
                    }
                }
                __syncthreads();
                if (F.tid < 8) { HIST[blockIdx.x * 8 + F.tid] = (int)hist[F.tid]; }
            }
        }
        PH_END SEAM(pb + 4);
        if (layer == 0) {
#if DENSE_F8
            PH_BEGIN(6) {
                PHASE_ARGS(); const bf16_t* const H = WSP(const bf16_t*, WS_H); const bf16_t* const WGUD = WSP(const bf16_t*, WS_WGU_D); unsigned char* const ACT = WSP(unsigned char*, WS_ACT);
                pg8::Gemm g{H, WGUD, T, 2 * DFF, D / 2}; pg8::StaticOrder S; S.init(T, 2 * DFF, F.G, (int)blockIdx.x);
                pg8::EpiSwiGLU8 E{ACT, DFFP, DFF / 128, 1.0f / (F8_SH * F8_SW), F8_SACT};
                pg8::gemm_phase<pg8::EpiSwiGLU8, pg8::StaticOrder, true, true, true>(F.lds, g, S, E, F.tid);
            }
            PH_END SEAM(6);
            PH_BEGIN(7) {
                PHASE_ARGS(); const bf16_t* const ACT = WSP(const bf16_t*, WS_ACT); const bf16_t* const WDD = WSP(const bf16_t*, WS_WD_D); bf16_t* const X = WSP(bf16_t*, WS_X);
                pg8::Gemm g{ACT, WDD, T, D, DFFP / 2}; pg8::StaticOrder S; S.init(T, D, F.G, (int)blockIdx.x);
#if NORM_FOLD
                pg8::EpiResF32N E{X, X, D, 1.0f / (F8_SACT * F8_SW), kp->in[IN_ANG] + D, WSP(bf16_t*, WS_H), WSP(float*, WS_PART)};
                pg8::gemm_phase<pg8::EpiResF32N, pg8::StaticOrder, true, true, true>(F.lds, g, S, E, F.tid);
#else
                pg8::EpiResB E{(const float*)nullptr, X, X, D, 1.0f / (F8_SACT * F8_SW)};
                pg8::gemm_phase<pg8::EpiResB, pg8::StaticOrder, true, true, true>(F.lds, g, S, E, F.tid);
#endif
            }
#else
            PH_BEGIN(6) {
                PHASE_ARGS(); bf16_t* const H = WSP(bf16_t*, WS_H); bf16_t* const WGUD = WSP(bf16_t*, WS_WGU_D); bf16_t* const ACT = WSP(bf16_t*, WS_ACT);
                pg8::Gemm g{H, WGUD, T, 2 * DFF, D}; pg8::StaticOrder S; S.init(T, 2 * DFF, F.G, (int)blockIdx.x);
                pg8::EpiSwiGLU E{ACT, DFF, DFF / 128};
#if defined(CLKPROBE)
                const unsigned long long ct0 = __builtin_amdgcn_s_memtime(), cr0 = __builtin_amdgcn_s_memrealtime();
#endif
                pg8::gemm_phase<pg8::EpiSwiGLU, pg8::StaticOrder, true, true>(F.lds, g, S, E, F.tid);
#if defined(CLKPROBE)
                { const unsigned long long ct1 = __builtin_amdgcn_s_memtime(), cr1 = __builtin_amdgcn_s_memrealtime();
                  if (blockIdx.x == 5 && F.tid == 0) { const float ghz = (float)(ct1 - ct0) / (float)(cr1 - cr0) * 0.1f; const float us = (float)(cr1 - cr0) * 0.01f;
                      unsigned* dbg = (unsigned*)(ws + WS_CTL) + 12288; dbg[0] = (unsigned)(CLKPROBE == 1 ? (int)(ghz * 4.f) : (int)(us * 0.1f + 0.5f)); } }
#endif
            }
            PH_END SEAM(6);
            PH_BEGIN(7) {
                PHASE_ARGS(); bf16_t* const ACT = WSP(bf16_t*, WS_ACT); bf16_t* const WDD = WSP(bf16_t*, WS_WD_D); bf16_t* const X = WSP(bf16_t*, WS_X);
                pg8::Gemm g{ACT, WDD, T, D, DFF}; pg8::StaticOrder S; S.init(T, D, F.G, (int)blockIdx.x);
                pg8::EpiResB E{(const float*)nullptr, X, X, D, 1.0f};
                pg8::gemm_phase<pg8::EpiResB, pg8::StaticOrder, true, true>(F.lds, g, S, E, F.tid);
            }
#endif
            PH_END SEAM(7);
#if !(DENSE_F8 && NORM_FOLD)
            PH_BEGIN(8) { PHASE_ARGS(); const bf16_t* const X = WSP(const bf16_t*, WS_X); bf16_t* const H = WSP(bf16_t*, WS_H); rms_rows_b2b(X, kp->in[IN_ANG] + D, H, F.gw, NGW, F.lane); }
            PH_END SEAM(8);
#endif
        }
    }
    PH_BEGIN(14) {
        PHASE_ARGS(); bf16_t* const H = WSP(bf16_t*, WS_H); unsigned char* const AS = WSP(unsigned char*, WS_AS); int* const SEL = WSP(int*, WS_SEL); int* const POS = WSP(int*, WS_POS); int* const HIST = WSP(int*, WS_HIST); int* const MOEINFO = WSP(int*, WS_MOEINFO);
        volatile LAS unsigned* tot = F.MISC + 32; volatile LAS unsigned* pre = F.MISC + 40; volatile LAS unsigned* rbase = F.MISC + 48; volatile LAS unsigned* ent = F.MISC + 64;
        if (F.tid < 16) F.MISC[32 + F.tid] = 0u;
        __syncthreads();
        { const int e = F.tid & 7, ch = F.tid >> 3; unsigned st = 0, sp = 0;
#pragma unroll
          for (int k = 0; k < 4; ++k) { const int w = 4 * ch + k; const unsigned hv = (unsigned)HIST[w * 8 + e]; st += hv; if (w < (int)blockIdx.x) sp += hv; }
          __hip_atomic_fetch_add((LAS unsigned*)&tot[e], st, __ATOMIC_RELAXED, __HIP_MEMORY_SCOPE_WORKGROUP); __hip_atomic_fetch_add((LAS unsigned*)&pre[e], sp, __ATOMIC_RELAXED, __HIP_MEMORY_SCOPE_WORKGROUP); }
        __syncthreads();
        if (F.tid == 0) { unsigned tbv = 0;
            for (int e = 0; e < 8; ++e) { rbase[e] = tbv * 256u + pre[e]; if (blockIdx.x == 0) MOEINFO[e] = (int)tbv; tbv += (tot[e] + 255u) >> 8; }
            if (blockIdx.x == 0) MOEINFO[8] = (int)tbv; }
        const int t0 = blockIdx.x * 64;
        if (F.tid < 128) ent[F.tid] = (unsigned)SEL[2 * t0 + F.tid];
        __syncthreads();
        if (F.tid < 128) { const unsigned e = ent[F.tid]; unsigned rank = 0; for (int j = 0; j < F.tid; ++j) rank += (ent[j] == e) ? 1u : 0u;
            const unsigned pos = rbase[e] + rank; POS[2 * t0 + F.tid] = (int)pos; F.MISC[192 + F.tid] = pos; }
        __syncthreads();
        for (int q = 0; q < 16; q += 8) {
            u32x4 v[8][2];
#pragma unroll
            for (int k = 0; k < 8; ++k) { const int en = 16 * F.wave + q + k; const u32x4* src = (const u32x4*)((const unsigned char*)H + (size_t)(t0 + (en >> 1)) * D) + F.lane;
                v[k][0] = src[0]; v[k][1] = src[64]; }
#pragma unroll
            for (int k = 0; k < 8; ++k) { const int en = 16 * F.wave + q + k; u32x4* dst = (u32x4*)(AS + (size_t)F.MISC[192 + en] * D) + F.lane;
                dst[0] = v[k][0]; dst[64] = v[k][1]; }
        }
    }
    PH_END SEAM(14);
    if (IN(15) || IN(16)) {
        PHASE_ARGS(); int* const MOEINFO = WSP(int*, WS_MOEINFO); const bf16_t* const AS = WSP(const bf16_t*, WS_AS); const bf16_t* const WGUM = WSP(const bf16_t*, WS_WGU_M); unsigned char* const ACTM = WSP(unsigned char*, WS_ACTM); const bf16_t* const WDM = WSP(const bf16_t*, WS_WD_M); bf16_t* const Y = WSP(bf16_t*, WS_Y);
        int tbv[9];
#pragma unroll
        for (int k = 0; k < 9; ++k) tbv[k] = __builtin_amdgcn_readfirstlane((int)__hip_atomic_load((unsigned*)MOEINFO + k, __ATOMIC_RELAXED, __HIP_MEMORY_SCOPE_AGENT));
        PH_BEGIN(15) {
            pg8::Gemm g{AS, WGUM, MOE_ROWS, NE * 2 * DFE, D / 2}; pg8::GroupedOrder S; S.init(tbv[8], 2 * DFE / 256, F.G, (int)blockIdx.x);
#pragma unroll
            for (int k = 0; k < 9; ++k) S.tb[k] = tbv[k];
            pg8::EpiSwiGLU8 E{ACTM, DFE, 2 * DFE / 256, 1.0f / (F8_SH * F8_SW), F8_SACT};
            pg8::gemm_phase<pg8::EpiSwiGLU8, pg8::GroupedOrder, F8_ALIGN, true, true>(F.lds, g, S, E, F.tid);
        }
        PH_END SEAM(15);
        PH_BEGIN(16) {
#if defined(NO_TAIL)
            const int rmain = tbv[8];
#else
            const int rmain = tbv[8] < TAIL_T0 ? tbv[8] : TAIL_T0;
#endif
            pg8::Gemm g{(const bf16_t*)ACTM, WDM, MOE_ROWS, NE * D, DFE / 2}; pg8::GroupedOrder S; S.init(rmain, D / 256, F.G, (int)blockIdx.x);
#pragma unroll
            for (int k = 0; k < 9; ++k) S.tb[k] = tbv[k];
            pg8::EpiBf16G E{Y, D, D / 256};
            pg8::gemm_phase<pg8::EpiBf16G, pg8::GroupedOrder, F8_ALIGN, true, true>(F.lds, g, S, E, F.tid);
            pg8::TailOrder S2; S2.init(tbv[8] - rmain, D / 256, TAIL_SL, TAIL_NT, F.G, (int)blockIdx.x);
#pragma unroll
            for (int k = 0; k < 9; ++k) S2.tb[k] = tbv[k];
            pg8::EpiPartF32 E2{WSP(float*, WS_YP), D / 256, TAIL_NT * 128, (unsigned)(TAIL_MAXT * 256 * D)};
            pg8::gemm_phase<pg8::EpiPartF32, pg8::TailOrder, F8_ALIGN, true, true>(F.lds, g, S2, E2, F.tid);
        } PH_END
    }
    SEAM(16);
    PH_BEGIN(17) {
        PHASE_ARGS(); const bf16_t* const X = WSP(const bf16_t*, WS_X); bf16_t* const Y = WSP(bf16_t*, WS_Y); int* const POS = WSP(int*, WS_POS); float* const GWT = WSP(float*, WS_GW);
        const float* gfin = kp->in[IN_FING];
#if defined(PHTIME)
        xcd_barrier(bar);
#endif
        {
            const int ntr = (WSP(const int*, WS_MOEINFO)[8] - TAIL_T0) * 256; const float* const YP = WSP(const float*, WS_YP);
            for (int r = F.gw; r < ntr; r += NGW) {
#pragma unroll
                for (int jh = 0; jh < 2; ++jh) { f32x4 s[4];
#pragma unroll
                    for (int j = 0; j < 4; ++j) s[j] = ((const f32x4*)(YP + (size_t)r * D))[F.lane + 64 * (4 * jh + j)];
#pragma unroll
                    for (int k = 1; k < TAIL_SL; ++k)
#pragma unroll
                        for (int j = 0; j < 4; ++j) s[j] += ((const f32x4*)(YP + ((size_t)k * TAIL_MAXT * 256 + r) * D))[F.lane + 64 * (4 * jh + j)];
#pragma unroll
                    for (int j = 0; j < 4; ++j) { u32x2 w; w.x = pk2(s[j].x, s[j].y); w.y = pk2(s[j].z, s[j].w); ((u32x2*)(Y + (size_t)(TAIL_T0 * 256 + r) * D))[F.lane + 64 * (4 * jh + j)] = w; }
                }
            }
            if (!one_phase) xcd_barrier(bar);
        }
#if defined(PHTIME)
        unsigned dbgv; { const unsigned s0_ = __hip_atomic_load((unsigned*)(ws + WS_CTL) + 12290 + PHTIME - 1, __ATOMIC_RELAXED, __HIP_MEMORY_SCOPE_AGENT), s1_ = __hip_atomic_load((unsigned*)(ws + WS_CTL) + 12290 + PHTIME, __ATOMIC_RELAXED, __HIP_MEMORY_SCOPE_AGENT);
            const float us_ = (float)(s1_ - s0_) * 0.01f; int v_ = (int)floorf(log2f(us_ / (float)(PHUNIT)) * 6.0f); v_ = v_ < 0 ? 0 : (v_ > 29 ? 29 : v_); dbgv = (unsigned)(1 + v_); }
#elif defined(CLKPROBE)
        const unsigned dbgv = __hip_atomic_load((unsigned*)(ws + WS_CTL) + 12288, __ATOMIC_RELAXED, __HIP_MEMORY_SCOPE_AGENT);
#endif
        f32x4 gq[8];
#pragma unroll
        for (int j = 0; j < 8; ++j) gq[j] = ((const f32x4*)gfin)[F.lane + 64 * j];
        for (int tb0 = F.gw; tb0 < T; tb0 += 2 * NGW) {
            int pp[2][2]; float ww[2][2];
#pragma unroll
            for (int r = 0; r < 2; ++r) { const int t = tb0 + r * NGW; pp[r][0] = POS[2 * t]; pp[r][1] = POS[2 * t + 1];
                ww[r][0] = GWT[2 * t] * (1.0f / (F8_SACT * F8_SW)); ww[r][1] = GWT[2 * t + 1] * (1.0f / (F8_SACT * F8_SW)); }
            u32x2 rx[2][8], ra[2][8], rb[2][8];
#pragma unroll
            for (int r = 0; r < 2; ++r) { const int t = tb0 + r * NGW;
                const u32x2* xr = (const u32x2*)(X + (size_t)t * D) + F.lane; const u32x2* y0 = (const u32x2*)(Y + (size_t)pp[r][0] * D) + F.lane; const u32x2* y1 = (const u32x2*)(Y + (size_t)pp[r][1] * D) + F.lane;
#pragma unroll
                for (int j = 0; j < 8; ++j) { rx[r][j] = xr[64 * j]; ra[r][j] = y0[64 * j]; rb[r][j] = y1[64 * j]; } }
#pragma unroll
            for (int r = 0; r < 2; ++r) { const int t = tb0 + r * NGW; const float w0 = ww[r][0], w1 = ww[r][1];
                f32x4 v[8]; float ss = 0.f;
#pragma unroll
                for (int j = 0; j < 8; ++j) { const u32x2 x2 = rx[r][j], a = ra[r][j], b = rb[r][j];
                    v[j].x = bf_lo(x2.x) + w0 * bf_lo(a.x) + w1 * bf_lo(b.x); v[j].y = bf_hi(x2.x) + w0 * bf_hi(a.x) + w1 * bf_hi(b.x); v[j].z = bf_lo(x2.y) + w0 * bf_lo(a.y) + w1 * bf_lo(b.y); v[j].w = bf_hi(x2.y) + w0 * bf_hi(a.y) + w1 * bf_hi(b.y);
                    ss += dot4(v[j]); }
                const float rstd = 1.0f / sqrtf(wave_sum(ss) * (1.0f / D) + EPS);
                f32x4* orow = (f32x4*)(kp->out + (size_t)t * D) + F.lane;
#pragma unroll
                for (int j = 0; j < 8; ++j) { const f32x4 gg = gq[j]; f32x4 ov = (f32x4){v[j].x * rstd * gg.x, v[j].y * rstd * gg.y, v[j].z * rstd * gg.z, v[j].w * rstd * gg.w};
#if defined(CLKPROBE) || defined(PHTIME)
                    ov = ov * (1.0f + (float)dbgv);
#endif
                    orow[64 * j] = ov; }
            }
        }
    } PH_END
#undef IN
#undef SEAM
}

#ifndef MK_ONE_LAUNCH
#define MK_ONE_LAUNCH 1
#endif
extern "C" void kernel_launch(void* const* d_in, const int* in_sizes, int n_in, void* d_out, int out_size, void* d_ws, size_t ws_size, hipStream_t stream) {
    static int grid = 0;
    if (grid == 0) {
        if (n_in != 16 || in_sizes[0] != T * D || out_size != T * D || ws_size < WS_END) { fprintf(stderr, "kernel_launch: shape/workspace mismatch (n_in %d, in0 %d, out %d, ws %zu, need %zu)\n", n_in, n_in > 0 ? in_sizes[0] : -1, out_size, ws_size, (size_t)WS_END); grid = -1; return; }
        int dev = 0, cus = 0, per_cu = 0;
        if (hipGetDevice(&dev) != hipSuccess || hipDeviceGetAttribute(&cus, hipDeviceAttributeMultiprocessorCount, dev) != hipSuccess) { grid = -1; return; }
        if (hipFuncSetAttribute((const void*)mega_fwd, hipFuncAttributeMaxDynamicSharedMemorySize, LDS_BYTES) != hipSuccess) { fprintf(stderr, "kernel_launch: hipFuncSetAttribute failed\n"); grid = -1; return; }
        if (hipOccupancyMaxActiveBlocksPerMultiprocessor(&per_cu, (const void*)mega_fwd, NTHREADS, LDS_BYTES) != hipSuccess || per_cu < 1) fprintf(stderr, "kernel_launch: occupancy query says %d\n", per_cu);
        (void)hipGetLastError();
        grid = cus;
        if (grid != 256) { fprintf(stderr, "kernel_launch: built for 256 CUs, found %d\n", cus); grid = -1; return; }
    }
    if (grid < 0) return;
    (void)hipMemsetAsync((char*)d_ws + WS_CTL, 0, CTL_ZERO_BYTES, stream);
    Params p{};
    for (int i = 0; i < 16; ++i) p.in[i] = (const float*)d_in[i];
    p.out = (float*)d_out; p.ws = (unsigned char*)d_ws;
#if MK_ONE_LAUNCH
    p.ph_lo = 0; p.ph_hi = N_PHASES;
    hipLaunchKernelGGL(mega_fwd, dim3(grid), dim3(NTHREADS), LDS_BYTES, stream, p);
#else
    for (int ph = 0; ph < N_PHASES; ++ph) { p.ph_lo = ph; p.ph_hi = ph + 1; hipLaunchKernelGGL(mega_fwd, dim3(grid), dim3(NTHREADS), LDS_BYTES, stream, p); }
#endif
}
```
